# Optimizing an MI355X kernel written in HIP

```python
import jax, jax.numpy as jnp
from jax import lax
import numpy as np

D_MODEL = 2048
BATCH = 4
SEQ = 4096
DEPTH = 4

MIX_WIDTH = D_MODEL
POOL_WIDTH = MIX_WIDTH // 2
RWKV_WIDTH = MIX_WIDTH - POOL_WIDTH
POOL_WINDOWS = (2, 4, 8, 16)
N_POOL_GROUPS = len(POOL_WINDOWS)
POOL_GROUP = POOL_WIDTH // N_POOL_GROUPS
HEAD_SIZE = 64
N_RWKV_HEADS = RWKV_WIDTH // HEAD_SIZE
D_DECAY_LORA = 64
D_AAA_LORA = 64
D_MV_LORA = 32
D_GATE_LORA = 160
D_FF = 4 * D_MODEL
D_PLE = 256
NORM_EPS = 1e-6
GN_EPS = 64e-5
SHIFT_WIDTH = 3 * RWKV_WIDTH + D_DECAY_LORA + D_AAA_LORA + D_GATE_LORA
IN_WIDTH = POOL_WIDTH + SHIFT_WIDTH

kernel_name = "hymba_pool_rwkv7_hybrid"


def rms_norm(x, g):
    xf = x.astype(jnp.float32)
    y = xf * lax.rsqrt(jnp.mean(xf * xf, axis=-1, keepdims=True) + NORM_EPS)
    return (y * g.astype(jnp.float32)).astype(x.dtype)


def token_shift(z, mu):
    zf = z.astype(jnp.float32)
    z_prev = jnp.pad(zf, ((0, 0), (1, 0), (0, 0)))[:, :-1]
    return zf + (z_prev - zf) * mu.astype(jnp.float32)


def causal_multiscale_pool(u):
    B, T, _ = u.shape
    uf = u.astype(jnp.float32).reshape(B, T, N_POOL_GROUPS, POOL_GROUP)
    cs = jnp.cumsum(uf, axis=1)
    t = jnp.arange(T)
    outs = []
    for gi, win in enumerate(POOL_WINDOWS):
        c = cs[:, :, gi]
        lagged = jnp.pad(c, ((0, 0), (win, 0), (0, 0)))[:, :T]
        cnt = jnp.minimum(t + 1, win).astype(jnp.float32)[None, :, None]
        outs.append((c - lagged) / cnt - uf[:, :, gi])
    return jnp.stack(outs, axis=2)


def wkv7_scan(r, decay, k, v, a_vec, b_vec):
    B, T, H, N = r.shape
    xs = tuple(jnp.swapaxes(z, 0, 1) for z in (r, decay, k, v, a_vec, b_vec))

    def step(S, inp):
        r_t, w_t, k_t, v_t, a_t, b_t = inp
        sa = jnp.einsum('bhij,bhj->bhi', S, a_t)
        S = S * w_t[:, :, None, :] + sa[..., None] * b_t[:, :, None, :] + v_t[..., None] * k_t[:, :, None, :]
        y = jnp.einsum('bhij,bhj->bhi', S, r_t)
        return S, y

    S0 = jnp.zeros((B, H, N, N), jnp.float32)
    _, y = lax.scan(step, S0, xs)
    return jnp.swapaxes(y, 0, 1)


def rwkv7_time_mix(zr, zk, zv, zw, za, zg, zvr, v_first, w0, w_up, a0, a_up, g_up,
                   v0, v_up, k_k, k_a, r_k, gn_g, gn_b):
    f32 = jnp.float32
    B, T, _ = zr.shape
    H, N = N_RWKV_HEADS, HEAD_SIZE
    r = zr
    k = zk
    v = zv
    w = -jax.nn.softplus(-(w0.astype(f32) + jnp.tanh(zw) @ w_up.astype(f32))) - 0.5
    decay = jnp.exp(-jnp.exp(w))
    a = jax.nn.sigmoid(a0.astype(f32) + za @ a_up.astype(f32))
    g = jax.nn.sigmoid(zg) @ g_up.astype(f32)
    if zvr is None:
        v_first = v
    else:
        v = v + (v_first - v) * jax.nn.sigmoid(v0.astype(f32) + zvr @ v_up.astype(f32))
    hs = lambda z: z.reshape(B, T, H, N)
    kk = hs(k * k_k.astype(f32))
    kk = kk / jnp.maximum(jnp.linalg.norm(kk, axis=-1, keepdims=True), 1e-12)
    k = k * (1.0 + (a - 1.0) * k_a.astype(f32))
    r_h, k_h, v_h, a_h = hs(r), hs(k), hs(v), hs(a)
    y = wkv7_scan(r_h, hs(decay), k_h, v_h, -kk, kk * a_h)
    mu = jnp.mean(y, axis=-1, keepdims=True)
    var = jnp.mean(jnp.square(y - mu), axis=-1, keepdims=True)
    y = (y - mu) * lax.rsqrt(var + GN_EPS) * gn_g.astype(f32).reshape(H, N) + gn_b.astype(f32).reshape(H, N)
    y = y + jnp.sum(r_h * k_h * r_k.astype(f32), axis=-1, keepdims=True) * v_h
    return y.reshape(B, T, RWKV_WIDTH) * g, v_first


def setup_inputs(seed: int = 0) -> dict:
    key = jax.random.key(seed)
    ks = iter(jax.random.split(key, 40))
    f32 = jnp.float32

    def nrm(shape, scale):
        return jax.random.normal(next(ks), shape, f32) * scale

    def unif(shape, lo, hi):
        return jax.random.uniform(next(ks), shape, f32, minval=lo, maxval=hi)

    L, Lm1, D, R = DEPTH, DEPTH - 1, D_MODEL, RWKV_WIDTH
    return {
        "x": nrm((BATCH, SEQ, D), 1.0),
        "p": nrm((DEPTH, BATCH, SEQ, D_PLE), 1.0),
        "attn_norm": 1.0 + nrm((L, D), 0.02),
        "w_in": nrm((L, D, IN_WIDTH), D ** -0.5),
        "mu_shift": unif((L, SHIFT_WIDTH), 0.0, 1.0),
        "w_vres_dn": nrm((Lm1, D, D_MV_LORA), D ** -0.5),
        "mu_vres": unif((Lm1, D_MV_LORA), 0.0, 1.0),
        "v0": nrm((Lm1, R), 0.5),
        "v_up": nrm((Lm1, D_MV_LORA, R), D_MV_LORA ** -0.5),
        "pool_w": nrm((L, N_POOL_GROUPS, POOL_GROUP, POOL_GROUP), POOL_GROUP ** -0.5),
        "pool_scale": 0.5 + nrm((L, POOL_WIDTH), 0.1),
        "w0": unif((L, R), -4.0, 1.0),
        "w_up": nrm((L, D_DECAY_LORA, R), D_DECAY_LORA ** -0.5),
        "a0": nrm((L, R), 0.3),
        "a_up": nrm((L, D_AAA_LORA, R), D_AAA_LORA ** -0.5),
        "g_up": nrm((L, D_GATE_LORA, R), D_GATE_LORA ** -0.5),
        "k_k": 0.85 + nrm((L, R), 0.05),
        "k_a": 1.0 + nrm((L, R), 0.05),
        "r_k": nrm((L, N_RWKV_HEADS, HEAD_SIZE), 0.1),
        "gn_g": 1.0 + nrm((L, R), 0.02),
        "gn_b": nrm((L, R), 0.02),
        "w_out": nrm((L, MIX_WIDTH, D), MIX_WIDTH ** -0.5),
        "mlp_norm": 1.0 + nrm((L, D), 0.02),
        "w_ffn_up": nrm((L, D, D_FF), D ** -0.5),
        "w_ffn_down": nrm((L, D_FF, D), D_FF ** -0.5),
        "ple_norm": 1.0 + nrm((L, D), 0.02),
        "w_ple_gate": nrm((L, D, D), D ** -0.5),
        "w_ple_proj": nrm((L, D_PLE, D), D_PLE ** -0.5),
        "final_norm": 1.0 + nrm((D,), 0.02),
    }


def reference(x, p, attn_norm, w_in, mu_shift, w_vres_dn, mu_vres, v0, v_up, pool_w, pool_scale,
              w0, w_up, a0, a_up, g_up, k_k, k_a, r_k, gn_g, gn_b, w_out, mlp_norm, w_ffn_up,
              w_ffn_down, ple_norm, w_ple_gate, w_ple_proj, final_norm):
    B, T, _ = x.shape
    R = RWKV_WIDTH
    o_w = 3 * R
    o_a = o_w + D_DECAY_LORA
    o_g = o_a + D_AAA_LORA
    v_first = None
    for i in range(DEPTH):
        h = rms_norm(x, attn_norm[i])
        if i == 0:
            z = h @ w_in[0]
        else:
            z = h @ jnp.concatenate([w_in[i], w_vres_dn[i - 1]], axis=1)
        z_pool = z[..., :POOL_WIDTH]
        zs = token_shift(z[..., POOL_WIDTH:IN_WIDTH], mu_shift[i])
        zvr = None if i == 0 else token_shift(z[..., IN_WIDTH:], mu_vres[i - 1])

        d = causal_multiscale_pool(z_pool)
        pool_out = jnp.einsum('btgc,gcd->btgd', d, pool_w[i].astype(jnp.float32)).reshape(B, T, POOL_WIDTH)
        pool_out = pool_out * pool_scale[i].astype(jnp.float32)

        rwkv_out, v_first = rwkv7_time_mix(
            zs[..., :R], zs[..., R:2 * R], zs[..., 2 * R:o_w], zs[..., o_w:o_a], zs[..., o_a:o_g], zs[..., o_g:],
            zvr, v_first, w0[i], w_up[i], a0[i], a_up[i], g_up[i],
            None if i == 0 else v0[i - 1], None if i == 0 else v_up[i - 1],
            k_k[i], k_a[i], r_k[i], gn_g[i], gn_b[i])

        mix = jnp.concatenate([pool_out, rwkv_out], axis=-1).astype(x.dtype)
        x = x + mix @ w_out[i]

        h2 = rms_norm(x, mlp_norm[i])
        x = x + jnp.square(jax.nn.relu(h2 @ w_ffn_up[i])) @ w_ffn_down[i]

        gate = jax.nn.sigmoid(rms_norm(x, ple_norm[i]) @ w_ple_gate[i])
        x = x + gate * (p[i] @ w_ple_proj[i])
    return rms_norm(x, final_norm)
```

```cpp
#include <hip/hip_runtime.h>
#include <hip/hip_cooperative_groups.h>
#include <cstdio>
#include <cstdint>
namespace cg = cooperative_groups;

#ifndef MK_PER_PHASE_LAUNCH
#define MK_PER_PHASE_LAUNCH 0
#endif

#define LAS __attribute__((address_space(3)))
typedef unsigned short bf16_t;
typedef short bf16x8 __attribute__((ext_vector_type(8)));
typedef float f32x4 __attribute__((ext_vector_type(4)));
typedef float f32x8 __attribute__((ext_vector_type(8)));
typedef unsigned v4u __attribute__((ext_vector_type(4)));
typedef unsigned v2u __attribute__((ext_vector_type(2)));

constexpr int BATCH = 4, SEQ = 4096, DM = 2048, DEPTH = 4, M = BATCH * SEQ;
constexpr int RW = 1024, HS = 64, NH = 16, DFF = 8192, DPLE = 256;
constexpr int INW = 4384, NZ = 4608, SHIFTW = 3360, KL = 384;
constexpr float NORM_EPS = 1e-6f, GN_EPS = 64e-5f;

constexpr size_t MiB = 1u << 20;
constexpr size_t WS_WIN = 1 * MiB, WS_WOUT = 73 * MiB, WS_WUP = 105 * MiB, WS_WDN = 233 * MiB, WS_WGATE = 361 * MiB, WS_WPROJ = 393 * MiB,
                 WS_WLORA = 397 * MiB, WS_WPOOL = 409 * MiB, WS_PB = 411 * MiB, WS_H = 443 * MiB, WS_MIX = 507 * MiB  ,
                 WS_DPOOL = 571 * MiB  , WS_ALORA = 603 * MiB, WS_VFIRST = 615 * MiB, WS_Z = 647 * MiB, WS_PLANES = 791 * MiB,
                 WS_U = 647 * MiB  , WS_END = 919 * MiB;
constexpr size_t PLANE = (size_t)M * RW;

constexpr int LDS_BYTES = 135168;

__device__ __forceinline__ unsigned cvt_pk_bf16(float lo, float hi) { unsigned r; asm volatile("v_cvt_pk_bf16_f32 %0, %1, %2" : "=v"(r) : "v"(lo), "v"(hi)); return r; }
__device__ __forceinline__ float bf2f(unsigned h) { return __uint_as_float(h << 16); }
__device__ __forceinline__ f32x8 up8(v4u p) {
    f32x8 r;
    r[0] = __uint_as_float(p.x << 16); r[1] = __uint_as_float(p.x & 0xffff0000u);
    r[2] = __uint_as_float(p.y << 16); r[3] = __uint_as_float(p.y & 0xffff0000u);
    r[4] = __uint_as_float(p.z << 16); r[5] = __uint_as_float(p.z & 0xffff0000u);
    r[6] = __uint_as_float(p.w << 16); r[7] = __uint_as_float(p.w & 0xffff0000u);
    return r;
}
__device__ __forceinline__ v4u pk8(f32x8 v) { v4u o; o.x = cvt_pk_bf16(v[0], v[1]); o.y = cvt_pk_bf16(v[2], v[3]); o.z = cvt_pk_bf16(v[4], v[5]); o.w = cvt_pk_bf16(v[6], v[7]); return o; }
__device__ __forceinline__ f32x8 ld8f(const float* p) { const f32x4 a = *(const f32x4*)p, b = *(const f32x4*)(p + 4); f32x8 r; r[0] = a[0]; r[1] = a[1]; r[2] = a[2]; r[3] = a[3]; r[4] = b[0]; r[5] = b[1]; r[6] = b[2]; r[7] = b[3]; return r; }
__device__ __forceinline__ float sigm(float x) { return __builtin_amdgcn_rcpf(1.0f + __expf(-x)); }
__device__ __forceinline__ float wave_sum(float v) {
#pragma unroll
    for (int o = 1; o < 64; o <<= 1) v += __shfl_xor(v, o);
    return v;
}
__device__ __forceinline__ float sum8(f32x8 v) { return ((v[0] + v[1]) + (v[2] + v[3])) + ((v[4] + v[5]) + (v[6] + v[7])); }
template <int CTRL> __device__ __forceinline__ float dpp_mov(float x) { const int xi = __builtin_bit_cast(int, x); return __builtin_bit_cast(float, __builtin_amdgcn_update_dpp(xi, xi, CTRL, 0xF, 0xF, false)); }
__device__ __forceinline__ float allreduce16(float x) {
    x += dpp_mov<0x128>(x); x += dpp_mov<0x124>(x); x += dpp_mov<0x122>(x); x += dpp_mov<0x121>(x); return x;
}

namespace pg8 {
constexpr int BM = 256, BK = 64, HALF = 128, HTB = HALF * BK * 2, STAGE_BYTES = 8 * HTB, NXCD = 8, WGM = 8;
__host__ __device__ __forceinline__ int lds_byte(int r, int c) { const int st = (r >> 4) * 2 + (c >> 5), rr = r & 15, cc = c & 31, ob = rr * 64 + cc * 2; return st * 1024 + (ob ^ (((ob >> 9) & 1) << 5)); }
__host__ __device__ __forceinline__ void stage_rc(int b, int& R, int& C) { const int st = b / 1024, sb = b % 1024, swz = sb ^ (((sb >> 9) & 1) << 5); R = (st >> 1) * 16 + swz / 64; C = (st & 1) * 32 + (swz % 64) / 2; }
__host__ __device__ __forceinline__ int perm32(int rho) { const int n = rho >> 4, i = rho & 15; return 8 * (i >> 2) + 4 * n + (i & 3); }

struct Unit { int pm, pn; };

struct StaticOrder {
    int nM, nN, nwg, G, c;
    __device__ void init(int nM_, int nN_, int G_, int c_) { nM = nM_; nN = nN_; nwg = nM * nN; G = G_; c = c_; }
    __device__ bool next(int i, Unit& u) const {
        const long L = (long)i * G + c; if (L >= nwg) return false;
        int wgid = (int)L; { const int q = nwg / NXCD, r = nwg % NXCD, xcd = wgid % NXCD, off = wgid / NXCD; wgid = (xcd < r ? xcd * (q + 1) : r * (q + 1) + (xcd - r) * q) + off; }
        const int nig = WGM * nN, gid = wgid / nig, fm = gid * WGM, gsz = (nM - fm) < WGM ? (nM - fm) : WGM;
        u.pm = fm + ((wgid % nig) % gsz); u.pn = (wgid % nig) / gsz; return true;
    }
};

template <int MODE> struct EpiB {
    static constexpr bool PERM = true;
    bf16_t* O; int ldc; const float* c0; const float* c1; const float* c2; size_t plane;
    __device__ __forceinline__ void operator()(const f32x4 (&acc)[2][2][4][2], const Unit& u, int wr, int wc, int fr, int fq) const {
        const int row0 = u.pm * BM + wr * 64 + fr; int colt = u.pn * BM; bf16_t* base = O; int t = 0;
        if (MODE == 3) { t = colt >> 10; base += (size_t)t * plane; colt &= 1023; }
        const int col0 = colt + wc * 32 + 8 * fq;
        f32x4 cv[2][2];
#pragma unroll
        for (int bj = 0; bj < 2; ++bj)
#pragma unroll
            for (int n = 0; n < 2; ++n) {
                cv[bj][n] = (f32x4){0.f, 0.f, 0.f, 0.f};
                if (MODE == 2) cv[bj][n] = *(const f32x4*)(c0 + col0 + bj * HALF + 4 * n);
                if (MODE == 3) { const float* b = (t == 0) ? c0 : (t == 1) ? c1 : (t == 3) ? c2 : nullptr; if (b) cv[bj][n] = *(const f32x4*)(b + col0 + bj * HALF + 4 * n); }
            }
#pragma unroll
        for (int ai = 0; ai < 2; ++ai)
#pragma unroll
            for (int m = 0; m < 4; ++m) { bf16_t* rowp = base + (size_t)(row0 + ai * HALF + m * 16) * ldc + col0;
#pragma unroll
                for (int bj = 0; bj < 2; ++bj) { f32x4 v0 = acc[ai][bj][m][0], v1 = acc[ai][bj][m][1];
                    if (MODE == 1) {
#pragma unroll
                        for (int j = 0; j < 4; ++j) { const float a = fmaxf(v0[j], 0.f), b = fmaxf(v1[j], 0.f); v0[j] = a * a; v1[j] = b * b; } }
                    if (MODE == 2) { v0 = v0 * cv[bj][0]; v1 = v1 * cv[bj][1]; }
                    if (MODE == 3) { v0 = v0 + cv[bj][0]; v1 = v1 + cv[bj][1];
                        if (t == 0) {
#pragma unroll
                            for (int j = 0; j < 4; ++j) { v0[j] = -0.6065306597f * sigm(v0[j]); v1[j] = -0.6065306597f * sigm(v1[j]); } }
                        else if (t != 2) {
#pragma unroll
                            for (int j = 0; j < 4; ++j) { v0[j] = sigm(v0[j]); v1[j] = sigm(v1[j]); } }
                    }
                    v4u w; w.x = cvt_pk_bf16(v0[0], v0[1]); w.y = cvt_pk_bf16(v0[2], v0[3]); w.z = cvt_pk_bf16(v1[0], v1[1]); w.w = cvt_pk_bf16(v1[2], v1[3]);
                    *(v4u*)(rowp + bj * HALF) = w; } }
    }
};
template <bool GATE> struct EpiR {
    static constexpr bool PERM = false;
    const float* base; float* out; const bf16_t* pp; int ldc;
    __device__ __forceinline__ void operator()(const f32x4 (&acc)[2][2][4][2], const Unit& u, int wr, int wc, int fr, int fq) const {
        const int row0 = u.pm * BM + wr * 64 + fr, col0 = u.pn * BM + wc * 32 + 4 * fq;
#pragma unroll
        for (int ai = 0; ai < 2; ++ai)
#pragma unroll
            for (int m = 0; m < 4; ++m) { const size_t off = (size_t)(row0 + ai * HALF + m * 16) * ldc + col0;
#pragma unroll
                for (int bj = 0; bj < 2; ++bj)
#pragma unroll
                    for (int n = 0; n < 2; ++n) { const f32x4 bs = *(const f32x4*)(base + off + bj * HALF + n * 16); f32x4 a = acc[ai][bj][m][n];
                        if (GATE) { const v2u q = *(const v2u*)(pp + off + bj * HALF + n * 16);
                            a[0] = sigm(a[0]) * __uint_as_float(q.x << 16); a[1] = sigm(a[1]) * __uint_as_float(q.x & 0xffff0000u);
                            a[2] = sigm(a[2]) * __uint_as_float(q.y << 16); a[3] = sigm(a[3]) * __uint_as_float(q.y & 0xffff0000u); }
                        *(f32x4*)(out + off + bj * HALF + n * 16) = bs + a; }
                asm volatile("" ::: "memory"); }
    }
};

struct Job { const bf16_t* A; const bf16_t* Bt; int lda, ldb, K, a_pn_step, nM, nN, mode;
             bf16_t* O; int ldc; const float* c0; const float* c1; const float* c2; const float* base; float* out; const bf16_t* pp; };
__device__ __forceinline__ void run_epi(const Job& J, const f32x4 (&acc)[2][2][4][2], const Unit& u, int wr, int wc, int fr, int fq) {
    switch (J.mode) {
    case 0: { EpiB<0> E{J.O, J.ldc, nullptr, nullptr, nullptr, 0}; E(acc, u, wr, wc, fr, fq); } break;
    case 1: { EpiB<1> E{J.O, J.ldc, nullptr, nullptr, nullptr, 0}; E(acc, u, wr, wc, fr, fq); } break;
    case 2: { EpiB<2> E{J.O, J.ldc, J.c0, nullptr, nullptr, 0}; E(acc, u, wr, wc, fr, fq); } break;
    case 3: { EpiB<3> E{J.O, J.ldc, J.c0, J.c1, J.c2, PLANE}; E(acc, u, wr, wc, fr, fq); } break;
    case 4: { EpiR<false> E{J.base, J.out, nullptr, J.ldc}; E(acc, u, wr, wc, fr, fq); } break;
    default: { EpiR<true> E{J.base, J.out, J.pp, J.ldc}; E(acc, u, wr, wc, fr, fq); } break;
    }
}
__device__ __forceinline__ void gemm_phase(LAS unsigned char* lds, const Job& J, const StaticOrder& S, const int tid) {
    const int wid = __builtin_amdgcn_readfirstlane(tid >> 6), lane = tid & 63, wr = wid >> 2, wc = wid & 3, fr = lane & 15, fq = lane >> 4;
    const int K = J.K, nt = K / BK;
    unsigned voffA[2], voffB[2];
#pragma unroll
    for (int i = 0; i < 2; ++i) { int R, C; stage_rc(tid * 16 + i * 8192, R, C); const int Rb = (J.mode < 4) ? ((R & ~31) + perm32(R & 31)) : R;
        voffA[i] = (unsigned)(R * J.lda + C) * 2u; voffB[i] = (unsigned)(Rb * J.ldb + C) * 2u; }
    const size_t kstep = (size_t)(BK * 2);
    const size_t hstepA = (size_t)HALF * J.lda * 2, hstepB = (size_t)HALF * J.ldb * 2;
    const size_t tstepA = 2 * hstepA, tstepB = 2 * hstepB;
    const unsigned ldsw = (unsigned)wid * 1024u;
    const int aoff = lds_byte(wr * 64 + fr, fq * 8), boff = lds_byte(wc * 32 + fr, fq * 8);
#define PG8_SA(b, h) (((b) * 2 + (h)) * HTB)
#define PG8_SB(b, h) ((4 + (b) * 2 + (h)) * HTB)
#define PG8_STAGE(bufoff, gbase, voff) do { _Pragma("unroll") for (int _i = 0; _i < 2; ++_i) \
        __builtin_amdgcn_global_load_lds((const unsigned*)((const char*)(gbase) + (voff)[_i]), (LAS unsigned*)(lds + (bufoff) + ldsw + _i * 8192), 16, 0, 0); } while (0)
#define PG8_LDA(dst, b, h) do { _Pragma("unroll") for (int m = 0; m < 4; ++m) _Pragma("unroll") for (int k = 0; k < 2; ++k) dst[m][k] = *(const LAS bf16x8*)(lds + PG8_SA(b, h) + aoff + m * 2048 + k * 1024); } while (0)
#define PG8_LDB(dst, b, h) do { _Pragma("unroll") for (int n = 0; n < 2; ++n) _Pragma("unroll") for (int k = 0; k < 2; ++k) dst[n][k] = *(const LAS bf16x8*)(lds + PG8_SB(b, h) + boff + n * 2048 + k * 1024); } while (0)
#define PG8_MMA(ai, bj, At, Bt) do { __builtin_amdgcn_s_setprio(1); _Pragma("unroll") for (int m = 0; m < 4; ++m) _Pragma("unroll") for (int n = 0; n < 2; ++n) _Pragma("unroll") for (int k = 0; k < 2; ++k) \
        acc[ai][bj][m][n] = __builtin_amdgcn_mfma_f32_16x16x32_bf16(Bt[n][k], At[m][k], acc[ai][bj][m][n], 0, 0, 0); __builtin_amdgcn_s_setprio(0); } while (0)
#define PG8_WAIT_V(n) asm volatile("s_waitcnt vmcnt(" #n ")" ::: "memory")
#define PG8_WAIT_L(n) asm volatile("s_waitcnt lgkmcnt(" #n ")" ::: "memory")
#define PG8_BAR __builtin_amdgcn_s_barrier()
#define PG8_SCHED __builtin_amdgcn_sched_barrier(0)
    Unit cur, nxt; int ui = 0;
    if (!S.next(0, cur)) return;
    f32x4 acc[2][2][4][2];
#pragma unroll
    for (int a = 0; a < 2; ++a)
#pragma unroll
        for (int b = 0; b < 2; ++b)
#pragma unroll
            for (int m = 0; m < 4; ++m)
#pragma unroll
                for (int n = 0; n < 2; ++n) acc[a][b][m][n] = (f32x4){0.f, 0.f, 0.f, 0.f};
    bf16x8 At[4][2], B0[2][2], B1[2][2];
    const char* cA = (const char*)J.A + (size_t)cur.pm * tstepA + (size_t)cur.pn * J.a_pn_step * 2; const char* cB = (const char*)J.Bt + (size_t)cur.pn * tstepB;
    PG8_STAGE(PG8_SB(0, 0), cB, voffB); PG8_STAGE(PG8_SB(0, 1), cB + hstepB, voffB); PG8_STAGE(PG8_SA(0, 0), cA, voffA); PG8_STAGE(PG8_SA(0, 1), cA + hstepA, voffA);
    if (wr == 1) PG8_BAR;
    PG8_WAIT_V(2); PG8_BAR;
    PG8_STAGE(PG8_SB(1, 0), cB + kstep, voffB); PG8_STAGE(PG8_SA(1, 0), cA + kstep, voffA); PG8_STAGE(PG8_SB(1, 1), cB + hstepB + kstep, voffB);
    PG8_WAIT_V(6); PG8_BAR;
    for (;;) {
        const bool has_next = S.next(ui + 1, nxt);
        const char* nA = has_next ? (const char*)J.A + (size_t)nxt.pm * tstepA + (size_t)nxt.pn * J.a_pn_step * 2 : cA; const char* nB = has_next ? (const char*)J.Bt + (size_t)nxt.pn * tstepB : cB;
        for (int t = 0; t < nt; t += 2) {
            const bool last = (t == nt - 2);
            const char* a1 = cA + (size_t)(t + 1) * kstep;
            const char* a2 = last ? nA : cA + (size_t)(t + 2) * kstep; const char* b2 = last ? nB : cB + (size_t)(t + 2) * kstep;
            const char* a3 = a2 + kstep; const char* b3 = b2 + kstep;
            PG8_LDB(B0, 0, 0); PG8_LDB(B1, 0, 1); PG8_SCHED; PG8_LDA(At, 0, 0); PG8_STAGE(PG8_SA(1, 1), a1 + hstepA, voffA);
            PG8_WAIT_V(8); PG8_WAIT_L(0); PG8_BAR; PG8_MMA(0, 0, At, B0); PG8_MMA(0, 1, At, B1); PG8_BAR; PG8_SCHED;
            PG8_LDA(At, 0, 1); PG8_STAGE(PG8_SB(0, 0), b2, voffB); PG8_STAGE(PG8_SB(0, 1), b2 + hstepB, voffB); PG8_STAGE(PG8_SA(0, 0), a2, voffA);
            PG8_WAIT_V(8); PG8_WAIT_L(0); PG8_BAR; PG8_MMA(1, 0, At, B0); PG8_MMA(1, 1, At, B1); PG8_BAR; PG8_SCHED;
            PG8_LDB(B0, 1, 0); PG8_LDB(B1, 1, 1); PG8_SCHED; PG8_LDA(At, 1, 0); PG8_STAGE(PG8_SA(0, 1), a2 + hstepA, voffA);
            PG8_WAIT_V(8); PG8_WAIT_L(0); PG8_BAR; PG8_MMA(0, 0, At, B0); PG8_MMA(0, 1, At, B1); PG8_BAR; PG8_SCHED;
            PG8_LDA(At, 1, 1); PG8_STAGE(PG8_SB(1, 0), b3, voffB); PG8_STAGE(PG8_SB(1, 1), b3 + hstepB, voffB); PG8_STAGE(PG8_SA(1, 0), a3, voffA);
            PG8_WAIT_V(8); PG8_WAIT_L(0); PG8_BAR; PG8_MMA(1, 0, At, B0); PG8_MMA(1, 1, At, B1); PG8_BAR; PG8_SCHED;
        }
        if (wr == 0) PG8_BAR;
        run_epi(J, acc, cur, wr, wc, fr, fq);
        if (!has_next) break;
#pragma unroll
        for (int a = 0; a < 2; ++a)
#pragma unroll
            for (int b = 0; b < 2; ++b)
#pragma unroll
                for (int m = 0; m < 4; ++m)
#pragma unroll
                    for (int n = 0; n < 2; ++n) acc[a][b][m][n] = (f32x4){0.f, 0.f, 0.f, 0.f};
        cur = nxt; cA = nA; cB = nB; ++ui;
        if (wr == 1) PG8_BAR;
    }
    PG8_WAIT_V(0);
    PG8_BAR;
#undef PG8_SA
#undef PG8_SB
#undef PG8_STAGE
#undef PG8_LDA
#undef PG8_LDB
#undef PG8_MMA
#undef PG8_WAIT_V
#undef PG8_WAIT_L
#undef PG8_BAR
#undef PG8_SCHED
}
}

struct Args { const float* in[29]; float* out; unsigned char* ws; int ph_lo, ph_hi; };
typedef const __attribute__((address_space(4))) Args* ArgsP;
enum { I_X = 0, I_P, I_ATTN_NORM, I_W_IN, I_MU_SHIFT, I_W_VRES_DN, I_MU_VRES, I_V0, I_V_UP, I_POOL_W, I_POOL_SCALE, I_W0, I_W_UP, I_A0, I_A_UP, I_G_UP,
       I_K_K, I_K_A, I_R_K, I_GN_G, I_GN_B, I_W_OUT, I_MLP_NORM, I_W_FFN_UP, I_W_FFN_DOWN, I_PLE_NORM, I_W_PLE_GATE, I_W_PLE_PROJ, I_FINAL_NORM };

__device__ __forceinline__ void p0_transpose_item(const float* W, int N, bf16_t* WT, int ldd, int row_off, LAS float* scr, int item, int nblk, int lane) {
    const int kb = item / nblk, nb = item % nblk, k0 = 64 * kb, n0 = 32 * nb;
#pragma unroll 8
    for (int i = 0; i < 32; ++i) { const int kk = 2 * i + (lane >> 5); scr[kk * 33 + (lane & 31)] = W[(size_t)(k0 + kk) * N + n0 + (lane & 31)]; }
    asm volatile("s_waitcnt lgkmcnt(0)" ::: "memory");
    const int c = lane & 7;
#pragma unroll
    for (int j = 0; j < 4; ++j) { const int n = (lane >> 3) + 8 * j; const LAS float* s = scr + (8 * c) * 33 + n;
        v4u o; o.x = cvt_pk_bf16(s[0 * 33], s[1 * 33]); o.y = cvt_pk_bf16(s[2 * 33], s[3 * 33]); o.z = cvt_pk_bf16(s[4 * 33], s[5 * 33]); o.w = cvt_pk_bf16(s[6 * 33], s[7 * 33]);
        *(v4u*)(WT + (size_t)(row_off + n0 + n) * ldd + k0 + 8 * c) = o; }
    asm volatile("s_waitcnt lgkmcnt(0)" ::: "memory");
}
__device__ __forceinline__ void cvt_job(const float* W, int K, int N, bf16_t* WT, int ldd, int row_off, LAS float* scr, int gw, int NW, int lane) {
    const int nblk = N / 32, nit = (K / 64) * nblk;
    for (int it = gw; it < nit; it += NW) p0_transpose_item(W, N, WT, ldd, row_off, scr, it, nblk, lane);
}
__device__ __forceinline__ void phase_convert(ArgsP a, LAS unsigned char* lds, const int tid, const int bx) {
    const int lane = tid & 63, wave = tid >> 6, G = gridDim.x;
    const int gw = bx * 8 + wave, NW = G * 8; const size_t gt = (size_t)bx * 512 + tid, NT = (size_t)G * 512;
    LAS float* scr = (LAS float*)(lds + wave * 8448);
    unsigned char* ws = a->ws;
    for (int l = 0; l < DEPTH; ++l) {
        bf16_t* win = (bf16_t*)(ws + WS_WIN) + (size_t)l * NZ * DM;
        cvt_job(a->in[I_W_IN] + (size_t)l * DM * INW, DM, INW, win, DM, 0, scr, gw, NW, lane);
        if (l > 0) cvt_job(a->in[I_W_VRES_DN] + (size_t)(l - 1) * DM * 32, DM, 32, win, DM, INW, scr, gw, NW, lane);
        { const int r0 = (l == 0) ? INW : INW + 32; const size_t n16 = (size_t)(NZ - r0) * DM / 8; v4u* z = (v4u*)(win + (size_t)r0 * DM);
          for (size_t i = gt; i < n16; i += NT) z[i] = (v4u){0u, 0u, 0u, 0u}; }
        cvt_job(a->in[I_W_OUT] + (size_t)l * DM * DM, DM, DM, (bf16_t*)(ws + WS_WOUT) + (size_t)l * DM * DM, DM, 0, scr, gw, NW, lane);
        cvt_job(a->in[I_W_FFN_UP] + (size_t)l * DM * DFF, DM, DFF, (bf16_t*)(ws + WS_WUP) + (size_t)l * DFF * DM, DM, 0, scr, gw, NW, lane);
        cvt_job(a->in[I_W_FFN_DOWN] + (size_t)l * DFF * DM, DFF, DM, (bf16_t*)(ws + WS_WDN) + (size_t)l * DM * DFF, DFF, 0, scr, gw, NW, lane);
        cvt_job(a->in[I_W_PLE_GATE] + (size_t)l * DM * DM, DM, DM, (bf16_t*)(ws + WS_WGATE) + (size_t)l * DM * DM, DM, 0, scr, gw, NW, lane);
        cvt_job(a->in[I_W_PLE_PROJ] + (size_t)l * DPLE * DM, DPLE, DM, (bf16_t*)(ws + WS_WPROJ) + (size_t)l * DM * DPLE, DPLE, 0, scr, gw, NW, lane);
        for (int gi = 0; gi < 4; ++gi)
            cvt_job(a->in[I_POOL_W] + ((size_t)l * 4 + gi) * 256 * 256, 256, 256, (bf16_t*)(ws + WS_WPOOL) + (size_t)l * 1024 * 256, 256, gi * 256, scr, gw, NW, lane);
        { bf16_t* wl = (bf16_t*)(ws + WS_WLORA) + (size_t)l * 4096 * KL;
          const float* wu = a->in[I_W_UP] + (size_t)l * 64 * RW; const float* au = a->in[I_A_UP] + (size_t)l * 64 * RW; const float* gu = a->in[I_G_UP] + (size_t)l * 160 * RW;
          const float* vu = a->in[I_V_UP] + (size_t)(l > 0 ? l - 1 : 0) * 32 * RW;
          for (size_t idx = gt; idx < (size_t)4096 * KL; idx += NT) { const int n = (int)(idx / KL), k = (int)(idx % KL), t = n >> 10, col = n & 1023; float v = 0.f;
              if (t == 0) { if (k < 64) v = wu[(size_t)k * RW + col]; }
              else if (t == 1) { if (k >= 64 && k < 128) v = au[(size_t)(k - 64) * RW + col]; }
              else if (t == 2) { if (k >= 128 && k < 288) v = gu[(size_t)(k - 128) * RW + col]; }
              else { if (l > 0 && k >= 288 && k < 320) v = vu[(size_t)(k - 288) * RW + col]; }
              wl[idx] = (bf16_t)(cvt_pk_bf16(v, 0.f) & 0xffffu); } }
    }
    { const float* p = a->in[I_P]; bf16_t* pb = (bf16_t*)(ws + WS_PB); const size_t n8 = (size_t)DEPTH * M * DPLE / 8;
      for (size_t i = gt; i < n8; i += NT) { const f32x8 v = ld8f(p + i * 8); *(v4u*)(pb + i * 8) = pk8(v); } }
}

__device__ __forceinline__ void phase_norm(const float* x, const float* g, bf16_t* H, float* outf, const int tid, const int bx) {
    const bool F32OUT = (outf != nullptr);
    const int lane = tid & 63, wave = tid >> 6; const int gw = bx * 8 + wave, NW = gridDim.x * 8;
    f32x4 gv[8];
#pragma unroll
    for (int j = 0; j < 8; ++j) gv[j] = ((const f32x4*)g)[lane + 64 * j];
    for (int row = gw; row < M; row += NW) {
        const f32x4* xr = (const f32x4*)(x + (size_t)row * DM) + lane;
        f32x4 v[8]; float s = 0.f;
#pragma unroll
        for (int j = 0; j < 8; ++j) { v[j] = xr[64 * j]; s += (v[j][0] * v[j][0] + v[j][1] * v[j][1]) + (v[j][2] * v[j][2] + v[j][3] * v[j][3]); }
        s = wave_sum(s);
        const float rs = rsqrtf(s * (1.0f / DM) + NORM_EPS);
#pragma unroll
        for (int j = 0; j < 8; ++j) { const f32x4 o = v[j] * rs * gv[j];
            if (F32OUT) ((f32x4*)(outf + (size_t)row * DM))[lane + 64 * j] = o;
            else { v2u w; w.x = cvt_pk_bf16(o[0], o[1]); w.y = cvt_pk_bf16(o[2], o[3]); ((v2u*)(H + (size_t)row * DM))[lane + 64 * j] = w; } }
    }
}

__device__ __forceinline__ void phase_prepa(ArgsP a, int l, const int tid, const int bx) {
    const int G = gridDim.x;
    const bf16_t* Z = (const bf16_t*)(a->ws + WS_Z); bf16_t* DP = (bf16_t*)(a->ws + WS_DPOOL); bf16_t* AL = (bf16_t*)(a->ws + WS_ALORA);
    const float* mus = a->in[I_MU_SHIFT] + (size_t)l * SHIFTW; const float* muv = a->in[I_MU_VRES] + (size_t)(l > 0 ? l - 1 : 0) * 32;
    const int rsub = tid >> 7, cgp = tid & 127;
    for (int unit = bx; unit < M / 4; unit += G) {
        const int row = unit * 4 + rsub, tpos = row & (SEQ - 1);
        { const int gi = cgp >> 5, win = 2 << gi, cnt = (tpos + 1 < win) ? tpos + 1 : win;
          const bf16_t* zp = Z + (size_t)row * NZ + 8 * cgp;
          const f32x8 u = up8(*(const v4u*)zp); f32x8 s = u;
          for (int q = 1; q < cnt; ++q) s = s + up8(*(const v4u*)(zp - (size_t)q * NZ));
          const f32x8 d = s * (1.0f / (float)cnt) - u;
          *(v4u*)(DP + (size_t)row * RW + 8 * cgp) = pk8(d); }
        if (cgp < KL / 8) {
            const int c = 8 * cgp; f32x8 o;
#pragma unroll
            for (int j = 0; j < 8; ++j) o[j] = 0.f;
            if (c < 288 || (c < 320 && l > 0)) {
                const bf16_t* zp = Z + (size_t)row * NZ + 4096 + c;
                const f32x8 zc = up8(*(const v4u*)zp); f32x8 zq;
                if (tpos > 0) zq = up8(*(const v4u*)(zp - NZ)); else {
#pragma unroll
                    for (int j = 0; j < 8; ++j) zq[j] = 0.f; }
                const f32x8 mu = (c < 288) ? ld8f(mus + 3072 + c) : ld8f(muv + (c - 288));
                const f32x8 zs = zc + (zq - zc) * mu;
                if (c < 64) {
#pragma unroll
                    for (int j = 0; j < 8; ++j) o[j] = 1.0f - 2.0f * __builtin_amdgcn_rcpf(1.0f + __expf(2.0f * zs[j])); }
                else if (c >= 128 && c < 288) {
#pragma unroll
                    for (int j = 0; j < 8; ++j) o[j] = sigm(zs[j]); }
                else o = zs;
            }
            *(v4u*)(AL + (size_t)row * KL + c) = pk8(o);
        }
    }
}

constexpr int TC = 32, STEPB = 1344, BUFB = TC * STEPB, YBB = TC * 16 * 4;
struct ScanRaw { v4u zr, zrp, zk, zkp, zv, zvp, ld, aa, vg, vf; };
__device__ __forceinline__ void scan_unit(ArgsP a, int l, int u, LAS unsigned char* lds, const int tid) {
    const int wave = __builtin_amdgcn_readfirstlane(tid >> 6), lane = tid & 63;
    const int bh = u >> 2, rg = u & 3, b = bh >> 4, h = bh & 15;
    const bool hasv = l > 0;
    constexpr int NC = SEQ / TC;
    const size_t rowbase = (size_t)b * SEQ;
    if (wave < 4) {
        const int rowl = 4 * wave + (lane >> 4), j = lane & 15;
        float s0 = 0.f, s1 = 0.f, s2 = 0.f, s3 = 0.f;
        for (int c = 0; c < NC; ++c) {
            __syncthreads();
            const LAS unsigned char* buf = lds + (c & 1) * BUFB + 16 * j;
            const LAS unsigned char* vb = lds + (c & 1) * BUFB + 1280 + 4 * rowl;
            LAS float* yb = (LAS float*)(lds + 2 * BUFB + (c & 1) * YBB) + rowl;
#pragma unroll 4
            for (int tl = 0; tl < TC; ++tl) {
                const f32x4 r4 = *(const LAS f32x4*)(buf + tl * STEPB);
                const f32x4 w4 = *(const LAS f32x4*)(buf + tl * STEPB + 256);
                const f32x4 k4 = *(const LAS f32x4*)(buf + tl * STEPB + 512);
                const f32x4 a4 = *(const LAS f32x4*)(buf + tl * STEPB + 768);
                const f32x4 b4 = *(const LAS f32x4*)(buf + tl * STEPB + 1024);
                const float v = *(const LAS float*)(vb + tl * STEPB);
                float p = (s0 * a4[0] + s1 * a4[1]) + (s2 * a4[2] + s3 * a4[3]);
                const float t0 = s0 * w4[0] + v * k4[0], t1 = s1 * w4[1] + v * k4[1], t2 = s2 * w4[2] + v * k4[2], t3 = s3 * w4[3] + v * k4[3];
                p = allreduce16(p);
                s0 = p * b4[0] + t0; s1 = p * b4[1] + t1; s2 = p * b4[2] + t2; s3 = p * b4[3] + t3;
                float y = (s0 * r4[0] + s1 * r4[1]) + (s2 * r4[2] + s3 * r4[3]);
                y = allreduce16(y);
                if (j == 0) yb[tl * 16] = y;
            }
        }
        __syncthreads();
    } else {
        const int ltid = tid - 256, tl = ltid >> 3, cgp = ltid & 7;
        const int col0 = h * HS + 8 * cgp;
        const bf16_t* Z = (const bf16_t*)(a->ws + WS_Z); const bf16_t* PL = (const bf16_t*)(a->ws + WS_PLANES); const bf16_t* VF = (const bf16_t*)(a->ws + WS_VFIRST);
        bf16_t* Y = (bf16_t*)(a->ws + WS_DPOOL);
        const float* mus = a->in[I_MU_SHIFT] + (size_t)l * SHIFTW;
        const f32x8 mur = ld8f(mus + col0), muk = ld8f(mus + 1024 + col0), muv = ld8f(mus + 2048 + col0);
        const f32x8 kkc = ld8f(a->in[I_K_K] + (size_t)l * RW + col0), kac = ld8f(a->in[I_K_A] + (size_t)l * RW + col0);
        const bool vmine = (cgp >> 1) == rg;
#define SCAN_LOAD(R, cc) do { const int t_ = (cc) * TC + tl; const size_t row_ = rowbase + t_; const size_t rowp_ = (t_ > 0) ? row_ - 1 : row_; \
            const bf16_t* z_ = Z + row_ * NZ + col0; const bf16_t* zq_ = Z + rowp_ * NZ + col0; \
            R.zr = *(const v4u*)(z_ + 1024); R.zk = *(const v4u*)(z_ + 2048); R.zv = *(const v4u*)(z_ + 3072); \
            R.zrp = *(const v4u*)(zq_ + 1024); R.zkp = *(const v4u*)(zq_ + 2048); R.zvp = *(const v4u*)(zq_ + 3072); \
            R.ld = *(const v4u*)(PL + row_ * RW + col0); R.aa = *(const v4u*)(PL + PLANE + row_ * RW + col0); \
            if (hasv) { R.vg = *(const v4u*)(PL + 3 * PLANE + row_ * RW + col0); R.vf = *(const v4u*)(VF + row_ * RW + col0); } else { R.vg = R.ld; R.vf = R.ld; } } while (0)
#define SCAN_FLUSH(cc) do { const LAS float* yb_ = (const LAS float*)(lds + 2 * BUFB + ((cc) & 1) * YBB) + tl * 16 + 2 * cgp; \
            const unsigned w_ = cvt_pk_bf16(yb_[0], yb_[1]); *(unsigned*)(Y + (rowbase + (size_t)(cc) * TC + tl) * RW + h * HS + 16 * rg + 2 * cgp) = w_; } while (0)
        ScanRaw nx; SCAN_LOAD(nx, 0);
        for (int c = 0; c < NC; ++c) {
            const ScanRaw cu = nx;
            if (c + 1 < NC) SCAN_LOAD(nx, c + 1);
            const int t = c * TC + tl;
            const f32x8 zr = up8(cu.zr), zk = up8(cu.zk), zv = up8(cu.zv);
            f32x8 zrp = up8(cu.zrp), zkp = up8(cu.zkp), zvp = up8(cu.zvp);
            if (t == 0) {
#pragma unroll
                for (int q = 0; q < 8; ++q) { zrp[q] = 0.f; zkp[q] = 0.f; zvp[q] = 0.f; } }
            const f32x8 r = zr + (zrp - zr) * mur, k = zk + (zkp - zk) * muk; f32x8 v = zv + (zvp - zv) * muv;
            const f32x8 ld = up8(cu.ld), av = up8(cu.aa);
            if (hasv) v = v + (up8(cu.vf) - v) * up8(cu.vg);
            const f32x8 kk = k * kkc;
            float n2 = sum8(kk * kk); n2 += __shfl_xor(n2, 1); n2 += __shfl_xor(n2, 2); n2 += __shfl_xor(n2, 4);
            const float inv = 1.0f / fmaxf(sqrtf(n2), 1e-12f);
            const f32x8 kkn = kk * inv;
            const f32x8 kadj = k * (1.0f + (av - 1.0f) * kac);
            f32x8 dec;
#pragma unroll
            for (int q = 0; q < 8; ++q) dec[q] = __expf(ld[q]);
            const f32x8 avec = -kkn, bvec = kkn * av;
            LAS unsigned char* dst = lds + (c & 1) * BUFB + tl * STEPB + cgp * 32;
#define ST8(off, val) do { *(LAS f32x4*)(dst + (off)) = (f32x4){val[0], val[1], val[2], val[3]}; *(LAS f32x4*)(dst + (off) + 16) = (f32x4){val[4], val[5], val[6], val[7]}; } while (0)
            ST8(0, r); ST8(256, dec); ST8(512, kadj); ST8(768, avec); ST8(1024, bvec);
            if (vmine) { LAS unsigned char* dv = lds + (c & 1) * BUFB + tl * STEPB + 1280 + (cgp & 1) * 32;
                *(LAS f32x4*)(dv) = (f32x4){v[0], v[1], v[2], v[3]}; *(LAS f32x4*)(dv + 16) = (f32x4){v[4], v[5], v[6], v[7]}; }
#undef ST8
            if (c >= 2) SCAN_FLUSH(c - 2);
            __syncthreads();
        }
        __syncthreads();
        SCAN_FLUSH(NC - 2); SCAN_FLUSH(NC - 1);
#undef SCAN_LOAD
#undef SCAN_FLUSH
    }
    __syncthreads();
}

__device__ __forceinline__ void phase_post(ArgsP a, int l, const int tid, const int bx) {
    const int lane = tid & 63, wave = tid >> 6; const int gw = bx * 8 + wave, NW = gridDim.x * 8;
    const bf16_t* Z = (const bf16_t*)(a->ws + WS_Z); const bf16_t* PL = (const bf16_t*)(a->ws + WS_PLANES); bf16_t* VF = (bf16_t*)(a->ws + WS_VFIRST);
    const bf16_t* Y = (const bf16_t*)(a->ws + WS_DPOOL); bf16_t* MIX = (bf16_t*)(a->ws + WS_MIX);
    const float* mus = a->in[I_MU_SHIFT] + (size_t)l * SHIFTW;
    const bool hasv = l > 0;
    for (int it = gw; it < M * 2; it += NW) {
        const int row = it >> 1, h = (it & 1) * 8 + (lane >> 3), col = h * HS + 8 * (lane & 7), tpos = row & (SEQ - 1);
        const bf16_t* z = Z + (size_t)row * NZ + col; const bf16_t* zq = (tpos > 0) ? z - NZ : z;
        const f32x8 zr = up8(*(const v4u*)(z + 1024)), zk = up8(*(const v4u*)(z + 2048)), zv = up8(*(const v4u*)(z + 3072));
        f32x8 zrp = up8(*(const v4u*)(zq + 1024)), zkp = up8(*(const v4u*)(zq + 2048)), zvp = up8(*(const v4u*)(zq + 3072));
        if (tpos == 0) {
#pragma unroll
            for (int q = 0; q < 8; ++q) { zrp[q] = 0.f; zkp[q] = 0.f; zvp[q] = 0.f; } }
        const f32x8 r = zr + (zrp - zr) * ld8f(mus + col), k = zk + (zkp - zk) * ld8f(mus + 1024 + col); f32x8 v = zv + (zvp - zv) * ld8f(mus + 2048 + col);
        const size_t po = (size_t)row * RW + col;
        const f32x8 av = up8(*(const v4u*)(PL + PLANE + po)), gg = up8(*(const v4u*)(PL + 2 * PLANE + po));
        if (hasv) v = v + (up8(*(const v4u*)(VF + po)) - v) * up8(*(const v4u*)(PL + 3 * PLANE + po));
        else *(v4u*)(VF + po) = pk8(v);
        const f32x8 kadj = k * (1.0f + (av - 1.0f) * ld8f(a->in[I_K_A] + (size_t)l * RW + col));
        float bonus = sum8(r * kadj * ld8f(a->in[I_R_K] + (size_t)l * RW + col));
        bonus += __shfl_xor(bonus, 1); bonus += __shfl_xor(bonus, 2); bonus += __shfl_xor(bonus, 4);
        const f32x8 y = up8(*(const v4u*)(Y + po));
        float sm = sum8(y); sm += __shfl_xor(sm, 1); sm += __shfl_xor(sm, 2); sm += __shfl_xor(sm, 4);
        const float mean = sm * (1.0f / 64.0f);
        const f32x8 d = y - mean;
        float vs = sum8(d * d); vs += __shfl_xor(vs, 1); vs += __shfl_xor(vs, 2); vs += __shfl_xor(vs, 4);
        const float rstd = rsqrtf(vs * (1.0f / 64.0f) + GN_EPS);
        const f32x8 o = (d * rstd * ld8f(a->in[I_GN_G] + (size_t)l * RW + col) + ld8f(a->in[I_GN_B] + (size_t)l * RW + col) + bonus * v) * gg;
        *(v4u*)(MIX + (size_t)row * DM + 1024 + col) = pk8(o);
    }
}

constexpr int N_PHASES = 2 + 12 * DEPTH;
__device__ __forceinline__ bool make_job(ArgsP a, int l, int s, int q, pg8::Job& J) {
    unsigned char* ws = a->ws; float* X = a->out;
    bf16_t* H = (bf16_t*)(ws + WS_H); bf16_t* MIX = (bf16_t*)(ws + WS_MIX); bf16_t* PP = (bf16_t*)(ws + WS_MIX);
    J.a_pn_step = 0; J.nM = M / 256; J.O = nullptr; J.ldc = DM; J.c0 = nullptr; J.c1 = nullptr; J.c2 = nullptr; J.base = nullptr; J.out = nullptr; J.pp = nullptr;
    if (s == 1 && q == 0) { J.A = H; J.Bt = (const bf16_t*)(ws + WS_WIN) + (size_t)l * NZ * DM; J.lda = DM; J.ldb = DM; J.K = DM; J.nN = NZ / 256; J.mode = 0; J.O = (bf16_t*)(ws + WS_Z); J.ldc = NZ; return true; }
    if (s == 3 && q == 0) { J.A = (const bf16_t*)(ws + WS_ALORA); J.Bt = (const bf16_t*)(ws + WS_WLORA) + (size_t)l * 4096 * KL; J.lda = KL; J.ldb = KL; J.K = KL; J.nN = 16; J.mode = 3; J.O = (bf16_t*)(ws + WS_PLANES); J.ldc = RW;
                            J.c0 = a->in[I_W0] + (size_t)l * RW; J.c1 = a->in[I_A0] + (size_t)l * RW; J.c2 = (l > 0) ? a->in[I_V0] + (size_t)(l - 1) * RW : nullptr; return true; }
    if (s == 3 && q == 1) { J.A = (const bf16_t*)(ws + WS_DPOOL); J.Bt = (const bf16_t*)(ws + WS_WPOOL) + (size_t)l * 1024 * 256; J.lda = RW; J.ldb = 256; J.K = 256; J.a_pn_step = 256; J.nN = 4; J.mode = 2; J.O = MIX; J.ldc = DM;
                            J.c0 = a->in[I_POOL_SCALE] + (size_t)l * 1024; return true; }
    if (s == 6 && q == 0) { J.A = MIX; J.Bt = (const bf16_t*)(ws + WS_WOUT) + (size_t)l * DM * DM; J.lda = DM; J.ldb = DM; J.K = DM; J.nN = DM / 256; J.mode = 4; J.base = (l == 0) ? a->in[I_X] : X; J.out = X; return true; }
    if (s == 8 && q == 0) { J.A = H; J.Bt = (const bf16_t*)(ws + WS_WUP) + (size_t)l * DFF * DM; J.lda = DM; J.ldb = DM; J.K = DM; J.nN = DFF / 256; J.mode = 1; J.O = (bf16_t*)(ws + WS_U); J.ldc = DFF; return true; }
    if (s == 8 && q == 1) { J.A = (const bf16_t*)(ws + WS_PB) + (size_t)l * M * DPLE; J.Bt = (const bf16_t*)(ws + WS_WPROJ) + (size_t)l * DM * DPLE; J.lda = DPLE; J.ldb = DPLE; J.K = DPLE; J.nN = DM / 256; J.mode = 0; J.O = PP; J.ldc = DM; return true; }
    if (s == 9 && q == 0) { J.A = (const bf16_t*)(ws + WS_U); J.Bt = (const bf16_t*)(ws + WS_WDN) + (size_t)l * DM * DFF; J.lda = DFF; J.ldb = DFF; J.K = DFF; J.nN = DM / 256; J.mode = 4; J.base = X; J.out = X; return true; }
    if (s == 11 && q == 0) { J.A = H; J.Bt = (const bf16_t*)(ws + WS_WGATE) + (size_t)l * DM * DM; J.lda = DM; J.ldb = DM; J.K = DM; J.nN = DM / 256; J.mode = 5; J.base = X; J.out = X; J.pp = PP; return true; }
    return false;
}
__global__ void __launch_bounds__(512, 2) fwd_megakernel(Args a_byval) {
    ArgsP a = (ArgsP)__builtin_amdgcn_kernarg_segment_ptr();
    extern __shared__ __attribute__((aligned(16))) unsigned char lds_raw[];
    LAS unsigned char* lds = (LAS unsigned char*)lds_raw;
    cg::grid_group grid = cg::this_grid();
    const int G = gridDim.x;
    const int ph_lo = a->ph_lo, ph_hi = a->ph_hi;
    for (int ph = ph_lo; ph < ph_hi; ++ph) {
        if (ph > ph_lo) grid.sync();
        asm volatile("" : "+s"(a) :: "memory");
        int tid = threadIdx.x, bx = blockIdx.x; asm volatile("" : "+v"(tid), "+s"(bx));
        float* X = a->out;
        if (ph == 0) {
#ifndef DIS_CONV
            phase_convert(a, lds, tid, bx);
#endif
            continue; }
        const bool fin = (ph == N_PHASES - 1);
        const int l = fin ? 0 : (ph - 1) / 12, s = fin ? 12 : (ph - 1) % 12;
        if (s == 0 || s == 7 || s == 10 || s == 12) {
            const float* xs = (s == 0 && l == 0) ? a->in[I_X] : X;
            const float* gp = (s == 0) ? a->in[I_ATTN_NORM] + (size_t)l * DM : (s == 7) ? a->in[I_MLP_NORM] + (size_t)l * DM : (s == 10) ? a->in[I_PLE_NORM] + (size_t)l * DM : a->in[I_FINAL_NORM];
#ifndef DIS_NORM
            phase_norm(xs, gp, (bf16_t*)(a->ws + WS_H), fin ? X : nullptr, tid, bx);
#endif
        } else if (s == 2) {
#ifndef DIS_PREPA
            phase_prepa(a, l, tid, bx);
#endif
        }
        else if (s == 4) { const int vcu = (G % 8 == 0) ? (bx % 8) * (G / 8) + bx / 8 : bx;
#ifndef DIS_SCAN
            for (int u = vcu; u < 256; u += G) scan_unit(a, l, u, lds, tid);
#endif
        }
        else if (s == 5) {
#ifndef DIS_POST
            phase_post(a, l, tid, bx);
#endif
        }
        else {
            for (int q = 0; q < 2; ++q) { pg8::Job J; if (!make_job(a, l, s, q, J)) break;

#ifndef DIS_GEMM
                pg8::StaticOrder S; S.init(J.nM, J.nN, G, bx); pg8::gemm_phase(lds, J, S, tid);
#endif
            }
        }
    }
}

extern "C" void kernel_launch(void* const* d_in, const int* in_sizes, int n_in, void* d_out, int out_size, void* d_ws, size_t ws_size, hipStream_t stream) {
    static int grid = 0;
    if (grid == 0) {
        if (n_in != 29 || in_sizes[0] != M * DM || out_size != M * DM || ws_size < WS_END) {
            fprintf(stderr, "kernel_launch: unexpected shapes: n_in %d in0 %d out %d ws %zu (need %zu); nothing launched\n", n_in, n_in > 0 ? in_sizes[0] : -1, out_size, ws_size, (size_t)WS_END); grid = -1; return; }
        int dev = 0, cus = 0, per_cu = 0;
        if (hipGetDevice(&dev) != hipSuccess || hipDeviceGetAttribute(&cus, hipDeviceAttributeMultiprocessorCount, dev) != hipSuccess) { fprintf(stderr, "kernel_launch: device query failed\n"); grid = -1; return; }
        if (hipFuncSetAttribute((const void*)fwd_megakernel, hipFuncAttributeMaxDynamicSharedMemorySize, LDS_BYTES) != hipSuccess) { fprintf(stderr, "kernel_launch: hipFuncSetAttribute failed\n"); grid = -1; return; }
        if (hipOccupancyMaxActiveBlocksPerMultiprocessor(&per_cu, (const void*)fwd_megakernel, 512, LDS_BYTES) != hipSuccess || per_cu < 1) {
            fprintf(stderr, "kernel_launch: occupancy query says %d blocks/CU; using 1\n", per_cu); per_cu = 1; }
        (void)hipGetLastError();
        grid = cus * 1;
        if (grid > 256) grid = 256;
    }
    if (grid < 0) return;
    Args a{};
    for (int i = 0; i < 29; ++i) a.in[i] = (const float*)d_in[i];
    a.out = (float*)d_out; a.ws = (unsigned char*)d_ws;
#if MK_PER_PHASE_LAUNCH
    for (int ph = 0; ph < N_PHASES; ++ph) {
        a.ph_lo = ph; a.ph_hi = ph + 1;
        hipLaunchKernelGGL(fwd_megakernel, dim3(grid), dim3(512), LDS_BYTES, stream, a);
    }
#else
    a.ph_lo = 0; a.ph_hi = N_PHASES;
    void* args[] = {&a};
    hipError_t e = hipLaunchCooperativeKernel((const void*)fwd_megakernel, dim3(grid), dim3(512), args, LDS_BYTES, stream);
    if (e != hipSuccess) fprintf(stderr, "cooperative launch failed: %s (grid %d)\n", hipGetErrorString(e), grid);
#endif
}
```

```cpp
#include <hip/hip_runtime.h>
#include <hip/hip_cooperative_groups.h>
#include <cstdio>
#include <cstdint>
namespace cg = cooperative_groups;

#ifndef MK_PER_PHASE_LAUNCH
#define MK_PER_PHASE_LAUNCH 0
#endif

#ifndef PROBE_REP
#define PROBE_REP 0
#endif
#define LAS __attribute__((address_space(3)))
typedef unsigned short bf16_t;
typedef short bf16x8 __attribute__((ext_vector_type(8)));
typedef float f32x4 __attribute__((ext_vector_type(4)));
typedef float f32x8 __attribute__((ext_vector_type(8)));
typedef float f32x2 __attribute__((ext_vector_type(2)));
typedef unsigned v4u __attribute__((ext_vector_type(4)));
typedef unsigned v2u __attribute__((ext_vector_type(2)));

constexpr int BATCH = 4, SEQ = 4096, DM = 2048, DEPTH = 4, M = BATCH * SEQ;
constexpr int RW = 1024, HS = 64, NH = 16, DFF = 8192, DPLE = 256;
constexpr int INW = 4384, NZ = 4608, SHIFTW = 3360, KL = 384;
constexpr float NORM_EPS = 1e-6f, GN_EPS = 64e-5f;

constexpr size_t MiB = 1u << 20;
constexpr size_t WS_WIN = 1 * MiB, WS_WOUT = 73 * MiB, WS_WUP = 105 * MiB, WS_WDN = 233 * MiB, WS_WGATE = 361 * MiB, WS_WPROJ = 393 * MiB,
                 WS_WLORA = 397 * MiB, WS_WPOOL = 409 * MiB, WS_PB = 411 * MiB, WS_H = 443 * MiB, WS_MIX = 507 * MiB  ,
                 WS_DPOOL = 571 * MiB  , WS_ALORA = 603 * MiB, WS_VFIRST = 615 * MiB, WS_Z = 647 * MiB, WS_PLANES = 791 * MiB,
                 WS_U = 647 * MiB  , WS_END = 919 * MiB;
constexpr size_t PLANE = (size_t)M * RW;

constexpr int LDS_BYTES = 135168, BAR_LDS_OFF = 131072 + 256;

__device__ __forceinline__ unsigned cvt_pk_bf16(float lo, float hi) { unsigned r; asm volatile("v_cvt_pk_bf16_f32 %0, %1, %2" : "=v"(r) : "v"(lo), "v"(hi)); return r; }
__device__ __forceinline__ float bf2f(unsigned h) { return __uint_as_float(h << 16); }
__device__ __forceinline__ f32x8 up8(v4u p) {
    f32x8 r;
    r[0] = __uint_as_float(p.x << 16); r[1] = __uint_as_float(p.x & 0xffff0000u);
    r[2] = __uint_as_float(p.y << 16); r[3] = __uint_as_float(p.y & 0xffff0000u);
    r[4] = __uint_as_float(p.z << 16); r[5] = __uint_as_float(p.z & 0xffff0000u);
    r[6] = __uint_as_float(p.w << 16); r[7] = __uint_as_float(p.w & 0xffff0000u);
    return r;
}
__device__ __forceinline__ v4u pk8(f32x8 v) { v4u o; o.x = cvt_pk_bf16(v[0], v[1]); o.y = cvt_pk_bf16(v[2], v[3]); o.z = cvt_pk_bf16(v[4], v[5]); o.w = cvt_pk_bf16(v[6], v[7]); return o; }
__device__ __forceinline__ f32x8 ld8f(const float* p) { const f32x4 a = *(const f32x4*)p, b = *(const f32x4*)(p + 4); f32x8 r; r[0] = a[0]; r[1] = a[1]; r[2] = a[2]; r[3] = a[3]; r[4] = b[0]; r[5] = b[1]; r[6] = b[2]; r[7] = b[3]; return r; }
__device__ __forceinline__ float sigm(float x) { return __builtin_amdgcn_rcpf(1.0f + __expf(-x)); }
__device__ __forceinline__ float wave_sum(float v) {
#pragma unroll
    for (int o = 1; o < 64; o <<= 1) v += __shfl_xor(v, o);
    return v;
}
__device__ __forceinline__ float sum8(f32x8 v) { return ((v[0] + v[1]) + (v[2] + v[3])) + ((v[4] + v[5]) + (v[6] + v[7])); }
template <int CTRL> __device__ __forceinline__ float dpp1(float x) { const int xi = __builtin_bit_cast(int, x); return __builtin_bit_cast(float, __builtin_amdgcn_update_dpp(0, xi, CTRL, 0xF, 0xF, true)); }
template <int CTRL> __device__ __forceinline__ float dpp_mov(float x) { const int xi = __builtin_bit_cast(int, x); return __builtin_bit_cast(float, __builtin_amdgcn_update_dpp(xi, xi, CTRL, 0xF, 0xF, false)); }
__device__ __forceinline__ float allreduce16(float x) {
    x += dpp_mov<0x128>(x); x += dpp_mov<0x124>(x); x += dpp_mov<0x122>(x); x += dpp_mov<0x121>(x); return x;
}

namespace pg8 {
constexpr int BM = 256, BK = 64, HALF = 128, HTB = HALF * BK * 2, STAGE_BYTES = 8 * HTB, NXCD = 8, WGM = 8;
__host__ __device__ __forceinline__ int lds_byte(int r, int c) { const int st = (r >> 4) * 2 + (c >> 5), rr = r & 15, cc = c & 31, ob = rr * 64 + cc * 2; return st * 1024 + (ob ^ (((ob >> 9) & 1) << 5)); }
__host__ __device__ __forceinline__ void stage_rc(int b, int& R, int& C) { const int st = b / 1024, sb = b % 1024, swz = sb ^ (((sb >> 9) & 1) << 5); R = (st >> 1) * 16 + swz / 64; C = (st & 1) * 32 + (swz % 64) / 2; }
__host__ __device__ __forceinline__ int perm32(int rho) { const int n = rho >> 4, i = rho & 15; return 8 * (i >> 2) + 4 * n + (i & 3); }

struct Unit { int pm, pn; };

struct StaticOrder {
    int nM, nN, nwg, G, c;
    __device__ void init(int nM_, int nN_, int G_, int c_) { nM = nM_; nN = nN_; nwg = nM * nN; G = G_; c = c_; }
    __device__ bool next(int i, Unit& u) const {
        const long L = (long)i * G + c; if (L >= nwg) return false;
        int wgid = (int)L; { const int q = nwg / NXCD, r = nwg % NXCD, xcd = wgid % NXCD, off = wgid / NXCD; wgid = (xcd < r ? xcd * (q + 1) : r * (q + 1) + (xcd - r) * q) + off; }
        const int nig = WGM * nN, gid = wgid / nig, fm = gid * WGM, gsz = (nM - fm) < WGM ? (nM - fm) : WGM;
        u.pm = fm + ((wgid % nig) % gsz); u.pn = (wgid % nig) / gsz; return true;
    }
};

template <int MODE> struct EpiB {
    static constexpr bool PERM = true;
    bf16_t* O; int ldc; const float* c0; const float* c1; const float* c2; size_t plane;
    __device__ __forceinline__ void operator()(const f32x4 (&acc)[2][2][4][2], const Unit& u, int wr, int wc, int fr, int fq) const {
        const int row0 = u.pm * BM + wr * 64 + fr; int colt = u.pn * BM; bf16_t* base = O; int t = 0;
        if (MODE == 3) { t = colt >> 10; base += (size_t)t * plane; colt &= 1023; }
        const int col0 = colt + wc * 32 + 8 * fq;
        f32x4 cv[2][2];
#pragma unroll
        for (int bj = 0; bj < 2; ++bj)
#pragma unroll
            for (int n = 0; n < 2; ++n) {
                cv[bj][n] = (f32x4){0.f, 0.f, 0.f, 0.f};
                if (MODE == 2) cv[bj][n] = *(const f32x4*)(c0 + col0 + bj * HALF + 4 * n);
                if (MODE == 3) { const float* b = (t == 0) ? c0 : (t == 1) ? c1 : (t == 3) ? c2 : nullptr; if (b) cv[bj][n] = *(const f32x4*)(b + col0 + bj * HALF + 4 * n); }
            }
#pragma unroll
        for (int ai = 0; ai < 2; ++ai)
#pragma unroll
            for (int m = 0; m < 4; ++m) { bf16_t* rowp = base + (size_t)(row0 + ai * HALF + m * 16) * ldc + col0;
#pragma unroll
                for (int bj = 0; bj < 2; ++bj) { f32x4 v0 = acc[ai][bj][m][0], v1 = acc[ai][bj][m][1];
                    if (MODE == 1) {
#pragma unroll
                        for (int j = 0; j < 4; ++j) { const float a = fmaxf(v0[j], 0.f), b = fmaxf(v1[j], 0.f); v0[j] = a * a; v1[j] = b * b; } }
                    if (MODE == 2) { v0 = v0 * cv[bj][0]; v1 = v1 * cv[bj][1]; }
                    if (MODE == 3) { v0 = v0 + cv[bj][0]; v1 = v1 + cv[bj][1];
                        if (t == 0) {
#pragma unroll
                            for (int j = 0; j < 4; ++j) { v0[j] = -0.6065306597f * sigm(v0[j]); v1[j] = -0.6065306597f * sigm(v1[j]); } }
                        else if (t != 2) {
#pragma unroll
                            for (int j = 0; j < 4; ++j) { v0[j] = sigm(v0[j]); v1[j] = sigm(v1[j]); } }
                    }
                    v4u w; w.x = cvt_pk_bf16(v0[0], v0[1]); w.y = cvt_pk_bf16(v0[2], v0[3]); w.z = cvt_pk_bf16(v1[0], v1[1]); w.w = cvt_pk_bf16(v1[2], v1[3]);
                    *(v4u*)(rowp + bj * HALF) = w; } }
    }
};
template <bool GATE> struct EpiR {
    static constexpr bool PERM = false;
    const float* base; float* out; const bf16_t* pp; int ldc;
    __device__ __forceinline__ void operator()(const f32x4 (&acc)[2][2][4][2], const Unit& u, int wr, int wc, int fr, int fq) const {
        const int row0 = u.pm * BM + wr * 64 + fr, col0 = u.pn * BM + wc * 32 + 4 * fq;
#pragma unroll
        for (int ai = 0; ai < 2; ++ai)
#pragma unroll
            for (int m = 0; m < 4; ++m) { const size_t off = (size_t)(row0 + ai * HALF + m * 16) * ldc + col0;
#pragma unroll
                for (int bj = 0; bj < 2; ++bj)
#pragma unroll
                    for (int n = 0; n < 2; ++n) { const f32x4 bs = *(const f32x4*)(base + off + bj * HALF + n * 16); f32x4 a = acc[ai][bj][m][n];
                        if (GATE) { const v2u q = *(const v2u*)(pp + off + bj * HALF + n * 16);
                            a[0] = sigm(a[0]) * __uint_as_float(q.x << 16); a[1] = sigm(a[1]) * __uint_as_float(q.x & 0xffff0000u);
                            a[2] = sigm(a[2]) * __uint_as_float(q.y << 16); a[3] = sigm(a[3]) * __uint_as_float(q.y & 0xffff0000u); }
                        *(f32x4*)(out + off + bj * HALF + n * 16) = bs + a; }
                asm volatile("" ::: "memory"); }
    }
};

struct Job { const bf16_t* A; const bf16_t* Bt; int lda, ldb, K, a_pn_step, nM, nN, mode;
             bf16_t* O; int ldc; const float* c0; const float* c1; const float* c2; const float* base; float* out; const bf16_t* pp; };
__device__ __forceinline__ void run_epi(const Job& J, const f32x4 (&acc)[2][2][4][2], const Unit& u, int wr, int wc, int fr, int fq) {
    switch (J.mode) {
    case 0: { EpiB<0> E{J.O, J.ldc, nullptr, nullptr, nullptr, 0}; E(acc, u, wr, wc, fr, fq); } break;
    case 1: { EpiB<1> E{J.O, J.ldc, nullptr, nullptr, nullptr, 0}; E(acc, u, wr, wc, fr, fq); } break;
    case 2: { EpiB<2> E{J.O, J.ldc, J.c0, nullptr, nullptr, 0}; E(acc, u, wr, wc, fr, fq); } break;
    case 3: { EpiB<3> E{J.O, J.ldc, J.c0, J.c1, J.c2, PLANE}; E(acc, u, wr, wc, fr, fq); } break;
    case 4: { EpiR<false> E{J.base, J.out, nullptr, J.ldc}; E(acc, u, wr, wc, fr, fq); } break;
    default: { EpiR<true> E{J.base, J.out, J.pp, J.ldc}; E(acc, u, wr, wc, fr, fq); } break;
    }
}
__device__ __forceinline__ void gemm_phase(LAS unsigned char* lds, const Job& J, const StaticOrder& S, const int tid) {
    const int wid = __builtin_amdgcn_readfirstlane(tid >> 6), lane = tid & 63, wr = wid >> 2, wc = wid & 3, fr = lane & 15, fq = lane >> 4;
    const int K = J.K, nt = K / BK;
    unsigned voffA[2], voffB[2];
#pragma unroll
    for (int i = 0; i < 2; ++i) { int R, C; stage_rc(tid * 16 + i * 8192, R, C); const int Rb = (J.mode < 4) ? ((R & ~31) + perm32(R & 31)) : R;
        voffA[i] = (unsigned)(R * J.lda + C) * 2u; voffB[i] = (unsigned)(Rb * J.ldb + C) * 2u; }
    const size_t kstep = (size_t)(BK * 2);
    const size_t hstepA = (size_t)HALF * J.lda * 2, hstepB = (size_t)HALF * J.ldb * 2;
    const size_t tstepA = 2 * hstepA, tstepB = 2 * hstepB;
    const unsigned ldsw = (unsigned)wid * 1024u;
    const int aoff = lds_byte(wr * 64 + fr, fq * 8), boff = lds_byte(wc * 32 + fr, fq * 8);
#define PG8_SA(b, h) (((b) * 2 + (h)) * HTB)
#define PG8_SB(b, h) ((4 + (b) * 2 + (h)) * HTB)
#define PG8_STAGE(bufoff, gbase, voff) do { _Pragma("unroll") for (int _i = 0; _i < 2; ++_i) \
        __builtin_amdgcn_global_load_lds((const unsigned*)((const char*)(gbase) + (voff)[_i]), (LAS unsigned*)(lds + (bufoff) + ldsw + _i * 8192), 16, 0, 0); } while (0)
#define PG8_LDA(dst, b, h) do { _Pragma("unroll") for (int m = 0; m < 4; ++m) _Pragma("unroll") for (int k = 0; k < 2; ++k) dst[m][k] = *(const LAS bf16x8*)(lds + PG8_SA(b, h) + aoff + m * 2048 + k * 1024); } while (0)
#define PG8_LDB(dst, b, h) do { _Pragma("unroll") for (int n = 0; n < 2; ++n) _Pragma("unroll") for (int k = 0; k < 2; ++k) dst[n][k] = *(const LAS bf16x8*)(lds + PG8_SB(b, h) + boff + n * 2048 + k * 1024); } while (0)
#define PG8_MMA(ai, bj, At, Bt) do { __builtin_amdgcn_s_setprio(1); _Pragma("unroll") for (int m = 0; m < 4; ++m) _Pragma("unroll") for (int n = 0; n < 2; ++n) _Pragma("unroll") for (int k = 0; k < 2; ++k) \
        acc[ai][bj][m][n] = __builtin_amdgcn_mfma_f32_16x16x32_bf16(Bt[n][k], At[m][k], acc[ai][bj][m][n], 0, 0, 0); __builtin_amdgcn_s_setprio(0); } while (0)
#define PG8_WAIT_V(n) asm volatile("s_waitcnt vmcnt(" #n ")" ::: "memory")
#define PG8_WAIT_L(n) asm volatile("s_waitcnt lgkmcnt(" #n ")" ::: "memory")
#define PG8_BAR __builtin_amdgcn_s_barrier()
#define PG8_SCHED __builtin_amdgcn_sched_barrier(0)
    Unit cur, nxt; int ui = 0;
    if (!S.next(0, cur)) return;
    f32x4 acc[2][2][4][2];
#pragma unroll
    for (int a = 0; a < 2; ++a)
#pragma unroll
        for (int b = 0; b < 2; ++b)
#pragma unroll
            for (int m = 0; m < 4; ++m)
#pragma unroll
                for (int n = 0; n < 2; ++n) acc[a][b][m][n] = (f32x4){0.f, 0.f, 0.f, 0.f};
    bf16x8 At[4][2], B0[2][2], B1[2][2];
    const char* cA = (const char*)J.A + (size_t)cur.pm * tstepA + (size_t)cur.pn * J.a_pn_step * 2; const char* cB = (const char*)J.Bt + (size_t)cur.pn * tstepB;
    PG8_STAGE(PG8_SB(0, 0), cB, voffB); PG8_STAGE(PG8_SB(0, 1), cB + hstepB, voffB); PG8_STAGE(PG8_SA(0, 0), cA, voffA); PG8_STAGE(PG8_SA(0, 1), cA + hstepA, voffA);
    if (wr == 1) PG8_BAR;
    PG8_WAIT_V(2); PG8_BAR;
    PG8_STAGE(PG8_SB(1, 0), cB + kstep, voffB); PG8_STAGE(PG8_SA(1, 0), cA + kstep, voffA); PG8_STAGE(PG8_SB(1, 1), cB + hstepB + kstep, voffB);
    PG8_WAIT_V(6); PG8_BAR;
    for (;;) {
        const bool has_next = S.next(ui + 1, nxt);
        const char* nA = has_next ? (const char*)J.A + (size_t)nxt.pm * tstepA + (size_t)nxt.pn * J.a_pn_step * 2 : cA; const char* nB = has_next ? (const char*)J.Bt + (size_t)nxt.pn * tstepB : cB;
        for (int t = 0; t < nt; t += 2) {
            const bool last = (t == nt - 2);
            const char* a1 = cA + (size_t)(t + 1) * kstep;
            const char* a2 = last ? nA : cA + (size_t)(t + 2) * kstep; const char* b2 = last ? nB : cB + (size_t)(t + 2) * kstep;
            const char* a3 = a2 + kstep; const char* b3 = b2 + kstep;
            PG8_LDB(B0, 0, 0); PG8_LDB(B1, 0, 1); PG8_SCHED; PG8_LDA(At, 0, 0); PG8_STAGE(PG8_SA(1, 1), a1 + hstepA, voffA);
            PG8_WAIT_V(8); PG8_WAIT_L(0); PG8_BAR; PG8_MMA(0, 0, At, B0); PG8_MMA(0, 1, At, B1); PG8_BAR; PG8_SCHED;
            PG8_LDA(At, 0, 1); PG8_STAGE(PG8_SB(0, 0), b2, voffB); PG8_STAGE(PG8_SB(0, 1), b2 + hstepB, voffB); PG8_STAGE(PG8_SA(0, 0), a2, voffA);
            PG8_WAIT_V(8); PG8_WAIT_L(0); PG8_BAR; PG8_MMA(1, 0, At, B0); PG8_MMA(1, 1, At, B1); PG8_BAR; PG8_SCHED;
            PG8_LDB(B0, 1, 0); PG8_LDB(B1, 1, 1); PG8_SCHED; PG8_LDA(At, 1, 0); PG8_STAGE(PG8_SA(0, 1), a2 + hstepA, voffA);
            PG8_WAIT_V(8); PG8_WAIT_L(0); PG8_BAR; PG8_MMA(0, 0, At, B0); PG8_MMA(0, 1, At, B1); PG8_BAR; PG8_SCHED;
            PG8_LDA(At, 1, 1); PG8_STAGE(PG8_SB(1, 0), b3, voffB); PG8_STAGE(PG8_SB(1, 1), b3 + hstepB, voffB); PG8_STAGE(PG8_SA(1, 0), a3, voffA);
            PG8_WAIT_V(8); PG8_WAIT_L(0); PG8_BAR; PG8_MMA(1, 0, At, B0); PG8_MMA(1, 1, At, B1); PG8_BAR; PG8_SCHED;
        }
        if (wr == 0) PG8_BAR;
        run_epi(J, acc, cur, wr, wc, fr, fq);
        if (!has_next) break;
#pragma unroll
        for (int a = 0; a < 2; ++a)
#pragma unroll
            for (int b = 0; b < 2; ++b)
#pragma unroll
                for (int m = 0; m < 4; ++m)
#pragma unroll
                    for (int n = 0; n < 2; ++n) acc[a][b][m][n] = (f32x4){0.f, 0.f, 0.f, 0.f};
        cur = nxt; cA = nA; cB = nB; ++ui;
        if (wr == 1) PG8_BAR;
    }
    PG8_WAIT_V(0);
    PG8_BAR;
#undef PG8_SA
#undef PG8_SB
#undef PG8_STAGE
#undef PG8_LDA
#undef PG8_LDB
#undef PG8_MMA
#undef PG8_WAIT_V
#undef PG8_WAIT_L
#undef PG8_BAR
#undef PG8_SCHED
}
}

struct Args { const float* in[29]; float* out; unsigned char* ws; int ph_lo, ph_hi; };
typedef const __attribute__((address_space(4))) Args* ArgsP;
enum { I_X = 0, I_P, I_ATTN_NORM, I_W_IN, I_MU_SHIFT, I_W_VRES_DN, I_MU_VRES, I_V0, I_V_UP, I_POOL_W, I_POOL_SCALE, I_W0, I_W_UP, I_A0, I_A_UP, I_G_UP,
       I_K_K, I_K_A, I_R_K, I_GN_G, I_GN_B, I_W_OUT, I_MLP_NORM, I_W_FFN_UP, I_W_FFN_DOWN, I_PLE_NORM, I_W_PLE_GATE, I_W_PLE_PROJ, I_FINAL_NORM };

__device__ __forceinline__ void p0_transpose_item(const float* W, int N, bf16_t* WT, int ldd, int row_off, LAS float* scr, int item, int nblk, int lane) {
    const int kb = item / nblk, nb = item % nblk, k0 = 64 * kb, n0 = 32 * nb;
#pragma unroll 8
    for (int i = 0; i < 32; ++i) { const int kk = 2 * i + (lane >> 5); scr[kk * 33 + (lane & 31)] = W[(size_t)(k0 + kk) * N + n0 + (lane & 31)]; }
    asm volatile("s_waitcnt lgkmcnt(0)" ::: "memory");
    const int c = lane & 7;
#pragma unroll
    for (int j = 0; j < 4; ++j) { const int n = (lane >> 3) + 8 * j; const LAS float* s = scr + (8 * c) * 33 + n;
        v4u o; o.x = cvt_pk_bf16(s[0 * 33], s[1 * 33]); o.y = cvt_pk_bf16(s[2 * 33], s[3 * 33]); o.z = cvt_pk_bf16(s[4 * 33], s[5 * 33]); o.w = cvt_pk_bf16(s[6 * 33], s[7 * 33]);
        *(v4u*)(WT + (size_t)(row_off + n0 + n) * ldd + k0 + 8 * c) = o; }
    asm volatile("s_waitcnt lgkmcnt(0)" ::: "memory");
}
__device__ __forceinline__ void cvt_job(const float* W, int K, int N, bf16_t* WT, int ldd, int row_off, LAS float* scr, int gw, int NW, int lane) {
    const int nblk = N / 32, nit = (K / 64) * nblk;
    for (int it = gw; it < nit; it += NW) p0_transpose_item(W, N, WT, ldd, row_off, scr, it, nblk, lane);
}
__device__ __forceinline__ void phase_convert(ArgsP a, LAS unsigned char* lds, const int tid, const int bx) {
    const int lane = tid & 63, wave = tid >> 6, G = gridDim.x;
    const int gw = bx * 8 + wave, NW = G * 8; const size_t gt = (size_t)bx * 512 + tid, NT = (size_t)G * 512;
    LAS float* scr = (LAS float*)(lds + wave * 8448);
    unsigned char* ws = a->ws;
    for (int l = 0; l < DEPTH; ++l) {
        bf16_t* win = (bf16_t*)(ws + WS_WIN) + (size_t)l * NZ * DM;
        cvt_job(a->in[I_W_IN] + (size_t)l * DM * INW, DM, INW, win, DM, 0, scr, gw, NW, lane);
        if (l > 0) cvt_job(a->in[I_W_VRES_DN] + (size_t)(l - 1) * DM * 32, DM, 32, win, DM, INW, scr, gw, NW, lane);
        { const int r0 = (l == 0) ? INW : INW + 32; const size_t n16 = (size_t)(NZ - r0) * DM / 8; v4u* z = (v4u*)(win + (size_t)r0 * DM);
          for (size_t i = gt; i < n16; i += NT) z[i] = (v4u){0u, 0u, 0u, 0u}; }
        cvt_job(a->in[I_W_OUT] + (size_t)l * DM * DM, DM, DM, (bf16_t*)(ws + WS_WOUT) + (size_t)l * DM * DM, DM, 0, scr, gw, NW, lane);
        cvt_job(a->in[I_W_FFN_UP] + (size_t)l * DM * DFF, DM, DFF, (bf16_t*)(ws + WS_WUP) + (size_t)l * DFF * DM, DM, 0, scr, gw, NW, lane);
        cvt_job(a->in[I_W_FFN_DOWN] + (size_t)l * DFF * DM, DFF, DM, (bf16_t*)(ws + WS_WDN) + (size_t)l * DM * DFF, DFF, 0, scr, gw, NW, lane);
        cvt_job(a->in[I_W_PLE_GATE] + (size_t)l * DM * DM, DM, DM, (bf16_t*)(ws + WS_WGATE) + (size_t)l * DM * DM, DM, 0, scr, gw, NW, lane);
        cvt_job(a->in[I_W_PLE_PROJ] + (size_t)l * DPLE * DM, DPLE, DM, (bf16_t*)(ws + WS_WPROJ) + (size_t)l * DM * DPLE, DPLE, 0, scr, gw, NW, lane);
        for (int gi = 0; gi < 4; ++gi)
            cvt_job(a->in[I_POOL_W] + ((size_t)l * 4 + gi) * 256 * 256, 256, 256, (bf16_t*)(ws + WS_WPOOL) + (size_t)l * 1024 * 256, 256, gi * 256, scr, gw, NW, lane);
        { bf16_t* wl = (bf16_t*)(ws + WS_WLORA) + (size_t)l * 4096 * KL;
          const float* wu = a->in[I_W_UP] + (size_t)l * 64 * RW; const float* au = a->in[I_A_UP] + (size_t)l * 64 * RW; const float* gu = a->in[I_G_UP] + (size_t)l * 160 * RW;
          const float* vu = a->in[I_V_UP] + (size_t)(l > 0 ? l - 1 : 0) * 32 * RW;
          for (size_t idx = gt; idx < (size_t)4096 * KL; idx += NT) { const int n = (int)(idx / KL), k = (int)(idx % KL), t = n >> 10, col = n & 1023; float v = 0.f;
              if (t == 0) { if (k < 64) v = wu[(size_t)k * RW + col]; }
              else if (t == 1) { if (k >= 64 && k < 128) v = au[(size_t)(k - 64) * RW + col]; }
              else if (t == 2) { if (k >= 128 && k < 288) v = gu[(size_t)(k - 128) * RW + col]; }
              else { if (l > 0 && k >= 288 && k < 320) v = vu[(size_t)(k - 288) * RW + col]; }
              wl[idx] = (bf16_t)(cvt_pk_bf16(v, 0.f) & 0xffffu); } }
    }
    { const float* p = a->in[I_P]; bf16_t* pb = (bf16_t*)(ws + WS_PB); const size_t n8 = (size_t)DEPTH * M * DPLE / 8;
      for (size_t i = gt; i < n8; i += NT) { const f32x8 v = ld8f(p + i * 8); *(v4u*)(pb + i * 8) = pk8(v); } }
}

__device__ __forceinline__ void phase_norm(const float* x, const float* g, bf16_t* H, float* outf, const int tid, const int bx) {
    const bool F32OUT = (outf != nullptr);
    const int lane = tid & 63, wave = tid >> 6; const int gw = bx * 8 + wave, NW = gridDim.x * 8;
    f32x4 gv[8];
#pragma unroll
    for (int j = 0; j < 8; ++j) gv[j] = ((const f32x4*)g)[lane + 64 * j];
    for (int row = gw; row < M; row += NW) {
        const f32x4* xr = (const f32x4*)(x + (size_t)row * DM) + lane;
        f32x4 v[8]; float s = 0.f;
#pragma unroll
        for (int j = 0; j < 8; ++j) { v[j] = xr[64 * j]; s += (v[j][0] * v[j][0] + v[j][1] * v[j][1]) + (v[j][2] * v[j][2] + v[j][3] * v[j][3]); }
        s = wave_sum(s);
        const float rs = rsqrtf(s * (1.0f / DM) + NORM_EPS);
#pragma unroll
        for (int j = 0; j < 8; ++j) { const f32x4 o = v[j] * rs * gv[j];
            if (F32OUT) ((f32x4*)(outf + (size_t)row * DM))[lane + 64 * j] = o;
            else { v2u w; w.x = cvt_pk_bf16(o[0], o[1]); w.y = cvt_pk_bf16(o[2], o[3]); ((v2u*)(H + (size_t)row * DM))[lane + 64 * j] = w; } }
    }
}

__device__ __forceinline__ void phase_prepa(ArgsP a, int l, const int tid, const int bx) {
    const int G = gridDim.x;
    const bf16_t* Z = (const bf16_t*)(a->ws + WS_Z); bf16_t* DP = (bf16_t*)(a->ws + WS_DPOOL); bf16_t* AL = (bf16_t*)(a->ws + WS_ALORA);
    const float* mus = a->in[I_MU_SHIFT] + (size_t)l * SHIFTW; const float* muv = a->in[I_MU_VRES] + (size_t)(l > 0 ? l - 1 : 0) * 32;
    const int rsub = tid >> 7, cgp = tid & 127;
    for (int unit = bx; unit < M / 4; unit += G) {
        const int row = unit * 4 + rsub, tpos = row & (SEQ - 1);
        { const int gi = cgp >> 5, win = 2 << gi, cnt = (tpos + 1 < win) ? tpos + 1 : win;
          const bf16_t* zp = Z + (size_t)row * NZ + 8 * cgp;
          const f32x8 u = up8(*(const v4u*)zp); f32x8 s = u;
          for (int q = 1; q < cnt; ++q) s = s + up8(*(const v4u*)(zp - (size_t)q * NZ));
          const f32x8 d = s * (1.0f / (float)cnt) - u;
          *(v4u*)(DP + (size_t)row * RW + 8 * cgp) = pk8(d); }
        if (cgp < KL / 8) {
            const int c = 8 * cgp; f32x8 o;
#pragma unroll
            for (int j = 0; j < 8; ++j) o[j] = 0.f;
            if (c < 288 || (c < 320 && l > 0)) {
                const bf16_t* zp = Z + (size_t)row * NZ + 4096 + c;
                const f32x8 zc = up8(*(const v4u*)zp); f32x8 zq;
                if (tpos > 0) zq = up8(*(const v4u*)(zp - NZ)); else {
#pragma unroll
                    for (int j = 0; j < 8; ++j) zq[j] = 0.f; }
                const f32x8 mu = (c < 288) ? ld8f(mus + 3072 + c) : ld8f(muv + (c - 288));
                const f32x8 zs = zc + (zq - zc) * mu;
                if (c < 64) {
#pragma unroll
                    for (int j = 0; j < 8; ++j) o[j] = 1.0f - 2.0f * __builtin_amdgcn_rcpf(1.0f + __expf(2.0f * zs[j])); }
                else if (c >= 128 && c < 288) {
#pragma unroll
                    for (int j = 0; j < 8; ++j) o[j] = sigm(zs[j]); }
                else o = zs;
            }
            *(v4u*)(AL + (size_t)row * KL + c) = pk8(o);
        }
    }
}

constexpr int TC = 32, STEPB = 1344, BUFB = TC * STEPB, YBB = TC * 16 * 4;
struct ScanRaw { v4u zr, zrp, zk, zkp, zv, zvp, ld, aa, vg, vf; };
__device__ __forceinline__ void scan_unit(ArgsP a, int l, int u, LAS unsigned char* lds, const int tid) {
    const int wave = __builtin_amdgcn_readfirstlane(tid >> 6), lane = tid & 63;
    const int bh = u >> 2, rg = u & 3, b = bh >> 4, h = bh & 15;
    const bool hasv = l > 0;
    constexpr int NC = SEQ / TC;
    const size_t rowbase = (size_t)b * SEQ;
    if (wave < 4) {
        const int rowl = 4 * wave + (lane >> 4), j = lane & 15;
        f32x2 s01 = {0.f, 0.f}, s23 = {0.f, 0.f};
        for (int c = 0; c < NC; ++c) {
            __syncthreads();
            const LAS unsigned char* buf = lds + (c & 1) * BUFB + 16 * j;
            const LAS unsigned char* vb = lds + (c & 1) * BUFB + 1280 + 4 * rowl;
            LAS float* yb = (LAS float*)(lds + 2 * BUFB + (c & 1) * YBB) + rowl + (15 - j) * 16;
            f32x4 R[3], W[3], K[3], A[3], B[3]; float V[3];
#define SC_LD(sl, tl) do { R[sl] = *(const LAS f32x4*)(buf + (tl) * STEPB); W[sl] = *(const LAS f32x4*)(buf + (tl) * STEPB + 256); K[sl] = *(const LAS f32x4*)(buf + (tl) * STEPB + 512); \
                A[sl] = *(const LAS f32x4*)(buf + (tl) * STEPB + 768); B[sl] = *(const LAS f32x4*)(buf + (tl) * STEPB + 1024); V[sl] = *(const LAS float*)(vb + (tl) * STEPB); } while (0)
            SC_LD(0, 0); SC_LD(1, 1);
            float yprev = 0.f, ysel = 0.f;
#pragma unroll
            for (int i = 0; i < TC; ++i) {
                const int sl = i % 3;
                if (i + 2 < TC) SC_LD((i + 2) % 3, i + 2);
                const f32x2 vv = {V[sl], V[sl]};
                f32x2 pp = s01 * (f32x2){A[sl][0], A[sl][1]}; pp = s23 * (f32x2){A[sl][2], A[sl][3]} + pp;
                float p = pp[0] + pp[1];
                f32x2 t01 = vv * (f32x2){K[sl][0], K[sl][1]}, t23 = vv * (f32x2){K[sl][2], K[sl][3]};
                t01 = s01 * (f32x2){W[sl][0], W[sl][1]} + t01; t23 = s23 * (f32x2){W[sl][2], W[sl][3]} + t23;
                if (i > 0) {
                    p += dpp1<0x128>(p); yprev += dpp1<0x128>(yprev);
                    p += dpp1<0x124>(p); yprev += dpp1<0x124>(yprev);
                    p += dpp1<0x122>(p); yprev += dpp1<0x122>(yprev);
                    p += dpp1<0x121>(p); yprev += dpp1<0x121>(yprev);
                    ysel = __builtin_bit_cast(float, __builtin_amdgcn_update_dpp(__builtin_bit_cast(int, yprev), __builtin_bit_cast(int, ysel), 0x111, 0xF, 0xF, false));
                    if ((i & 15) == 0) yb[((i >> 4) - 1) * 256] = ysel;
                } else {
                    p += dpp1<0x128>(p); p += dpp1<0x124>(p); p += dpp1<0x122>(p); p += dpp1<0x121>(p);
                }
                const f32x2 pv = {p, p};
                s01 = pv * (f32x2){B[sl][0], B[sl][1]} + t01; s23 = pv * (f32x2){B[sl][2], B[sl][3]} + t23;
                f32x2 yy = s01 * (f32x2){R[sl][0], R[sl][1]}; yy = s23 * (f32x2){R[sl][2], R[sl][3]} + yy;
                yprev = yy[0] + yy[1];
            }
            yprev += dpp1<0x128>(yprev); yprev += dpp1<0x124>(yprev); yprev += dpp1<0x122>(yprev); yprev += dpp1<0x121>(yprev);
            ysel = __builtin_bit_cast(float, __builtin_amdgcn_update_dpp(__builtin_bit_cast(int, yprev), __builtin_bit_cast(int, ysel), 0x111, 0xF, 0xF, false));
            yb[(TC / 16 - 1) * 256] = ysel;
#undef SC_LD
        }
        __syncthreads();
    } else {
        const int ltid = tid - 256, tl = ltid >> 3, cgp = ltid & 7;
        const int col0 = h * HS + 8 * cgp;
        const bf16_t* Z = (const bf16_t*)(a->ws + WS_Z); const bf16_t* PL = (const bf16_t*)(a->ws + WS_PLANES); const bf16_t* VF = (const bf16_t*)(a->ws + WS_VFIRST);
        bf16_t* Y = (bf16_t*)(a->ws + WS_DPOOL);
        const float* mus = a->in[I_MU_SHIFT] + (size_t)l * SHIFTW;
        const f32x8 mur = ld8f(mus + col0), muk = ld8f(mus + 1024 + col0), muv = ld8f(mus + 2048 + col0);
        const f32x8 kkc = ld8f(a->in[I_K_K] + (size_t)l * RW + col0), kac = ld8f(a->in[I_K_A] + (size_t)l * RW + col0);
        const bool vmine = (cgp >> 1) == rg;
#define SCAN_LOAD(R, cc) do { const int t_ = (cc) * TC + tl; const size_t row_ = rowbase + t_; const size_t rowp_ = (t_ > 0) ? row_ - 1 : row_; \
            const bf16_t* z_ = Z + row_ * NZ + col0; const bf16_t* zq_ = Z + rowp_ * NZ + col0; \
            R.zr = *(const v4u*)(z_ + 1024); R.zk = *(const v4u*)(z_ + 2048); R.zv = *(const v4u*)(z_ + 3072); \
            R.zrp = *(const v4u*)(zq_ + 1024); R.zkp = *(const v4u*)(zq_ + 2048); R.zvp = *(const v4u*)(zq_ + 3072); \
            R.ld = *(const v4u*)(PL + row_ * RW + col0); R.aa = *(const v4u*)(PL + PLANE + row_ * RW + col0); \
            if (hasv) { R.vg = *(const v4u*)(PL + 3 * PLANE + row_ * RW + col0); R.vf = *(const v4u*)(VF + row_ * RW + col0); } else { R.vg = R.ld; R.vf = R.ld; } } while (0)
#define SCAN_FLUSH(cc) do { const LAS float* yb_ = (const LAS float*)(lds + 2 * BUFB + ((cc) & 1) * YBB) + tl * 16 + 2 * cgp; \
            const unsigned w_ = cvt_pk_bf16(yb_[0], yb_[1]); *(unsigned*)(Y + (rowbase + (size_t)(cc) * TC + tl) * RW + h * HS + 16 * rg + 2 * cgp) = w_; } while (0)
        ScanRaw nx; SCAN_LOAD(nx, 0);
        for (int c = 0; c < NC; ++c) {
            const ScanRaw cu = nx;
            if (c + 1 < NC) SCAN_LOAD(nx, c + 1);
            const int t = c * TC + tl;
            const f32x8 zr = up8(cu.zr), zk = up8(cu.zk), zv = up8(cu.zv);
            f32x8 zrp = up8(cu.zrp), zkp = up8(cu.zkp), zvp = up8(cu.zvp);
            if (t == 0) {
#pragma unroll
                for (int q = 0; q < 8; ++q) { zrp[q] = 0.f; zkp[q] = 0.f; zvp[q] = 0.f; } }
            const f32x8 r = zr + (zrp - zr) * mur, k = zk + (zkp - zk) * muk; f32x8 v = zv + (zvp - zv) * muv;
            const f32x8 ld = up8(cu.ld), av = up8(cu.aa);
            if (hasv) v = v + (up8(cu.vf) - v) * up8(cu.vg);
            const f32x8 kk = k * kkc;
            float n2 = sum8(kk * kk); n2 += __shfl_xor(n2, 1); n2 += __shfl_xor(n2, 2); n2 += __shfl_xor(n2, 4);
            const float inv = 1.0f / fmaxf(sqrtf(n2), 1e-12f);
            const f32x8 kkn = kk * inv;
            const f32x8 kadj = k * (1.0f + (av - 1.0f) * kac);
            f32x8 dec;
#pragma unroll
            for (int q = 0; q < 8; ++q) dec[q] = __expf(ld[q]);
            const f32x8 avec = -kkn, bvec = kkn * av;
            LAS unsigned char* dst = lds + (c & 1) * BUFB + tl * STEPB + cgp * 32;
#define ST8(off, val) do { *(LAS f32x4*)(dst + (off)) = (f32x4){val[0], val[1], val[2], val[3]}; *(LAS f32x4*)(dst + (off) + 16) = (f32x4){val[4], val[5], val[6], val[7]}; } while (0)
            ST8(0, r); ST8(256, dec); ST8(512, kadj); ST8(768, avec); ST8(1024, bvec);
            if (vmine) { LAS unsigned char* dv = lds + (c & 1) * BUFB + tl * STEPB + 1280 + (cgp & 1) * 32;
                *(LAS f32x4*)(dv) = (f32x4){v[0], v[1], v[2], v[3]}; *(LAS f32x4*)(dv + 16) = (f32x4){v[4], v[5], v[6], v[7]}; }
#undef ST8
            if (c >= 2) SCAN_FLUSH(c - 2);
            __syncthreads();
        }
        __syncthreads();
        SCAN_FLUSH(NC - 2); SCAN_FLUSH(NC - 1);
#undef SCAN_LOAD
#undef SCAN_FLUSH
    }
    __syncthreads();
}

__device__ __forceinline__ void phase_post(ArgsP a, int l, const int tid, const int bx) {
    const int lane = tid & 63, wave = tid >> 6; const int gw = bx * 8 + wave, NW = gridDim.x * 8;
    const bf16_t* Z = (const bf16_t*)(a->ws + WS_Z); const bf16_t* PL = (const bf16_t*)(a->ws + WS_PLANES); bf16_t* VF = (bf16_t*)(a->ws + WS_VFIRST);
    const bf16_t* Y = (const bf16_t*)(a->ws + WS_DPOOL); bf16_t* MIX = (bf16_t*)(a->ws + WS_MIX);
    const float* mus = a->in[I_MU_SHIFT] + (size_t)l * SHIFTW;
    const bool hasv = l > 0;
    for (int it = gw; it < M * 2; it += NW) {
        const int row = it >> 1, h = (it & 1) * 8 + (lane >> 3), col = h * HS + 8 * (lane & 7), tpos = row & (SEQ - 1);
        const bf16_t* z = Z + (size_t)row * NZ + col; const bf16_t* zq = (tpos > 0) ? z - NZ : z;
        const f32x8 zr = up8(*(const v4u*)(z + 1024)), zk = up8(*(const v4u*)(z + 2048)), zv = up8(*(const v4u*)(z + 3072));
        f32x8 zrp = up8(*(const v4u*)(zq + 1024)), zkp = up8(*(const v4u*)(zq + 2048)), zvp = up8(*(const v4u*)(zq + 3072));
        if (tpos == 0) {
#pragma unroll
            for (int q = 0; q < 8; ++q) { zrp[q] = 0.f; zkp[q] = 0.f; zvp[q] = 0.f; } }
        const f32x8 r = zr + (zrp - zr) * ld8f(mus + col), k = zk + (zkp - zk) * ld8f(mus + 1024 + col); f32x8 v = zv + (zvp - zv) * ld8f(mus + 2048 + col);
        const size_t po = (size_t)row * RW + col;
        const f32x8 av = up8(*(const v4u*)(PL + PLANE + po)), gg = up8(*(const v4u*)(PL + 2 * PLANE + po));
        if (hasv) v = v + (up8(*(const v4u*)(VF + po)) - v) * up8(*(const v4u*)(PL + 3 * PLANE + po));
        else *(v4u*)(VF + po) = pk8(v);
        const f32x8 kadj = k * (1.0f + (av - 1.0f) * ld8f(a->in[I_K_A] + (size_t)l * RW + col));
        float bonus = sum8(r * kadj * ld8f(a->in[I_R_K] + (size_t)l * RW + col));
        bonus += __shfl_xor(bonus, 1); bonus += __shfl_xor(bonus, 2); bonus += __shfl_xor(bonus, 4);
        const f32x8 y = up8(*(const v4u*)(Y + po));
        float sm = sum8(y); sm += __shfl_xor(sm, 1); sm += __shfl_xor(sm, 2); sm += __shfl_xor(sm, 4);
        const float mean = sm * (1.0f / 64.0f);
        const f32x8 d = y - mean;
        float vs = sum8(d * d); vs += __shfl_xor(vs, 1); vs += __shfl_xor(vs, 2); vs += __shfl_xor(vs, 4);
        const float rstd = rsqrtf(vs * (1.0f / 64.0f) + GN_EPS);
        const f32x8 o = (d * rstd * ld8f(a->in[I_GN_G] + (size_t)l * RW + col) + ld8f(a->in[I_GN_B] + (size_t)l * RW + col) + bonus * v) * gg;
        *(v4u*)(MIX + (size_t)row * DM + 1024 + col) = pk8(o);
    }
}

#define XB_TMO      128
#define XB_XCNT(j)  (256  + 64 * (j))
#define XB_XSUB(j)  (1280 + 64 * (j))
#define XB_XGEN(j)  (2304 + 64 * (j))
#define XB_TOP      3328
#define XB_TOPGEN   3392
#define XCD_BAR_WORDS 3456
#define XB_SPIN_CAP (1u << 18)

__device__ __forceinline__ unsigned xb_ld(unsigned* p)              { return __hip_atomic_load(p, __ATOMIC_RELAXED, __HIP_MEMORY_SCOPE_AGENT); }
__device__ __forceinline__ unsigned xb_add(unsigned* p, unsigned v) { return __hip_atomic_fetch_add(p, v, __ATOMIC_RELAXED, __HIP_MEMORY_SCOPE_AGENT); }
__device__ __forceinline__ unsigned xb_xcc_id() { return (unsigned)__builtin_amdgcn_s_getreg((3 << 11) | 20) & 0xFu; }
#define XB_SPIN(cond, bar) do { unsigned _sp = 0; while (cond) { __builtin_amdgcn_s_sleep(1); \
    if ((++_sp & 255u) == 0u) { if (xb_ld(&(bar)[XB_TMO])) break; if (_sp > XB_SPIN_CAP) { atomicAdd(&(bar)[XB_TMO], 1u); break; } } } } while (0)

struct XcdBarrier {
    unsigned* bar; unsigned x;
    volatile LAS unsigned* st;
};

__device__ __forceinline__ XcdBarrier xcd_barrier_post(unsigned* bar, volatile LAS unsigned* st) {
    XcdBarrier b; b.bar = bar; b.x = xb_xcc_id(); b.st = st;
    if (threadIdx.x == 0) (void)xb_add(&bar[XB_XCNT(b.x)], 1u);
    return b;
}
__device__ __forceinline__ void xcd_barrier_complete(unsigned* bar, unsigned x, unsigned& nloc, unsigned& nx) {
    const unsigned G = gridDim.x * gridDim.y * gridDim.z;
    unsigned sum, cnt, mine, sp = 0u;
    for (;;) {
        sum = 0u; cnt = 0u; mine = 0u;
#pragma unroll
        for (unsigned j = 0; j < 16; ++j) { const unsigned c = xb_ld(&bar[XB_XCNT(j)]); sum += c; cnt += (c > 0u) ? 1u : 0u; mine = (j == x) ? c : mine; }
        if (sum == G) break;
        __builtin_amdgcn_s_sleep(1);
        if ((++sp & 255u) == 0u) { if (xb_ld(&bar[XB_TMO])) break; if (sp > XB_SPIN_CAP) { atomicAdd(&bar[XB_TMO], 1u); break; } }
    }
    nloc = mine > 0u ? mine : 1u; nx = cnt > 0u ? cnt : 1u;
}

__device__ __forceinline__ void xcd_barrier(const XcdBarrier& b) {
    asm volatile("s_waitcnt vmcnt(0)" ::: "memory");
    __syncthreads();
    if (threadIdx.x == 0) {
        unsigned* bar = b.bar;
        __builtin_amdgcn_s_waitcnt(0);
        unsigned nloc = b.st[0], nx = b.st[1];
        if (nloc == 0u) { xcd_barrier_complete(bar, b.x, nloc, nx); b.st[0] = nloc; b.st[1] = nx; }
        const unsigned old = xb_add(&bar[XB_XSUB(b.x)], 1u);
        const unsigned gen = old / nloc;
        if (old + 1u == (gen + 1u) * nloc) {
            __builtin_amdgcn_fence(__ATOMIC_RELEASE, "agent");
            asm volatile("s_waitcnt vmcnt(0)" ::: "memory");
            const unsigned og = xb_add(&bar[XB_TOP], 1u);
            const unsigned tg = og / nx;
            if (og + 1u == (tg + 1u) * nx) xb_add(&bar[XB_TOPGEN], 1u);
            else XB_SPIN(xb_ld(&bar[XB_TOPGEN]) == tg, bar);
            __builtin_amdgcn_fence(__ATOMIC_ACQUIRE, "agent");
            xb_add(&bar[XB_XGEN(b.x)], 1u);
            asm volatile("s_waitcnt vmcnt(0)" ::: "memory");
        } else {
            XB_SPIN(xb_ld(&bar[XB_XGEN(b.x)]) == gen, bar);
            __builtin_amdgcn_fence(__ATOMIC_ACQUIRE, "agent");
            asm volatile("s_waitcnt vmcnt(0)" ::: "memory");
        }
    }
    __syncthreads();
}


constexpr int N_PHASES = 2 + 12 * DEPTH;
__device__ __forceinline__ bool make_job(ArgsP a, int l, int s, int q, pg8::Job& J) {
    unsigned char* ws = a->ws; float* X = a->out;
    bf16_t* H = (bf16_t*)(ws + WS_H); bf16_t* MIX = (bf16_t*)(ws + WS_MIX); bf16_t* PP = (bf16_t*)(ws + WS_MIX);
    J.a_pn_step = 0; J.nM = M / 256; J.O = nullptr; J.ldc = DM; J.c0 = nullptr; J.c1 = nullptr; J.c2 = nullptr; J.base = nullptr; J.out = nullptr; J.pp = nullptr;
    if (s == 1 && q == 0) { J.A = H; J.Bt = (const bf16_t*)(ws + WS_WIN) + (size_t)l * NZ * DM; J.lda = DM; J.ldb = DM; J.K = DM; J.nN = NZ / 256; J.mode = 0; J.O = (bf16_t*)(ws + WS_Z); J.ldc = NZ; return true; }
    if (s == 3 && q == 0) { J.A = (const bf16_t*)(ws + WS_ALORA); J.Bt = (const bf16_t*)(ws + WS_WLORA) + (size_t)l * 4096 * KL; J.lda = KL; J.ldb = KL; J.K = KL; J.nN = 16; J.mode = 3; J.O = (bf16_t*)(ws + WS_PLANES); J.ldc = RW;
                            J.c0 = a->in[I_W0] + (size_t)l * RW; J.c1 = a->in[I_A0] + (size_t)l * RW; J.c2 = (l > 0) ? a->in[I_V0] + (size_t)(l - 1) * RW : nullptr; return true; }
    if (s == 3 && q == 1) { J.A = (const bf16_t*)(ws + WS_DPOOL); J.Bt = (const bf16_t*)(ws + WS_WPOOL) + (size_t)l * 1024 * 256; J.lda = RW; J.ldb = 256; J.K = 256; J.a_pn_step = 256; J.nN = 4; J.mode = 2; J.O = MIX; J.ldc = DM;
                            J.c0 = a->in[I_POOL_SCALE] + (size_t)l * 1024; return true; }
    if (s == 6 && q == 0) { J.A = MIX; J.Bt = (const bf16_t*)(ws + WS_WOUT) + (size_t)l * DM * DM; J.lda = DM; J.ldb = DM; J.K = DM; J.nN = DM / 256; J.mode = 4; J.base = (l == 0) ? a->in[I_X] : X; J.out = X; return true; }
    if (s == 8 && q == 0) { J.A = H; J.Bt = (const bf16_t*)(ws + WS_WUP) + (size_t)l * DFF * DM; J.lda = DM; J.ldb = DM; J.K = DM; J.nN = DFF / 256; J.mode = 1; J.O = (bf16_t*)(ws + WS_U); J.ldc = DFF; return true; }
    if (s == 8 && q == 1) { J.A = (const bf16_t*)(ws + WS_PB) + (size_t)l * M * DPLE; J.Bt = (const bf16_t*)(ws + WS_WPROJ) + (size_t)l * DM * DPLE; J.lda = DPLE; J.ldb = DPLE; J.K = DPLE; J.nN = DM / 256; J.mode = 0; J.O = PP; J.ldc = DM; return true; }
    if (s == 9 && q == 0) { J.A = (const bf16_t*)(ws + WS_U); J.Bt = (const bf16_t*)(ws + WS_WDN) + (size_t)l * DM * DFF; J.lda = DFF; J.ldb = DFF; J.K = DFF; J.nN = DM / 256; J.mode = 4; J.base = X; J.out = X; return true; }
    if (s == 11 && q == 0) { J.A = H; J.Bt = (const bf16_t*)(ws + WS_WGATE) + (size_t)l * DM * DM; J.lda = DM; J.ldb = DM; J.K = DM; J.nN = DM / 256; J.mode = 5; J.base = X; J.out = X; J.pp = PP; return true; }
    return false;
}
__global__ void __launch_bounds__(512, 2) fwd_megakernel(Args a_byval) {
    ArgsP a = (ArgsP)__builtin_amdgcn_kernarg_segment_ptr();
    extern __shared__ __attribute__((aligned(16))) unsigned char lds_raw[];
    LAS unsigned char* lds = (LAS unsigned char*)lds_raw;
    cg::grid_group grid = cg::this_grid();
    const int G = gridDim.x;
    if (threadIdx.x < 16) ((LAS unsigned*)(lds + BAR_LDS_OFF))[threadIdx.x] = 0u;
    __syncthreads();
    XcdBarrier xbar = xcd_barrier_post((unsigned*)a->ws, (volatile LAS unsigned*)(lds + BAR_LDS_OFF));
    const int ph_lo = a->ph_lo, ph_hi = a->ph_hi;
    for (int ph = ph_lo; ph < ph_hi; ++ph) {
        if (ph > ph_lo) { if (ph == ph_lo + 1) grid.sync(); else xcd_barrier(xbar); }
        asm volatile("" : "+s"(a) :: "memory");
        int tid = threadIdx.x, bx = blockIdx.x; asm volatile("" : "+v"(tid), "+s"(bx));
        float* X = a->out;
        const bool fin = (ph == N_PHASES - 1);
        const int l = (fin || ph == 0) ? 0 : (ph - 1) / 12, s = (ph == 0) ? 13 : fin ? 12 : (ph - 1) % 12;
        int nrep = 1;
        if (PROBE_REP & 1) { if (s == 4) nrep = 2; }
        if (PROBE_REP & 2) { if (s == 1 || s == 3 || s == 8) nrep = 2; }
        if (PROBE_REP & 4) { if (s == 0 || s == 7 || s == 10 || s == 2 || s == 5) nrep = 2; }
        if (PROBE_REP & 8) { if (s == 13) nrep = 2; }
        if (PROBE_REP & 16) { if (ph > ph_lo) xcd_barrier(xbar); }
        for (int rep = 0; rep < nrep; ++rep) {
        if (rep) __syncthreads();
        asm volatile("" : "+v"(tid), "+s"(bx), "+s"(a) :: "memory");
        if (s == 13) { phase_convert(a, lds, tid, bx); }
        else if (s == 0 || s == 7 || s == 10 || s == 12) {
            const float* xs = (s == 0 && l == 0) ? a->in[I_X] : X;
            const float* gp = (s == 0) ? a->in[I_ATTN_NORM] + (size_t)l * DM : (s == 7) ? a->in[I_MLP_NORM] + (size_t)l * DM : (s == 10) ? a->in[I_PLE_NORM] + (size_t)l * DM : a->in[I_FINAL_NORM];
            phase_norm(xs, gp, (bf16_t*)(a->ws + WS_H), fin ? X : nullptr, tid, bx);
        } else if (s == 2) { phase_prepa(a, l, tid, bx); }
        else if (s == 4) { const int vcu = (G % 8 == 0) ? (bx % 8) * (G / 8) + bx / 8 : bx; for (int u = vcu; u < 256; u += G) scan_unit(a, l, u, lds, tid); }
        else if (s == 5) { phase_post(a, l, tid, bx); }
        else {
            for (int q = 0; q < 2; ++q) { pg8::Job J; if (!make_job(a, l, s, q, J)) break;
                pg8::StaticOrder S; S.init(J.nM, J.nN, G, bx); pg8::gemm_phase(lds, J, S, tid); }
        }
        }
    }
}

extern "C" void kernel_launch(void* const* d_in, const int* in_sizes, int n_in, void* d_out, int out_size, void* d_ws, size_t ws_size, hipStream_t stream) {
    static int grid = 0;
    if (grid == 0) {
        if (n_in != 29 || in_sizes[0] != M * DM || out_size != M * DM || ws_size < WS_END) {
            fprintf(stderr, "kernel_launch: unexpected shapes: n_in %d in0 %d out %d ws %zu (need %zu); nothing launched\n", n_in, n_in > 0 ? in_sizes[0] : -1, out_size, ws_size, (size_t)WS_END); grid = -1; return; }
        int dev = 0, cus = 0, per_cu = 0;
        if (hipGetDevice(&dev) != hipSuccess || hipDeviceGetAttribute(&cus, hipDeviceAttributeMultiprocessorCount, dev) != hipSuccess) { fprintf(stderr, "kernel_launch: device query failed\n"); grid = -1; return; }
        if (hipFuncSetAttribute((const void*)fwd_megakernel, hipFuncAttributeMaxDynamicSharedMemorySize, LDS_BYTES) != hipSuccess) { fprintf(stderr, "kernel_launch: hipFuncSetAttribute failed\n"); grid = -1; return; }
        if (hipOccupancyMaxActiveBlocksPerMultiprocessor(&per_cu, (const void*)fwd_megakernel, 512, LDS_BYTES) != hipSuccess || per_cu < 1) {
            fprintf(stderr, "kernel_launch: occupancy query says %d blocks/CU; using 1\n", per_cu); per_cu = 1; }
        (void)hipGetLastError();
        grid = cus * 1;
        if (grid > 256) grid = 256;
    }
    if (grid < 0) return;
    Args a{};
    for (int i = 0; i < 29; ++i) a.in[i] = (const float*)d_in[i];
    a.out = (float*)d_out; a.ws = (unsigned char*)d_ws;
    if (hipMemsetAsync(d_ws, 0, 65536, stream) != hipSuccess) { fprintf(stderr, "kernel_launch: memset of barrier words failed\n"); return; }
#if MK_PER_PHASE_LAUNCH
    for (int ph = 0; ph < N_PHASES; ++ph) {
        a.ph_lo = ph; a.ph_hi = ph + 1;
        hipLaunchKernelGGL(fwd_megakernel, dim3(grid), dim3(512), LDS_BYTES, stream, a);
    }
#else
    a.ph_lo = 0; a.ph_hi = N_PHASES;
    void* args[] = {&a};
    hipError_t e = hipLaunchCooperativeKernel((const void*)fwd_megakernel, dim3(grid), dim3(512), args, LDS_BYTES, stream);
    if (e != hipSuccess) fprintf(stderr, "cooperative launch failed: %s (grid %d)\n", hipGetErrorString(e), grid);
#endif
}
```

```cpp
#include <hip/hip_runtime.h>
#include <hip/hip_cooperative_groups.h>
#include <cstdio>
#include <cstdint>
namespace cg = cooperative_groups;

#ifndef MK_PER_PHASE_LAUNCH
#define MK_PER_PHASE_LAUNCH 0
#endif

#ifndef PROBE_REP
#define PROBE_REP 0
#endif
#define LAS __attribute__((address_space(3)))
typedef unsigned short bf16_t;
typedef short bf16x8 __attribute__((ext_vector_type(8)));
typedef float f32x4 __attribute__((ext_vector_type(4)));
typedef float f32x8 __attribute__((ext_vector_type(8)));
typedef float f32x2 __attribute__((ext_vector_type(2)));
typedef unsigned v4u __attribute__((ext_vector_type(4)));
typedef unsigned v2u __attribute__((ext_vector_type(2)));

constexpr int BATCH = 4, SEQ = 4096, DM = 2048, DEPTH = 4, M = BATCH * SEQ;
constexpr int RW = 1024, HS = 64, NH = 16, DFF = 8192, DPLE = 256;
constexpr int INW = 4384, NZ = 4608, SHIFTW = 3360, KL = 384;
constexpr float NORM_EPS = 1e-6f, GN_EPS = 64e-5f;

constexpr size_t MiB = 1u << 20;
constexpr size_t WS_WIN = 1 * MiB, WS_WOUT = 73 * MiB, WS_WUP = 105 * MiB, WS_WDN = 233 * MiB, WS_WGATE = 361 * MiB, WS_WPROJ = 393 * MiB,
                 WS_WLORA = 397 * MiB, WS_WPOOL = 409 * MiB, WS_PB = 411 * MiB, WS_H = 443 * MiB, WS_MIX = 507 * MiB  ,
                 WS_DPOOL = 571 * MiB  , WS_ALORA = 603 * MiB, WS_VFIRST = 615 * MiB, WS_Z = 647 * MiB, WS_PLANES = 791 * MiB,
                 WS_U = 647 * MiB  , WS_END = 919 * MiB;
constexpr size_t PLANE = (size_t)M * RW;

constexpr int LDS_BYTES = 135168, BAR_LDS_OFF = 131072 + 256;

__device__ __forceinline__ unsigned cvt_pk_bf16(float lo, float hi) { unsigned r; asm volatile("v_cvt_pk_bf16_f32 %0, %1, %2" : "=v"(r) : "v"(lo), "v"(hi)); return r; }
__device__ __forceinline__ float bf2f(unsigned h) { return __uint_as_float(h << 16); }
__device__ __forceinline__ f32x8 up8(v4u p) {
    f32x8 r;
    r[0] = __uint_as_float(p.x << 16); r[1] = __uint_as_float(p.x & 0xffff0000u);
    r[2] = __uint_as_float(p.y << 16); r[3] = __uint_as_float(p.y & 0xffff0000u);
    r[4] = __uint_as_float(p.z << 16); r[5] = __uint_as_float(p.z & 0xffff0000u);
    r[6] = __uint_as_float(p.w << 16); r[7] = __uint_as_float(p.w & 0xffff0000u);
    return r;
}
__device__ __forceinline__ v4u pk8(f32x8 v) { v4u o; o.x = cvt_pk_bf16(v[0], v[1]); o.y = cvt_pk_bf16(v[2], v[3]); o.z = cvt_pk_bf16(v[4], v[5]); o.w = cvt_pk_bf16(v[6], v[7]); return o; }
__device__ __forceinline__ f32x8 ld8f(const float* p) { const f32x4 a = *(const f32x4*)p, b = *(const f32x4*)(p + 4); f32x8 r; r[0] = a[0]; r[1] = a[1]; r[2] = a[2]; r[3] = a[3]; r[4] = b[0]; r[5] = b[1]; r[6] = b[2]; r[7] = b[3]; return r; }
__device__ __forceinline__ float sigm(float x) { return __builtin_amdgcn_rcpf(1.0f + __expf(-x)); }
__device__ __forceinline__ float wave_sum(float v) {
#pragma unroll
    for (int o = 1; o < 64; o <<= 1) v += __shfl_xor(v, o);
    return v;
}
__device__ __forceinline__ float sum8(f32x8 v) { return ((v[0] + v[1]) + (v[2] + v[3])) + ((v[4] + v[5]) + (v[6] + v[7])); }
template <int CTRL> __device__ __forceinline__ float dpp1(float x) { const int xi = __builtin_bit_cast(int, x); return __builtin_bit_cast(float, __builtin_amdgcn_update_dpp(0, xi, CTRL, 0xF, 0xF, true)); }
template <int CTRL> __device__ __forceinline__ float dpp_mov(float x) { const int xi = __builtin_bit_cast(int, x); return __builtin_bit_cast(float, __builtin_amdgcn_update_dpp(xi, xi, CTRL, 0xF, 0xF, false)); }
__device__ __forceinline__ float allreduce16(float x) {
    x += dpp_mov<0x128>(x); x += dpp_mov<0x124>(x); x += dpp_mov<0x122>(x); x += dpp_mov<0x121>(x); return x;
}

namespace pg8 {
constexpr int BM = 256, BK = 64, HALF = 128, HTB = HALF * BK * 2, STAGE_BYTES = 8 * HTB, NXCD = 8, WGM = 8;
__host__ __device__ __forceinline__ int lds_byte(int r, int c) { const int st = (r >> 4) * 2 + (c >> 5), rr = r & 15, cc = c & 31, ob = rr * 64 + cc * 2; return st * 1024 + (ob ^ (((ob >> 9) & 1) << 5)); }
__host__ __device__ __forceinline__ void stage_rc(int b, int& R, int& C) { const int st = b / 1024, sb = b % 1024, swz = sb ^ (((sb >> 9) & 1) << 5); R = (st >> 1) * 16 + swz / 64; C = (st & 1) * 32 + (swz % 64) / 2; }
__host__ __device__ __forceinline__ int perm32(int rho) { const int n = rho >> 4, i = rho & 15; return 8 * (i >> 2) + 4 * n + (i & 3); }

struct Unit { int pm, pn; };

struct StaticOrder {
    int nM, nN, nwg, G, c;
    __device__ void init(int nM_, int nN_, int G_, int c_) { nM = nM_; nN = nN_; nwg = nM * nN; G = G_; c = c_; }
    __device__ bool next(int i, Unit& u) const {
        const long L = (long)i * G + c; if (L >= nwg) return false;
        int wgid = (int)L; { const int q = nwg / NXCD, r = nwg % NXCD, xcd = wgid % NXCD, off = wgid / NXCD; wgid = (xcd < r ? xcd * (q + 1) : r * (q + 1) + (xcd - r) * q) + off; }
        const int nig = WGM * nN, gid = wgid / nig, fm = gid * WGM, gsz = (nM - fm) < WGM ? (nM - fm) : WGM;
        u.pm = fm + ((wgid % nig) % gsz); u.pn = (wgid % nig) / gsz; return true;
    }
};

template <int MODE> struct EpiB {
    static constexpr bool PERM = true;
    bf16_t* O; int ldc; const float* c0; const float* c1; const float* c2; size_t plane;
    __device__ __forceinline__ void operator()(const f32x4 (&acc)[2][2][4][2], const Unit& u, int wr, int wc, int fr, int fq) const {
        const int row0 = u.pm * BM + wr * 64 + fr; int colt = u.pn * BM; bf16_t* base = O; int t = 0;
        if (MODE == 3) { t = colt >> 10; base += (size_t)t * plane; colt &= 1023; }
        const int col0 = colt + wc * 32 + 8 * fq;
        f32x4 cv[2][2];
#pragma unroll
        for (int bj = 0; bj < 2; ++bj)
#pragma unroll
            for (int n = 0; n < 2; ++n) {
                cv[bj][n] = (f32x4){0.f, 0.f, 0.f, 0.f};
                if (MODE == 2) cv[bj][n] = *(const f32x4*)(c0 + col0 + bj * HALF + 4 * n);
                if (MODE == 3) { const float* b = (t == 0) ? c0 : (t == 1) ? c1 : (t == 3) ? c2 : nullptr; if (b) cv[bj][n] = *(const f32x4*)(b + col0 + bj * HALF + 4 * n); }
            }
#pragma unroll
        for (int ai = 0; ai < 2; ++ai)
#pragma unroll
            for (int m = 0; m < 4; ++m) { bf16_t* rowp = base + (size_t)(row0 + ai * HALF + m * 16) * ldc + col0;
#pragma unroll
                for (int bj = 0; bj < 2; ++bj) { f32x4 v0 = acc[ai][bj][m][0], v1 = acc[ai][bj][m][1];
                    if (MODE == 1) {
#pragma unroll
                        for (int j = 0; j < 4; ++j) { const float a = fmaxf(v0[j], 0.f), b = fmaxf(v1[j], 0.f); v0[j] = a * a; v1[j] = b * b; } }
                    if (MODE == 2) { v0 = v0 * cv[bj][0]; v1 = v1 * cv[bj][1]; }
                    if (MODE == 3) { v0 = v0 + cv[bj][0]; v1 = v1 + cv[bj][1];
                        if (t == 0) {
#pragma unroll
                            for (int j = 0; j < 4; ++j) { v0[j] = -0.6065306597f * sigm(v0[j]); v1[j] = -0.6065306597f * sigm(v1[j]); } }
                        else if (t != 2) {
#pragma unroll
                            for (int j = 0; j < 4; ++j) { v0[j] = sigm(v0[j]); v1[j] = sigm(v1[j]); } }
                    }
                    v4u w; w.x = cvt_pk_bf16(v0[0], v0[1]); w.y = cvt_pk_bf16(v0[2], v0[3]); w.z = cvt_pk_bf16(v1[0], v1[1]); w.w = cvt_pk_bf16(v1[2], v1[3]);
                    *(v4u*)(rowp + bj * HALF) = w; } }
    }
};
template <bool GATE> struct EpiR {
    static constexpr bool PERM = false;
    static constexpr int RB = GATE ? 2 : 4;
    const float* base; float* out; const bf16_t* pp; int ldc;
    __device__ __forceinline__ void operator()(const f32x4 (&acc)[2][2][4][2], const Unit& u, int wr, int wc, int fr, int fq) const {
        const int row0 = u.pm * BM + wr * 64 + fr, col0 = u.pn * BM + wc * 32 + 4 * fq;
#pragma unroll
        for (int aim = 0; aim < 8 / RB; ++aim) { const int ai = (aim * RB) >> 2, m0 = (aim * RB) & 3;
            f32x4 bs[RB][2][2]; v2u q[RB][2][2];
#pragma unroll
            for (int mm = 0; mm < RB; ++mm) { const size_t off = (size_t)(row0 + ai * HALF + (m0 + mm) * 16) * ldc + col0;
#pragma unroll
                for (int bj = 0; bj < 2; ++bj)
#pragma unroll
                    for (int n = 0; n < 2; ++n) { bs[mm][bj][n] = *(const f32x4*)(base + off + bj * HALF + n * 16); if (GATE) q[mm][bj][n] = *(const v2u*)(pp + off + bj * HALF + n * 16); } }
#pragma unroll
            for (int mm = 0; mm < RB; ++mm) { const int m = m0 + mm; const size_t off = (size_t)(row0 + ai * HALF + m * 16) * ldc + col0;
#pragma unroll
                for (int bj = 0; bj < 2; ++bj)
#pragma unroll
                    for (int n = 0; n < 2; ++n) { f32x4 a = acc[ai][bj][m][n];
                        if (GATE) {
                            a[0] = sigm(a[0]) * __uint_as_float(q[mm][bj][n].x << 16); a[1] = sigm(a[1]) * __uint_as_float(q[mm][bj][n].x & 0xffff0000u);
                            a[2] = sigm(a[2]) * __uint_as_float(q[mm][bj][n].y << 16); a[3] = sigm(a[3]) * __uint_as_float(q[mm][bj][n].y & 0xffff0000u); }
                        *(f32x4*)(out + off + bj * HALF + n * 16) = bs[mm][bj][n] + a; } }
            asm volatile("" ::: "memory"); }
    }
};

struct Job { const bf16_t* A; const bf16_t* Bt; int lda, ldb, K, a_pn_step, nM, nN, mode;
             bf16_t* O; int ldc; const float* c0; const float* c1; const float* c2; const float* base; float* out; const bf16_t* pp; };
__device__ __forceinline__ void run_epi(const Job& J, const f32x4 (&acc)[2][2][4][2], const Unit& u, int wr, int wc, int fr, int fq) {
    switch (J.mode) {
    case 0: { EpiB<0> E{J.O, J.ldc, nullptr, nullptr, nullptr, 0}; E(acc, u, wr, wc, fr, fq); } break;
    case 1: { EpiB<1> E{J.O, J.ldc, nullptr, nullptr, nullptr, 0}; E(acc, u, wr, wc, fr, fq); } break;
    case 2: { EpiB<2> E{J.O, J.ldc, J.c0, nullptr, nullptr, 0}; E(acc, u, wr, wc, fr, fq); } break;
    case 3: { EpiB<3> E{J.O, J.ldc, J.c0, J.c1, J.c2, PLANE}; E(acc, u, wr, wc, fr, fq); } break;
    case 4: { EpiR<false> E{J.base, J.out, nullptr, J.ldc}; E(acc, u, wr, wc, fr, fq); } break;
    default: { EpiR<true> E{J.base, J.out, J.pp, J.ldc}; E(acc, u, wr, wc, fr, fq); } break;
    }
}
__device__ __forceinline__ void gemm_phase(LAS unsigned char* lds, const Job& J, const StaticOrder& S, const int tid) {
    const int wid = __builtin_amdgcn_readfirstlane(tid >> 6), lane = tid & 63, wr = wid >> 2, wc = wid & 3, fr = lane & 15, fq = lane >> 4;
    const int K = J.K, nt = K / BK;
    unsigned voffA[2], voffB[2];
#pragma unroll
    for (int i = 0; i < 2; ++i) { int R, C; stage_rc(tid * 16 + i * 8192, R, C); const int Rb = (J.mode < 4) ? ((R & ~31) + perm32(R & 31)) : R;
        voffA[i] = (unsigned)(R * J.lda + C) * 2u; voffB[i] = (unsigned)(Rb * J.ldb + C) * 2u; }
    const size_t kstep = (size_t)(BK * 2);
    const size_t hstepA = (size_t)HALF * J.lda * 2, hstepB = (size_t)HALF * J.ldb * 2;
    const size_t tstepA = 2 * hstepA, tstepB = 2 * hstepB;
    const unsigned ldsw = (unsigned)wid * 1024u;
    const int aoff = lds_byte(wr * 64 + fr, fq * 8), boff = lds_byte(wc * 32 + fr, fq * 8);
#define PG8_SA(b, h) (((b) * 2 + (h)) * HTB)
#define PG8_SB(b, h) ((4 + (b) * 2 + (h)) * HTB)
#define PG8_STAGE(bufoff, gbase, voff) do { _Pragma("unroll") for (int _i = 0; _i < 2; ++_i) \
        __builtin_amdgcn_global_load_lds((const unsigned*)((const char*)(gbase) + (voff)[_i]), (LAS unsigned*)(lds + (bufoff) + ldsw + _i * 8192), 16, 0, 0); } while (0)
#define PG8_LDA(dst, b, h) do { _Pragma("unroll") for (int m = 0; m < 4; ++m) _Pragma("unroll") for (int k = 0; k < 2; ++k) dst[m][k] = *(const LAS bf16x8*)(lds + PG8_SA(b, h) + aoff + m * 2048 + k * 1024); } while (0)
#define PG8_LDB(dst, b, h) do { _Pragma("unroll") for (int n = 0; n < 2; ++n) _Pragma("unroll") for (int k = 0; k < 2; ++k) dst[n][k] = *(const LAS bf16x8*)(lds + PG8_SB(b, h) + boff + n * 2048 + k * 1024); } while (0)
#define PG8_MMA(ai, bj, At, Bt) do { __builtin_amdgcn_s_setprio(1); _Pragma("unroll") for (int m = 0; m < 4; ++m) _Pragma("unroll") for (int n = 0; n < 2; ++n) _Pragma("unroll") for (int k = 0; k < 2; ++k) \
        acc[ai][bj][m][n] = __builtin_amdgcn_mfma_f32_16x16x32_bf16(Bt[n][k], At[m][k], acc[ai][bj][m][n], 0, 0, 0); __builtin_amdgcn_s_setprio(0); } while (0)
#define PG8_WAIT_V(n) asm volatile("s_waitcnt vmcnt(" #n ")" ::: "memory")
#define PG8_WAIT_L(n) asm volatile("s_waitcnt lgkmcnt(" #n ")" ::: "memory")
#define PG8_BAR __builtin_amdgcn_s_barrier()
#define PG8_SCHED __builtin_amdgcn_sched_barrier(0)
    Unit cur, nxt; int ui = 0;
    if (!S.next(0, cur)) return;
    f32x4 acc[2][2][4][2];
#pragma unroll
    for (int a = 0; a < 2; ++a)
#pragma unroll
        for (int b = 0; b < 2; ++b)
#pragma unroll
            for (int m = 0; m < 4; ++m)
#pragma unroll
                for (int n = 0; n < 2; ++n) acc[a][b][m][n] = (f32x4){0.f, 0.f, 0.f, 0.f};
    bf16x8 At[4][2], B0[2][2], B1[2][2];
    const char* cA = (const char*)J.A + (size_t)cur.pm * tstepA + (size_t)cur.pn * J.a_pn_step * 2; const char* cB = (const char*)J.Bt + (size_t)cur.pn * tstepB;
    PG8_STAGE(PG8_SB(0, 0), cB, voffB); PG8_STAGE(PG8_SB(0, 1), cB + hstepB, voffB); PG8_STAGE(PG8_SA(0, 0), cA, voffA); PG8_STAGE(PG8_SA(0, 1), cA + hstepA, voffA);
    if (wr == 1) PG8_BAR;
    PG8_WAIT_V(2); PG8_BAR;
    PG8_STAGE(PG8_SB(1, 0), cB + kstep, voffB); PG8_STAGE(PG8_SA(1, 0), cA + kstep, voffA); PG8_STAGE(PG8_SB(1, 1), cB + hstepB + kstep, voffB);
    PG8_WAIT_V(6); PG8_BAR;
    for (;;) {
        const bool has_next = S.next(ui + 1, nxt);
        const char* nA = has_next ? (const char*)J.A + (size_t)nxt.pm * tstepA + (size_t)nxt.pn * J.a_pn_step * 2 : cA; const char* nB = has_next ? (const char*)J.Bt + (size_t)nxt.pn * tstepB : cB;
        for (int t = 0; t < nt; t += 2) {
            const bool last = (t == nt - 2);
            const char* a1 = cA + (size_t)(t + 1) * kstep;
            const char* a2 = last ? nA : cA + (size_t)(t + 2) * kstep; const char* b2 = last ? nB : cB + (size_t)(t + 2) * kstep;
            const char* a3 = a2 + kstep; const char* b3 = b2 + kstep;
            PG8_LDB(B0, 0, 0); PG8_LDB(B1, 0, 1); PG8_SCHED; PG8_LDA(At, 0, 0); PG8_STAGE(PG8_SA(1, 1), a1 + hstepA, voffA);
            PG8_WAIT_V(8); PG8_WAIT_L(0); PG8_BAR; PG8_MMA(0, 0, At, B0); PG8_MMA(0, 1, At, B1); PG8_BAR; PG8_SCHED;
            PG8_LDA(At, 0, 1); PG8_STAGE(PG8_SB(0, 0), b2, voffB); PG8_STAGE(PG8_SB(0, 1), b2 + hstepB, voffB); PG8_STAGE(PG8_SA(0, 0), a2, voffA);
            PG8_WAIT_V(8); PG8_WAIT_L(0); PG8_BAR; PG8_MMA(1, 0, At, B0); PG8_MMA(1, 1, At, B1); PG8_BAR; PG8_SCHED;
            PG8_LDB(B0, 1, 0); PG8_LDB(B1, 1, 1); PG8_SCHED; PG8_LDA(At, 1, 0); PG8_STAGE(PG8_SA(0, 1), a2 + hstepA, voffA);
            PG8_WAIT_V(8); PG8_WAIT_L(0); PG8_BAR; PG8_MMA(0, 0, At, B0); PG8_MMA(0, 1, At, B1); PG8_BAR; PG8_SCHED;
            PG8_LDA(At, 1, 1); PG8_STAGE(PG8_SB(1, 0), b3, voffB); PG8_STAGE(PG8_SB(1, 1), b3 + hstepB, voffB); PG8_STAGE(PG8_SA(1, 0), a3, voffA);
            PG8_WAIT_V(8); PG8_WAIT_L(0); PG8_BAR; PG8_MMA(1, 0, At, B0); PG8_MMA(1, 1, At, B1); PG8_BAR; PG8_SCHED;
        }
        if (wr == 0) PG8_BAR;
        run_epi(J, acc, cur, wr, wc, fr, fq);
        if (!has_next) break;
#pragma unroll
        for (int a = 0; a < 2; ++a)
#pragma unroll
            for (int b = 0; b < 2; ++b)
#pragma unroll
                for (int m = 0; m < 4; ++m)
#pragma unroll
                    for (int n = 0; n < 2; ++n) acc[a][b][m][n] = (f32x4){0.f, 0.f, 0.f, 0.f};
        cur = nxt; cA = nA; cB = nB; ++ui;
        if (wr == 1) PG8_BAR;
    }
    PG8_WAIT_V(0);
    PG8_BAR;
#undef PG8_SA
#undef PG8_SB
#undef PG8_STAGE
#undef PG8_LDA
#undef PG8_LDB
#undef PG8_MMA
#undef PG8_WAIT_V
#undef PG8_WAIT_L
#undef PG8_BAR
#undef PG8_SCHED
}
}

struct Args { const float* in[29]; float* out; unsigned char* ws; int ph_lo, ph_hi; };
typedef const __attribute__((address_space(4))) Args* ArgsP;
enum { I_X = 0, I_P, I_ATTN_NORM, I_W_IN, I_MU_SHIFT, I_W_VRES_DN, I_MU_VRES, I_V0, I_V_UP, I_POOL_W, I_POOL_SCALE, I_W0, I_W_UP, I_A0, I_A_UP, I_G_UP,
       I_K_K, I_K_A, I_R_K, I_GN_G, I_GN_B, I_W_OUT, I_MLP_NORM, I_W_FFN_UP, I_W_FFN_DOWN, I_PLE_NORM, I_W_PLE_GATE, I_W_PLE_PROJ, I_FINAL_NORM };

__device__ __forceinline__ void p0_transpose_item(const float* W, int N, bf16_t* WT, int ldd, int row_off, LAS float* scr, int item, int nblk, int lane) {
    const int kb = item / nblk, nb = item % nblk, k0 = 64 * kb, n0 = 32 * nb;
#pragma unroll 8
    for (int i = 0; i < 32; ++i) { const int kk = 2 * i + (lane >> 5); scr[kk * 33 + (lane & 31)] = W[(size_t)(k0 + kk) * N + n0 + (lane & 31)]; }
    asm volatile("s_waitcnt lgkmcnt(0)" ::: "memory");
    const int c = lane & 7;
#pragma unroll
    for (int j = 0; j < 4; ++j) { const int n = (lane >> 3) + 8 * j; const LAS float* s = scr + (8 * c) * 33 + n;
        v4u o; o.x = cvt_pk_bf16(s[0 * 33], s[1 * 33]); o.y = cvt_pk_bf16(s[2 * 33], s[3 * 33]); o.z = cvt_pk_bf16(s[4 * 33], s[5 * 33]); o.w = cvt_pk_bf16(s[6 * 33], s[7 * 33]);
        *(v4u*)(WT + (size_t)(row_off + n0 + n) * ldd + k0 + 8 * c) = o; }
    asm volatile("s_waitcnt lgkmcnt(0)" ::: "memory");
}
__device__ __forceinline__ void cvt_job(const float* W, int K, int N, bf16_t* WT, int ldd, int row_off, LAS float* scr, int gw, int NW, int lane) {
    const int nblk = N / 32, nit = (K / 64) * nblk;
    for (int it = gw; it < nit; it += NW) p0_transpose_item(W, N, WT, ldd, row_off, scr, it, nblk, lane);
}
__device__ __forceinline__ void phase_convert(ArgsP a, LAS unsigned char* lds, const int tid, const int bx) {
    const int lane = tid & 63, wave = tid >> 6, G = gridDim.x;
    const int gw = bx * 8 + wave, NW = G * 8; const size_t gt = (size_t)bx * 512 + tid, NT = (size_t)G * 512;
    LAS float* scr = (LAS float*)(lds + wave * 8448);
    unsigned char* ws = a->ws;
    for (int l = 0; l < DEPTH; ++l) {
        bf16_t* win = (bf16_t*)(ws + WS_WIN) + (size_t)l * NZ * DM;
        cvt_job(a->in[I_W_IN] + (size_t)l * DM * INW, DM, INW, win, DM, 0, scr, gw, NW, lane);
        if (l > 0) cvt_job(a->in[I_W_VRES_DN] + (size_t)(l - 1) * DM * 32, DM, 32, win, DM, INW, scr, gw, NW, lane);
        { const int r0 = (l == 0) ? INW : INW + 32; const size_t n16 = (size_t)(NZ - r0) * DM / 8; v4u* z = (v4u*)(win + (size_t)r0 * DM);
          for (size_t i = gt; i < n16; i += NT) z[i] = (v4u){0u, 0u, 0u, 0u}; }
        cvt_job(a->in[I_W_OUT] + (size_t)l * DM * DM, DM, DM, (bf16_t*)(ws + WS_WOUT) + (size_t)l * DM * DM, DM, 0, scr, gw, NW, lane);
        cvt_job(a->in[I_W_FFN_UP] + (size_t)l * DM * DFF, DM, DFF, (bf16_t*)(ws + WS_WUP) + (size_t)l * DFF * DM, DM, 0, scr, gw, NW, lane);
        cvt_job(a->in[I_W_FFN_DOWN] + (size_t)l * DFF * DM, DFF, DM, (bf16_t*)(ws + WS_WDN) + (size_t)l * DM * DFF, DFF, 0, scr, gw, NW, lane);
        cvt_job(a->in[I_W_PLE_GATE] + (size_t)l * DM * DM, DM, DM, (bf16_t*)(ws + WS_WGATE) + (size_t)l * DM * DM, DM, 0, scr, gw, NW, lane);
        cvt_job(a->in[I_W_PLE_PROJ] + (size_t)l * DPLE * DM, DPLE, DM, (bf16_t*)(ws + WS_WPROJ) + (size_t)l * DM * DPLE, DPLE, 0, scr, gw, NW, lane);
        for (int gi = 0; gi < 4; ++gi)
            cvt_job(a->in[I_POOL_W] + ((size_t)l * 4 + gi) * 256 * 256, 256, 256, (bf16_t*)(ws + WS_WPOOL) + (size_t)l * 1024 * 256, 256, gi * 256, scr, gw, NW, lane);
        { bf16_t* wl = (bf16_t*)(ws + WS_WLORA) + (size_t)l * 4096 * KL;
          const float* wu = a->in[I_W_UP] + (size_t)l * 64 * RW; const float* au = a->in[I_A_UP] + (size_t)l * 64 * RW; const float* gu = a->in[I_G_UP] + (size_t)l * 160 * RW;
          const float* vu = a->in[I_V_UP] + (size_t)(l > 0 ? l - 1 : 0) * 32 * RW;
          for (size_t idx = gt; idx < (size_t)4096 * KL; idx += NT) { const int n = (int)(idx / KL), k = (int)(idx % KL), t = n >> 10, col = n & 1023; float v = 0.f;
              if (t == 0) { if (k < 64) v = wu[(size_t)k * RW + col]; }
              else if (t == 1) { if (k >= 64 && k < 128) v = au[(size_t)(k - 64) * RW + col]; }
              else if (t == 2) { if (k >= 128 && k < 288) v = gu[(size_t)(k - 128) * RW + col]; }
              else { if (l > 0 && k >= 288 && k < 320) v = vu[(size_t)(k - 288) * RW + col]; }
              wl[idx] = (bf16_t)(cvt_pk_bf16(v, 0.f) & 0xffffu); } }
    }
    { const float* p = a->in[I_P]; bf16_t* pb = (bf16_t*)(ws + WS_PB); const size_t n8 = (size_t)DEPTH * M * DPLE / 8;
      for (size_t i = gt; i < n8; i += NT) { const f32x8 v = ld8f(p + i * 8); *(v4u*)(pb + i * 8) = pk8(v); } }
}

__device__ __forceinline__ void phase_norm(const float* x, const float* g, bf16_t* H, float* outf, const int tid, const int bx) {
    const bool F32OUT = (outf != nullptr);
    const int lane = tid & 63, wave = tid >> 6; const int gw = bx * 8 + wave, NW = gridDim.x * 8;
    f32x4 gv[8];
#pragma unroll
    for (int j = 0; j < 8; ++j) gv[j] = ((const f32x4*)g)[lane + 64 * j];
    for (int row = gw; row < M; row += NW) {
        const f32x4* xr = (const f32x4*)(x + (size_t)row * DM) + lane;
        f32x4 v[8]; float s = 0.f;
#pragma unroll
        for (int j = 0; j < 8; ++j) { v[j] = xr[64 * j]; s += (v[j][0] * v[j][0] + v[j][1] * v[j][1]) + (v[j][2] * v[j][2] + v[j][3] * v[j][3]); }
        s = wave_sum(s);
        const float rs = rsqrtf(s * (1.0f / DM) + NORM_EPS);
#pragma unroll
        for (int j = 0; j < 8; ++j) { const f32x4 o = v[j] * rs * gv[j];
            if (F32OUT) ((f32x4*)(outf + (size_t)row * DM))[lane + 64 * j] = o;
            else { v2u w; w.x = cvt_pk_bf16(o[0], o[1]); w.y = cvt_pk_bf16(o[2], o[3]); ((v2u*)(H + (size_t)row * DM))[lane + 64 * j] = w; } }
    }
}

__device__ __forceinline__ void phase_prepa(ArgsP a, int l, const int tid, const int bx) {
    const int G = gridDim.x;
    const bf16_t* Z = (const bf16_t*)(a->ws + WS_Z); bf16_t* DP = (bf16_t*)(a->ws + WS_DPOOL); bf16_t* AL = (bf16_t*)(a->ws + WS_ALORA);
    const float* mus = a->in[I_MU_SHIFT] + (size_t)l * SHIFTW; const float* muv = a->in[I_MU_VRES] + (size_t)(l > 0 ? l - 1 : 0) * 32;
    const int rsub = tid >> 7, cgp = tid & 127;
    for (int unit = bx; unit < M / 4; unit += G) {
        const int row = unit * 4 + rsub, tpos = row & (SEQ - 1);
        { const int gi = cgp >> 5, win = 2 << gi, cnt = (tpos + 1 < win) ? tpos + 1 : win;
          const bf16_t* zp = Z + (size_t)row * NZ + 8 * cgp;
          const f32x8 u = up8(*(const v4u*)zp); f32x8 s = u;
          for (int q = 1; q < cnt; ++q) s = s + up8(*(const v4u*)(zp - (size_t)q * NZ));
          const f32x8 d = s * (1.0f / (float)cnt) - u;
          *(v4u*)(DP + (size_t)row * RW + 8 * cgp) = pk8(d); }
        if (cgp < KL / 8) {
            const int c = 8 * cgp; f32x8 o;
#pragma unroll
            for (int j = 0; j < 8; ++j) o[j] = 0.f;
            if (c < 288 || (c < 320 && l > 0)) {
                const bf16_t* zp = Z + (size_t)row * NZ + 4096 + c;
                const f32x8 zc = up8(*(const v4u*)zp); f32x8 zq;
                if (tpos > 0) zq = up8(*(const v4u*)(zp - NZ)); else {
#pragma unroll
                    for (int j = 0; j < 8; ++j) zq[j] = 0.f; }
                const f32x8 mu = (c < 288) ? ld8f(mus + 3072 + c) : ld8f(muv + (c - 288));
                const f32x8 zs = zc + (zq - zc) * mu;
                if (c < 64) {
#pragma unroll
                    for (int j = 0; j < 8; ++j) o[j] = 1.0f - 2.0f * __builtin_amdgcn_rcpf(1.0f + __expf(2.0f * zs[j])); }
                else if (c >= 128 && c < 288) {
#pragma unroll
                    for (int j = 0; j < 8; ++j) o[j] = sigm(zs[j]); }
                else o = zs;
            }
            *(v4u*)(AL + (size_t)row * KL + c) = pk8(o);
        }
    }
}

constexpr int TC = 32, STEPB = 1344, BUFB = TC * STEPB, YBB = TC * 16 * 4;
struct ScanRaw { v4u zr, zrp, zk, zkp, zv, zvp, ld, aa, vg, vf; };
__device__ __forceinline__ void scan_unit(ArgsP a, int l, int u, LAS unsigned char* lds, const int tid) {
    const int wave = __builtin_amdgcn_readfirstlane(tid >> 6), lane = tid & 63;
    const int bh = u >> 2, rg = u & 3, b = bh >> 4, h = bh & 15;
    const bool hasv = l > 0;
    constexpr int NC = SEQ / TC;
    const size_t rowbase = (size_t)b * SEQ;
    if (wave < 4) {
        const int rowl = 4 * wave + (lane >> 4), j = lane & 15;
        f32x2 s01 = {0.f, 0.f}, s23 = {0.f, 0.f};
        for (int c = 0; c < NC; ++c) {
            __syncthreads();
            const LAS unsigned char* buf = lds + (c & 1) * BUFB + 16 * j;
            const LAS unsigned char* vb = lds + (c & 1) * BUFB + 1280 + 4 * rowl;
            LAS float* yb = (LAS float*)(lds + 2 * BUFB + (c & 1) * YBB) + rowl + (15 - j) * 16;
            f32x4 R[3], W[3], K[3], A[3], B[3]; float V[3];
#define SC_LD(sl, tl) do { R[sl] = *(const LAS f32x4*)(buf + (tl) * STEPB); W[sl] = *(const LAS f32x4*)(buf + (tl) * STEPB + 256); K[sl] = *(const LAS f32x4*)(buf + (tl) * STEPB + 512); \
                A[sl] = *(const LAS f32x4*)(buf + (tl) * STEPB + 768); B[sl] = *(const LAS f32x4*)(buf + (tl) * STEPB + 1024); V[sl] = *(const LAS float*)(vb + (tl) * STEPB); } while (0)
            SC_LD(0, 0); SC_LD(1, 1);
            float yprev = 0.f, ysel = 0.f;
#pragma unroll
            for (int i = 0; i < TC; ++i) {
                const int sl = i % 3;
                if (i + 2 < TC) SC_LD((i + 2) % 3, i + 2);
                const f32x2 vv = {V[sl], V[sl]};
                f32x2 pp = s01 * (f32x2){A[sl][0], A[sl][1]}; pp = s23 * (f32x2){A[sl][2], A[sl][3]} + pp;
                float p = pp[0] + pp[1];
                f32x2 t01 = vv * (f32x2){K[sl][0], K[sl][1]}, t23 = vv * (f32x2){K[sl][2], K[sl][3]};
                t01 = s01 * (f32x2){W[sl][0], W[sl][1]} + t01; t23 = s23 * (f32x2){W[sl][2], W[sl][3]} + t23;
                if (i > 0) {
                    p += dpp1<0x128>(p); yprev += dpp1<0x128>(yprev);
                    p += dpp1<0x124>(p); yprev += dpp1<0x124>(yprev);
                    p += dpp1<0x122>(p); yprev += dpp1<0x122>(yprev);
                    p += dpp1<0x121>(p); yprev += dpp1<0x121>(yprev);
                    ysel = __builtin_bit_cast(float, __builtin_amdgcn_update_dpp(__builtin_bit_cast(int, yprev), __builtin_bit_cast(int, ysel), 0x111, 0xF, 0xF, false));
                    if ((i & 15) == 0) yb[((i >> 4) - 1) * 256] = ysel;
                } else {
                    p += dpp1<0x128>(p); p += dpp1<0x124>(p); p += dpp1<0x122>(p); p += dpp1<0x121>(p);
                }
                const f32x2 pv = {p, p};
                s01 = pv * (f32x2){B[sl][0], B[sl][1]} + t01; s23 = pv * (f32x2){B[sl][2], B[sl][3]} + t23;
                f32x2 yy = s01 * (f32x2){R[sl][0], R[sl][1]}; yy = s23 * (f32x2){R[sl][2], R[sl][3]} + yy;
                yprev = yy[0] + yy[1];
            }
            yprev += dpp1<0x128>(yprev); yprev += dpp1<0x124>(yprev); yprev += dpp1<0x122>(yprev); yprev += dpp1<0x121>(yprev);
            ysel = __builtin_bit_cast(float, __builtin_amdgcn_update_dpp(__builtin_bit_cast(int, yprev), __builtin_bit_cast(int, ysel), 0x111, 0xF, 0xF, false));
            yb[(TC / 16 - 1) * 256] = ysel;
#undef SC_LD
        }
        __syncthreads();
    } else {
        const int ltid = tid - 256, tl = ltid >> 3, cgp = ltid & 7;
        const int col0 = h * HS + 8 * cgp;
        const bf16_t* Z = (const bf16_t*)(a->ws + WS_Z); const bf16_t* PL = (const bf16_t*)(a->ws + WS_PLANES); const bf16_t* VF = (const bf16_t*)(a->ws + WS_VFIRST);
        bf16_t* Y = (bf16_t*)(a->ws + WS_DPOOL);
        const float* mus = a->in[I_MU_SHIFT] + (size_t)l * SHIFTW;
        const f32x8 mur = ld8f(mus + col0), muk = ld8f(mus + 1024 + col0), muv = ld8f(mus + 2048 + col0);
        const f32x8 kkc = ld8f(a->in[I_K_K] + (size_t)l * RW + col0), kac = ld8f(a->in[I_K_A] + (size_t)l * RW + col0);
        const bool vmine = (cgp >> 1) == rg;
#define SCAN_LOAD(R, cc) do { const int t_ = (cc) * TC + tl; const size_t row_ = rowbase + t_; const size_t rowp_ = (t_ > 0) ? row_ - 1 : row_; \
            const bf16_t* z_ = Z + row_ * NZ + col0; const bf16_t* zq_ = Z + rowp_ * NZ + col0; \
            R.zr = *(const v4u*)(z_ + 1024); R.zk = *(const v4u*)(z_ + 2048); R.zv = *(const v4u*)(z_ + 3072); \
            R.zrp = *(const v4u*)(zq_ + 1024); R.zkp = *(const v4u*)(zq_ + 2048); R.zvp = *(const v4u*)(zq_ + 3072); \
            R.ld = *(const v4u*)(PL + row_ * RW + col0); R.aa = *(const v4u*)(PL + PLANE + row_ * RW + col0); \
            if (hasv) { R.vg = *(const v4u*)(PL + 3 * PLANE + row_ * RW + col0); R.vf = *(const v4u*)(VF + row_ * RW + col0); } else { R.vg = R.ld; R.vf = R.ld; } } while (0)
#define SCAN_FLUSH(cc) do { const LAS float* yb_ = (const LAS float*)(lds + 2 * BUFB + ((cc) & 1) * YBB) + tl * 16 + 2 * cgp; \
            const unsigned w_ = cvt_pk_bf16(yb_[0], yb_[1]); *(unsigned*)(Y + (rowbase + (size_t)(cc) * TC + tl) * RW + h * HS + 16 * rg + 2 * cgp) = w_; } while (0)
        ScanRaw nx; SCAN_LOAD(nx, 0);
        for (int c = 0; c < NC; ++c) {
            const ScanRaw cu = nx;
            if (c + 1 < NC) SCAN_LOAD(nx, c + 1);
            const int t = c * TC + tl;
            const f32x8 zr = up8(cu.zr), zk = up8(cu.zk), zv = up8(cu.zv);
            f32x8 zrp = up8(cu.zrp), zkp = up8(cu.zkp), zvp = up8(cu.zvp);
            if (t == 0) {
#pragma unroll
                for (int q = 0; q < 8; ++q) { zrp[q] = 0.f; zkp[q] = 0.f; zvp[q] = 0.f; } }
            const f32x8 r = zr + (zrp - zr) * mur, k = zk + (zkp - zk) * muk; f32x8 v = zv + (zvp - zv) * muv;
            const f32x8 ld = up8(cu.ld), av = up8(cu.aa);
            if (hasv) v = v + (up8(cu.vf) - v) * up8(cu.vg);
            const f32x8 kk = k * kkc;
            float n2 = sum8(kk * kk); n2 += __shfl_xor(n2, 1); n2 += __shfl_xor(n2, 2); n2 += __shfl_xor(n2, 4);
            const float inv = 1.0f / fmaxf(sqrtf(n2), 1e-12f);
            const f32x8 kkn = kk * inv;
            const f32x8 kadj = k * (1.0f + (av - 1.0f) * kac);
            f32x8 dec;
#pragma unroll
            for (int q = 0; q < 8; ++q) dec[q] = __expf(ld[q]);
            const f32x8 avec = -kkn, bvec = kkn * av;
            LAS unsigned char* dst = lds + (c & 1) * BUFB + tl * STEPB + cgp * 32;
#define ST8(off, val) do { *(LAS f32x4*)(dst + (off)) = (f32x4){val[0], val[1], val[2], val[3]}; *(LAS f32x4*)(dst + (off) + 16) = (f32x4){val[4], val[5], val[6], val[7]}; } while (0)
            ST8(0, r); ST8(256, dec); ST8(512, kadj); ST8(768, avec); ST8(1024, bvec);
            if (vmine) { LAS unsigned char* dv = lds + (c & 1) * BUFB + tl * STEPB + 1280 + (cgp & 1) * 32;
                *(LAS f32x4*)(dv) = (f32x4){v[0], v[1], v[2], v[3]}; *(LAS f32x4*)(dv + 16) = (f32x4){v[4], v[5], v[6], v[7]}; }
#undef ST8
            if (c >= 2) SCAN_FLUSH(c - 2);
            __syncthreads();
        }
        __syncthreads();
        SCAN_FLUSH(NC - 2); SCAN_FLUSH(NC - 1);
#undef SCAN_LOAD
#undef SCAN_FLUSH
    }
    __syncthreads();
}

__device__ __forceinline__ void phase_post(ArgsP a, int l, const int tid, const int bx) {
    const int lane = tid & 63, wave = tid >> 6; const int gw = bx * 8 + wave, NW = gridDim.x * 8;
    const bf16_t* Z = (const bf16_t*)(a->ws + WS_Z); const bf16_t* PL = (const bf16_t*)(a->ws + WS_PLANES); bf16_t* VF = (bf16_t*)(a->ws + WS_VFIRST);
    const bf16_t* Y = (const bf16_t*)(a->ws + WS_DPOOL); bf16_t* MIX = (bf16_t*)(a->ws + WS_MIX);
    const float* mus = a->in[I_MU_SHIFT] + (size_t)l * SHIFTW;
    const bool hasv = l > 0;
    for (int it = gw; it < M * 2; it += NW) {
        const int row = it >> 1, h = (it & 1) * 8 + (lane >> 3), col = h * HS + 8 * (lane & 7), tpos = row & (SEQ - 1);
        const bf16_t* z = Z + (size_t)row * NZ + col; const bf16_t* zq = (tpos > 0) ? z - NZ : z;
        const f32x8 zr = up8(*(const v4u*)(z + 1024)), zk = up8(*(const v4u*)(z + 2048)), zv = up8(*(const v4u*)(z + 3072));
        f32x8 zrp = up8(*(const v4u*)(zq + 1024)), zkp = up8(*(const v4u*)(zq + 2048)), zvp = up8(*(const v4u*)(zq + 3072));
        if (tpos == 0) {
#pragma unroll
            for (int q = 0; q < 8; ++q) { zrp[q] = 0.f; zkp[q] = 0.f; zvp[q] = 0.f; } }
        const f32x8 r = zr + (zrp - zr) * ld8f(mus + col), k = zk + (zkp - zk) * ld8f(mus + 1024 + col); f32x8 v = zv + (zvp - zv) * ld8f(mus + 2048 + col);
        const size_t po = (size_t)row * RW + col;
        const f32x8 av = up8(*(const v4u*)(PL + PLANE + po)), gg = up8(*(const v4u*)(PL + 2 * PLANE + po));
        if (hasv) v = v + (up8(*(const v4u*)(VF + po)) - v) * up8(*(const v4u*)(PL + 3 * PLANE + po));
        else *(v4u*)(VF + po) = pk8(v);
        const f32x8 kadj = k * (1.0f + (av - 1.0f) * ld8f(a->in[I_K_A] + (size_t)l * RW + col));
        float bonus = sum8(r * kadj * ld8f(a->in[I_R_K] + (size_t)l * RW + col));
        bonus += __shfl_xor(bonus, 1); bonus += __shfl_xor(bonus, 2); bonus += __shfl_xor(bonus, 4);
        const f32x8 y = up8(*(const v4u*)(Y + po));
        float sm = sum8(y); sm += __shfl_xor(sm, 1); sm += __shfl_xor(sm, 2); sm += __shfl_xor(sm, 4);
        const float mean = sm * (1.0f / 64.0f);
        const f32x8 d = y - mean;
        float vs = sum8(d * d); vs += __shfl_xor(vs, 1); vs += __shfl_xor(vs, 2); vs += __shfl_xor(vs, 4);
        const float rstd = rsqrtf(vs * (1.0f / 64.0f) + GN_EPS);
        const f32x8 o = (d * rstd * ld8f(a->in[I_GN_G] + (size_t)l * RW + col) + ld8f(a->in[I_GN_B] + (size_t)l * RW + col) + bonus * v) * gg;
        *(v4u*)(MIX + (size_t)row * DM + 1024 + col) = pk8(o);
    }
}

#define XB_TMO      128
#define XB_XCNT(j)  (256  + 64 * (j))
#define XB_XSUB(j)  (1280 + 64 * (j))
#define XB_XGEN(j)  (2304 + 64 * (j))
#define XB_TOP      3328
#define XB_TOPGEN   3392
#define XCD_BAR_WORDS 3456
#define XB_SPIN_CAP (1u << 18)

__device__ __forceinline__ unsigned xb_ld(unsigned* p)              { return __hip_atomic_load(p, __ATOMIC_RELAXED, __HIP_MEMORY_SCOPE_AGENT); }
__device__ __forceinline__ unsigned xb_add(unsigned* p, unsigned v) { return __hip_atomic_fetch_add(p, v, __ATOMIC_RELAXED, __HIP_MEMORY_SCOPE_AGENT); }
__device__ __forceinline__ unsigned xb_xcc_id() { return (unsigned)__builtin_amdgcn_s_getreg((3 << 11) | 20) & 0xFu; }
#define XB_SPIN(cond, bar) do { unsigned _sp = 0; while (cond) { __builtin_amdgcn_s_sleep(1); \
    if ((++_sp & 255u) == 0u) { if (xb_ld(&(bar)[XB_TMO])) break; if (_sp > XB_SPIN_CAP) { atomicAdd(&(bar)[XB_TMO], 1u); break; } } } } while (0)

struct XcdBarrier {
    unsigned* bar; unsigned x;
    volatile LAS unsigned* st;
};

__device__ __forceinline__ XcdBarrier xcd_barrier_post(unsigned* bar, volatile LAS unsigned* st) {
    XcdBarrier b; b.bar = bar; b.x = xb_xcc_id(); b.st = st;
    if (threadIdx.x == 0) (void)xb_add(&bar[XB_XCNT(b.x)], 1u);
    return b;
}
__device__ __forceinline__ void xcd_barrier_complete(unsigned* bar, unsigned x, unsigned& nloc, unsigned& nx) {
    const unsigned G = gridDim.x * gridDim.y * gridDim.z;
    unsigned sum, cnt, mine, sp = 0u;
    for (;;) {
        sum = 0u; cnt = 0u; mine = 0u;
#pragma unroll
        for (unsigned j = 0; j < 16; ++j) { const unsigned c = xb_ld(&bar[XB_XCNT(j)]); sum += c; cnt += (c > 0u) ? 1u : 0u; mine = (j == x) ? c : mine; }
        if (sum == G) break;
        __builtin_amdgcn_s_sleep(1);
        if ((++sp & 255u) == 0u) { if (xb_ld(&bar[XB_TMO])) break; if (sp > XB_SPIN_CAP) { atomicAdd(&bar[XB_TMO], 1u); break; } }
    }
    nloc = mine > 0u ? mine : 1u; nx = cnt > 0u ? cnt : 1u;
}

__device__ __forceinline__ void xcd_barrier(const XcdBarrier& b) {
    asm volatile("s_waitcnt vmcnt(0)" ::: "memory");
    __syncthreads();
    if (threadIdx.x == 0) {
        unsigned* bar = b.bar;
        __builtin_amdgcn_s_waitcnt(0);
        unsigned nloc = b.st[0], nx = b.st[1];
        if (nloc == 0u) { xcd_barrier_complete(bar, b.x, nloc, nx); b.st[0] = nloc; b.st[1] = nx; }
        const unsigned old = xb_add(&bar[XB_XSUB(b.x)], 1u);
        const unsigned gen = old / nloc;
        if (old + 1u == (gen + 1u) * nloc) {
            __builtin_amdgcn_fence(__ATOMIC_RELEASE, "agent");
            asm volatile("s_waitcnt vmcnt(0)" ::: "memory");
            const unsigned og = xb_add(&bar[XB_TOP], 1u);
            const unsigned tg = og / nx;
            if (og + 1u == (tg + 1u) * nx) xb_add(&bar[XB_TOPGEN], 1u);
            else XB_SPIN(xb_ld(&bar[XB_TOPGEN]) == tg, bar);
            __builtin_amdgcn_fence(__ATOMIC_ACQUIRE, "agent");
            xb_add(&bar[XB_XGEN(b.x)], 1u);
            asm volatile("s_waitcnt vmcnt(0)" ::: "memory");
        } else {
            XB_SPIN(xb_ld(&bar[XB_XGEN(b.x)]) == gen, bar);
            __builtin_amdgcn_fence(__ATOMIC_ACQUIRE, "agent");
            asm volatile("s_waitcnt vmcnt(0)" ::: "memory");
        }
    }
    __syncthreads();
}


constexpr int N_PHASES = 2 + 12 * DEPTH;
__device__ __forceinline__ bool make_job(ArgsP a, int l, int s, int q, pg8::Job& J) {
    unsigned char* ws = a->ws; float* X = a->out;
    bf16_t* H = (bf16_t*)(ws + WS_H); bf16_t* MIX = (bf16_t*)(ws + WS_MIX); bf16_t* PP = (bf16_t*)(ws + WS_MIX);
    J.a_pn_step = 0; J.nM = M / 256; J.O = nullptr; J.ldc = DM; J.c0 = nullptr; J.c1 = nullptr; J.c2 = nullptr; J.base = nullptr; J.out = nullptr; J.pp = nullptr;
    if (s == 1 && q == 0) { J.A = H; J.Bt = (const bf16_t*)(ws + WS_WIN) + (size_t)l * NZ * DM; J.lda = DM; J.ldb = DM; J.K = DM; J.nN = NZ / 256; J.mode = 0; J.O = (bf16_t*)(ws + WS_Z); J.ldc = NZ; return true; }
    if (s == 3 && q == 0) { J.A = (const bf16_t*)(ws + WS_ALORA); J.Bt = (const bf16_t*)(ws + WS_WLORA) + (size_t)l * 4096 * KL; J.lda = KL; J.ldb = KL; J.K = KL; J.nN = 16; J.mode = 3; J.O = (bf16_t*)(ws + WS_PLANES); J.ldc = RW;
                            J.c0 = a->in[I_W0] + (size_t)l * RW; J.c1 = a->in[I_A0] + (size_t)l * RW; J.c2 = (l > 0) ? a->in[I_V0] + (size_t)(l - 1) * RW : nullptr; return true; }
    if (s == 3 && q == 1) { J.A = (const bf16_t*)(ws + WS_DPOOL); J.Bt = (const bf16_t*)(ws + WS_WPOOL) + (size_t)l * 1024 * 256; J.lda = RW; J.ldb = 256; J.K = 256; J.a_pn_step = 256; J.nN = 4; J.mode = 2; J.O = MIX; J.ldc = DM;
                            J.c0 = a->in[I_POOL_SCALE] + (size_t)l * 1024; return true; }
    if (s == 6 && q == 0) { J.A = MIX; J.Bt = (const bf16_t*)(ws + WS_WOUT) + (size_t)l * DM * DM; J.lda = DM; J.ldb = DM; J.K = DM; J.nN = DM / 256; J.mode = 4; J.base = (l == 0) ? a->in[I_X] : X; J.out = X; return true; }
    if (s == 8 && q == 0) { J.A = H; J.Bt = (const bf16_t*)(ws + WS_WUP) + (size_t)l * DFF * DM; J.lda = DM; J.ldb = DM; J.K = DM; J.nN = DFF / 256; J.mode = 1; J.O = (bf16_t*)(ws + WS_U); J.ldc = DFF; return true; }
    if (s == 8 && q == 1) { J.A = (const bf16_t*)(ws + WS_PB) + (size_t)l * M * DPLE; J.Bt = (const bf16_t*)(ws + WS_WPROJ) + (size_t)l * DM * DPLE; J.lda = DPLE; J.ldb = DPLE; J.K = DPLE; J.nN = DM / 256; J.mode = 0; J.O = PP; J.ldc = DM; return true; }
    if (s == 9 && q == 0) { J.A = (const bf16_t*)(ws + WS_U); J.Bt = (const bf16_t*)(ws + WS_WDN) + (size_t)l * DM * DFF; J.lda = DFF; J.ldb = DFF; J.K = DFF; J.nN = DM / 256; J.mode = 4; J.base = X; J.out = X; return true; }
    if (s == 11 && q == 0) { J.A = H; J.Bt = (const bf16_t*)(ws + WS_WGATE) + (size_t)l * DM * DM; J.lda = DM; J.ldb = DM; J.K = DM; J.nN = DM / 256; J.mode = 5; J.base = X; J.out = X; J.pp = PP; return true; }
    return false;
}
__global__ void __launch_bounds__(512, 2) fwd_megakernel(Args a_byval) {
    ArgsP a = (ArgsP)__builtin_amdgcn_kernarg_segment_ptr();
    extern __shared__ __attribute__((aligned(16))) unsigned char lds_raw[];
    LAS unsigned char* lds = (LAS unsigned char*)lds_raw;
    cg::grid_group grid = cg::this_grid();
    const int G = gridDim.x;
    if (threadIdx.x < 16) ((LAS unsigned*)(lds + BAR_LDS_OFF))[threadIdx.x] = 0u;
    __syncthreads();
    XcdBarrier xbar = xcd_barrier_post((unsigned*)a->ws, (volatile LAS unsigned*)(lds + BAR_LDS_OFF));
    const int ph_lo = a->ph_lo, ph_hi = a->ph_hi;
    for (int ph = ph_lo; ph < ph_hi; ++ph) {
        if (ph > ph_lo) { if (ph == ph_lo + 1) grid.sync(); else xcd_barrier(xbar); }
        asm volatile("" : "+s"(a) :: "memory");
        int tid = threadIdx.x, bx = blockIdx.x; asm volatile("" : "+v"(tid), "+s"(bx));
        float* X = a->out;
        const bool fin = (ph == N_PHASES - 1);
        const int l = (fin || ph == 0) ? 0 : (ph - 1) / 12, s = (ph == 0) ? 13 : fin ? 12 : (ph - 1) % 12;
        int nrep = 1;
        if (PROBE_REP & 1) { if (s == 4) nrep = 2; }
        if (PROBE_REP & 2) { if (s == 1 || s == 3 || s == 8) nrep = 2; }
        if (PROBE_REP & 4) { if (s == 0 || s == 7 || s == 10 || s == 2 || s == 5) nrep = 2; }
        if (PROBE_REP & 8) { if (s == 13) nrep = 2; }
        if (PROBE_REP & 16) { if (ph > ph_lo) xcd_barrier(xbar); }
        for (int rep = 0; rep < nrep; ++rep) {
        if (rep) __syncthreads();
        asm volatile("" : "+v"(tid), "+s"(bx), "+s"(a) :: "memory");
        if (s == 13) { phase_convert(a, lds, tid, bx); }
        else if (s == 0 || s == 7 || s == 10 || s == 12) {
            const float* xs = (s == 0 && l == 0) ? a->in[I_X] : X;
            const float* gp = (s == 0) ? a->in[I_ATTN_NORM] + (size_t)l * DM : (s == 7) ? a->in[I_MLP_NORM] + (size_t)l * DM : (s == 10) ? a->in[I_PLE_NORM] + (size_t)l * DM : a->in[I_FINAL_NORM];
            phase_norm(xs, gp, (bf16_t*)(a->ws + WS_H), fin ? X : nullptr, tid, bx);
        } else if (s == 2) { phase_prepa(a, l, tid, bx); }
        else if (s == 4) { const int vcu = (G % 8 == 0) ? (bx % 8) * (G / 8) + bx / 8 : bx; for (int u = vcu; u < 256; u += G) scan_unit(a, l, u, lds, tid); }
        else if (s == 5) { phase_post(a, l, tid, bx); }
        else {
            for (int q = 0; q < 2; ++q) { pg8::Job J; if (!make_job(a, l, s, q, J)) break;
                pg8::StaticOrder S; S.init(J.nM, J.nN, G, bx); pg8::gemm_phase(lds, J, S, tid); }
        }
        }
    }
}

extern "C" void kernel_launch(void* const* d_in, const int* in_sizes, int n_in, void* d_out, int out_size, void* d_ws, size_t ws_size, hipStream_t stream) {
    static int grid = 0;
    if (grid == 0) {
        if (n_in != 29 || in_sizes[0] != M * DM || out_size != M * DM || ws_size < WS_END) {
            fprintf(stderr, "kernel_launch: unexpected shapes: n_in %d in0 %d out %d ws %zu (need %zu); nothing launched\n", n_in, n_in > 0 ? in_sizes[0] : -1, out_size, ws_size, (size_t)WS_END); grid = -1; return; }
        int dev = 0, cus = 0, per_cu = 0;
        if (hipGetDevice(&dev) != hipSuccess || hipDeviceGetAttribute(&cus, hipDeviceAttributeMultiprocessorCount, dev) != hipSuccess) { fprintf(stderr, "kernel_launch: device query failed\n"); grid = -1; return; }
        if (hipFuncSetAttribute((const void*)fwd_megakernel, hipFuncAttributeMaxDynamicSharedMemorySize, LDS_BYTES) != hipSuccess) { fprintf(stderr, "kernel_launch: hipFuncSetAttribute failed\n"); grid = -1; return; }
        if (hipOccupancyMaxActiveBlocksPerMultiprocessor(&per_cu, (const void*)fwd_megakernel, 512, LDS_BYTES) != hipSuccess || per_cu < 1) {
            fprintf(stderr, "kernel_launch: occupancy query says %d blocks/CU; using 1\n", per_cu); per_cu = 1; }
        (void)hipGetLastError();
        grid = cus * 1;
        if (grid > 256) grid = 256;
    }
    if (grid < 0) return;
    Args a{};
    for (int i = 0; i < 29; ++i) a.in[i] = (const float*)d_in[i];
    a.out = (float*)d_out; a.ws = (unsigned char*)d_ws;
    if (hipMemsetAsync(d_ws, 0, 65536, stream) != hipSuccess) { fprintf(stderr, "kernel_launch: memset of barrier words failed\n"); return; }
#if MK_PER_PHASE_LAUNCH
    for (int ph = 0; ph < N_PHASES; ++ph) {
        a.ph_lo = ph; a.ph_hi = ph + 1;
        hipLaunchKernelGGL(fwd_megakernel, dim3(grid), dim3(512), LDS_BYTES, stream, a);
    }
#else
    a.ph_lo = 0; a.ph_hi = N_PHASES;
    void* args[] = {&a};
    hipError_t e = hipLaunchCooperativeKernel((const void*)fwd_megakernel, dim3(grid), dim3(512), args, LDS_BYTES, stream);
    if (e != hipSuccess) fprintf(stderr, "cooperative launch failed: %s (grid %d)\n", hipGetErrorString(e), grid);
#endif
}
```

```cpp
#include <hip/hip_runtime.h>
#include <hip/hip_cooperative_groups.h>
#include <cstdio>
#include <cstdint>
namespace cg = cooperative_groups;

#ifndef MK_PER_PHASE_LAUNCH
#define MK_PER_PHASE_LAUNCH 0
#endif

#ifndef PROBE_REP
#define PROBE_REP 0
#endif
#define LAS __attribute__((address_space(3)))
typedef unsigned short bf16_t;
typedef short bf16x8 __attribute__((ext_vector_type(8)));
typedef float f32x4 __attribute__((ext_vector_type(4)));
typedef float f32x8 __attribute__((ext_vector_type(8)));
typedef float f32x2 __attribute__((ext_vector_type(2)));
typedef unsigned v4u __attribute__((ext_vector_type(4)));
typedef unsigned v2u __attribute__((ext_vector_type(2)));

constexpr int BATCH = 4, SEQ = 4096, DM = 2048, DEPTH = 4, M = BATCH * SEQ;
constexpr int RW = 1024, HS = 64, NH = 16, DFF = 8192, DPLE = 256;
constexpr int INW = 4384, NZ = 4608, SHIFTW = 3360, KL = 384;
constexpr float NORM_EPS = 1e-6f, GN_EPS = 64e-5f;

constexpr size_t MiB = 1u << 20;
constexpr size_t WS_WIN = 1 * MiB, WS_WOUT = 73 * MiB, WS_WUP = 105 * MiB, WS_WDN = 233 * MiB, WS_WGATE = 361 * MiB, WS_WPROJ = 393 * MiB,
                 WS_WLORA = 397 * MiB, WS_WPOOL = 409 * MiB, WS_PB = 411 * MiB, WS_H = 443 * MiB, WS_MIX = 507 * MiB  ,
                 WS_DPOOL = 571 * MiB  , WS_ALORA = 603 * MiB, WS_VFIRST = 615 * MiB, WS_Z = 647 * MiB, WS_PLANES = 791 * MiB,
                 WS_U = 647 * MiB  , WS_END = 983 * MiB;
constexpr size_t PLANE = (size_t)M * RW;

constexpr int LDS_BYTES = 135168, BAR_LDS_OFF = 131072 + 256;

__device__ __forceinline__ unsigned cvt_pk_bf16(float lo, float hi) { unsigned r; asm volatile("v_cvt_pk_bf16_f32 %0, %1, %2" : "=v"(r) : "v"(lo), "v"(hi)); return r; }
__device__ __forceinline__ float bf2f(unsigned h) { return __uint_as_float(h << 16); }
__device__ __forceinline__ f32x8 up8(v4u p) {
    f32x8 r;
    r[0] = __uint_as_float(p.x << 16); r[1] = __uint_as_float(p.x & 0xffff0000u);
    r[2] = __uint_as_float(p.y << 16); r[3] = __uint_as_float(p.y & 0xffff0000u);
    r[4] = __uint_as_float(p.z << 16); r[5] = __uint_as_float(p.z & 0xffff0000u);
    r[6] = __uint_as_float(p.w << 16); r[7] = __uint_as_float(p.w & 0xffff0000u);
    return r;
}
__device__ __forceinline__ v4u pk8(f32x8 v) { v4u o; o.x = cvt_pk_bf16(v[0], v[1]); o.y = cvt_pk_bf16(v[2], v[3]); o.z = cvt_pk_bf16(v[4], v[5]); o.w = cvt_pk_bf16(v[6], v[7]); return o; }
__device__ __forceinline__ f32x8 ld8f(const float* p) { const f32x4 a = *(const f32x4*)p, b = *(const f32x4*)(p + 4); f32x8 r; r[0] = a[0]; r[1] = a[1]; r[2] = a[2]; r[3] = a[3]; r[4] = b[0]; r[5] = b[1]; r[6] = b[2]; r[7] = b[3]; return r; }
__device__ __forceinline__ float sigm(float x) { return __builtin_amdgcn_rcpf(1.0f + __expf(-x)); }
__device__ __forceinline__ float wave_sum(float v) {
#pragma unroll
    for (int o = 1; o < 64; o <<= 1) v += __shfl_xor(v, o);
    return v;
}
__device__ __forceinline__ float sum8(f32x8 v) { return ((v[0] + v[1]) + (v[2] + v[3])) + ((v[4] + v[5]) + (v[6] + v[7])); }
template <int CTRL> __device__ __forceinline__ float dpp1(float x) { const int xi = __builtin_bit_cast(int, x); return __builtin_bit_cast(float, __builtin_amdgcn_update_dpp(0, xi, CTRL, 0xF, 0xF, true)); }
template <int CTRL> __device__ __forceinline__ float dpp_mov(float x) { const int xi = __builtin_bit_cast(int, x); return __builtin_bit_cast(float, __builtin_amdgcn_update_dpp(xi, xi, CTRL, 0xF, 0xF, false)); }
__device__ __forceinline__ float allreduce16(float x) {
    x += dpp_mov<0x128>(x); x += dpp_mov<0x124>(x); x += dpp_mov<0x122>(x); x += dpp_mov<0x121>(x); return x;
}

namespace pg8 {
constexpr int BM = 256, BK = 64, HALF = 128, HTB = HALF * BK * 2, STAGE_BYTES = 8 * HTB, NXCD = 8, WGM = 8;
__host__ __device__ __forceinline__ int lds_byte(int r, int c) { const int st = (r >> 4) * 2 + (c >> 5), rr = r & 15, cc = c & 31, ob = rr * 64 + cc * 2; return st * 1024 + (ob ^ (((ob >> 9) & 1) << 5)); }
__host__ __device__ __forceinline__ void stage_rc(int b, int& R, int& C) { const int st = b / 1024, sb = b % 1024, swz = sb ^ (((sb >> 9) & 1) << 5); R = (st >> 1) * 16 + swz / 64; C = (st & 1) * 32 + (swz % 64) / 2; }
__host__ __device__ __forceinline__ int perm32(int rho) { const int n = rho >> 4, i = rho & 15; return 8 * (i >> 2) + 4 * n + (i & 3); }

struct Unit { int pm, pn; };

struct StaticOrder {
    int nM, nN, nwg, G, c;
    __device__ void init(int nM_, int nN_, int G_, int c_) { nM = nM_; nN = nN_; nwg = nM * nN; G = G_; c = c_; }
    __device__ bool next(int i, Unit& u) const {
        const long L = (long)i * G + c; if (L >= nwg) return false;
        int wgid = (int)L; { const int q = nwg / NXCD, r = nwg % NXCD, xcd = wgid % NXCD, off = wgid / NXCD; wgid = (xcd < r ? xcd * (q + 1) : r * (q + 1) + (xcd - r) * q) + off; }
        const int nig = WGM * nN, gid = wgid / nig, fm = gid * WGM, gsz = (nM - fm) < WGM ? (nM - fm) : WGM;
        u.pm = fm + ((wgid % nig) % gsz); u.pn = (wgid % nig) / gsz; return true;
    }
};

template <int MODE> struct EpiB {
    static constexpr bool PERM = true;
    bf16_t* O; int ldc; const float* c0; const float* c1; const float* c2; size_t plane;
    __device__ __forceinline__ void operator()(const f32x4 (&acc)[2][2][4][2], const Unit& u, int wr, int wc, int fr, int fq) const {
        const int row0 = u.pm * BM + wr * 64 + fr; int colt = u.pn * BM; bf16_t* base = O; int t = 0;
        if (MODE == 3) { t = colt >> 10; base += (size_t)t * plane; colt &= 1023; }
        const int col0 = colt + wc * 32 + 8 * fq;
        f32x4 cv[2][2];
#pragma unroll
        for (int bj = 0; bj < 2; ++bj)
#pragma unroll
            for (int n = 0; n < 2; ++n) {
                cv[bj][n] = (f32x4){0.f, 0.f, 0.f, 0.f};
                if (MODE == 2) cv[bj][n] = *(const f32x4*)(c0 + col0 + bj * HALF + 4 * n);
                if (MODE == 3) { const float* b = (t == 0) ? c0 : (t == 1) ? c1 : (t == 3) ? c2 : nullptr; if (b) cv[bj][n] = *(const f32x4*)(b + col0 + bj * HALF + 4 * n); }
            }
#pragma unroll
        for (int ai = 0; ai < 2; ++ai)
#pragma unroll
            for (int m = 0; m < 4; ++m) { bf16_t* rowp = base + (size_t)(row0 + ai * HALF + m * 16) * ldc + col0;
#pragma unroll
                for (int bj = 0; bj < 2; ++bj) { f32x4 v0 = acc[ai][bj][m][0], v1 = acc[ai][bj][m][1];
                    if (MODE == 1) {
#pragma unroll
                        for (int j = 0; j < 4; ++j) { const float a = fmaxf(v0[j], 0.f), b = fmaxf(v1[j], 0.f); v0[j] = a * a; v1[j] = b * b; } }
                    if (MODE == 2) { v0 = v0 * cv[bj][0]; v1 = v1 * cv[bj][1]; }
                    if (MODE == 3) { v0 = v0 + cv[bj][0]; v1 = v1 + cv[bj][1];
                        if (t == 0) {
#pragma unroll
                            for (int j = 0; j < 4; ++j) { v0[j] = -0.6065306597f * sigm(v0[j]); v1[j] = -0.6065306597f * sigm(v1[j]); } }
                        else if (t != 2) {
#pragma unroll
                            for (int j = 0; j < 4; ++j) { v0[j] = sigm(v0[j]); v1[j] = sigm(v1[j]); } }
                    }
                    v4u w; w.x = cvt_pk_bf16(v0[0], v0[1]); w.y = cvt_pk_bf16(v0[2], v0[3]); w.z = cvt_pk_bf16(v1[0], v1[1]); w.w = cvt_pk_bf16(v1[2], v1[3]);
                    *(v4u*)(rowp + bj * HALF) = w; } }
    }
};
template <bool GATE> struct EpiR {
    static constexpr bool PERM = false;
    static constexpr int RB = GATE ? 2 : 4;
    const float* base; float* out; const bf16_t* pp; int ldc;
    __device__ __forceinline__ void operator()(const f32x4 (&acc)[2][2][4][2], const Unit& u, int wr, int wc, int fr, int fq) const {
        const int row0 = u.pm * BM + wr * 64 + fr, col0 = u.pn * BM + wc * 32 + 4 * fq;
#pragma unroll
        for (int aim = 0; aim < 8 / RB; ++aim) { const int ai = (aim * RB) >> 2, m0 = (aim * RB) & 3;
            f32x4 bs[RB][2][2]; v2u q[RB][2][2];
#pragma unroll
            for (int mm = 0; mm < RB; ++mm) { const size_t off = (size_t)(row0 + ai * HALF + (m0 + mm) * 16) * ldc + col0;
#pragma unroll
                for (int bj = 0; bj < 2; ++bj)
#pragma unroll
                    for (int n = 0; n < 2; ++n) { bs[mm][bj][n] = *(const f32x4*)(base + off + bj * HALF + n * 16); if (GATE) q[mm][bj][n] = *(const v2u*)(pp + off + bj * HALF + n * 16); } }
#pragma unroll
            for (int mm = 0; mm < RB; ++mm) { const int m = m0 + mm; const size_t off = (size_t)(row0 + ai * HALF + m * 16) * ldc + col0;
#pragma unroll
                for (int bj = 0; bj < 2; ++bj)
#pragma unroll
                    for (int n = 0; n < 2; ++n) { f32x4 a = acc[ai][bj][m][n];
                        if (GATE) {
                            a[0] = sigm(a[0]) * __uint_as_float(q[mm][bj][n].x << 16); a[1] = sigm(a[1]) * __uint_as_float(q[mm][bj][n].x & 0xffff0000u);
                            a[2] = sigm(a[2]) * __uint_as_float(q[mm][bj][n].y << 16); a[3] = sigm(a[3]) * __uint_as_float(q[mm][bj][n].y & 0xffff0000u); }
                        *(f32x4*)(out + off + bj * HALF + n * 16) = bs[mm][bj][n] + a; } }
            asm volatile("" ::: "memory"); }
    }
};

struct Job { const bf16_t* A; const bf16_t* Bt; int lda, ldb, K, a_pn_step, nM, nN, mode;
             bf16_t* O; int ldc; const float* c0; const float* c1; const float* c2; const float* base; float* out; const bf16_t* pp; };
__device__ __forceinline__ void run_epi(const Job& J, const f32x4 (&acc)[2][2][4][2], const Unit& u, int wr, int wc, int fr, int fq) {
    switch (J.mode) {
    case 0: { EpiB<0> E{J.O, J.ldc, nullptr, nullptr, nullptr, 0}; E(acc, u, wr, wc, fr, fq); } break;
    case 1: { EpiB<1> E{J.O, J.ldc, nullptr, nullptr, nullptr, 0}; E(acc, u, wr, wc, fr, fq); } break;
    case 2: { EpiB<2> E{J.O, J.ldc, J.c0, nullptr, nullptr, 0}; E(acc, u, wr, wc, fr, fq); } break;
    case 3: { EpiB<3> E{J.O, J.ldc, J.c0, J.c1, J.c2, PLANE}; E(acc, u, wr, wc, fr, fq); } break;
    case 4: { EpiR<false> E{J.base, J.out, nullptr, J.ldc}; E(acc, u, wr, wc, fr, fq); } break;
    default: { EpiR<true> E{J.base, J.out, J.pp, J.ldc}; E(acc, u, wr, wc, fr, fq); } break;
    }
}
__device__ __forceinline__ void gemm_phase(LAS unsigned char* lds, const Job& J, const StaticOrder& S, const int tid) {
    const int wid = __builtin_amdgcn_readfirstlane(tid >> 6), lane = tid & 63, wr = wid >> 2, wc = wid & 3, fr = lane & 15, fq = lane >> 4;
    const int K = J.K, nt = K / BK;
    unsigned voffA[2], voffB[2];
#pragma unroll
    for (int i = 0; i < 2; ++i) { int R, C; stage_rc(tid * 16 + i * 8192, R, C); const int Rb = (J.mode < 4) ? ((R & ~31) + perm32(R & 31)) : R;
        voffA[i] = (unsigned)(R * J.lda + C) * 2u; voffB[i] = (unsigned)(Rb * J.ldb + C) * 2u; }
    const size_t kstep = (size_t)(BK * 2);
    const size_t hstepA = (size_t)HALF * J.lda * 2, hstepB = (size_t)HALF * J.ldb * 2;
    const size_t tstepA = 2 * hstepA, tstepB = 2 * hstepB;
    const unsigned ldsw = (unsigned)wid * 1024u;
    const int aoff = lds_byte(wr * 64 + fr, fq * 8), boff = lds_byte(wc * 32 + fr, fq * 8);
#define PG8_SA(b, h) (((b) * 2 + (h)) * HTB)
#define PG8_SB(b, h) ((4 + (b) * 2 + (h)) * HTB)
#define PG8_STAGE(bufoff, gbase, voff) do { _Pragma("unroll") for (int _i = 0; _i < 2; ++_i) \
        __builtin_amdgcn_global_load_lds((const unsigned*)((const char*)(gbase) + (voff)[_i]), (LAS unsigned*)(lds + (bufoff) + ldsw + _i * 8192), 16, 0, 0); } while (0)
#define PG8_LDA(dst, b, h) do { _Pragma("unroll") for (int m = 0; m < 4; ++m) _Pragma("unroll") for (int k = 0; k < 2; ++k) dst[m][k] = *(const LAS bf16x8*)(lds + PG8_SA(b, h) + aoff + m * 2048 + k * 1024); } while (0)
#define PG8_LDB(dst, b, h) do { _Pragma("unroll") for (int n = 0; n < 2; ++n) _Pragma("unroll") for (int k = 0; k < 2; ++k) dst[n][k] = *(const LAS bf16x8*)(lds + PG8_SB(b, h) + boff + n * 2048 + k * 1024); } while (0)
#define PG8_MMA(ai, bj, At, Bt) do { __builtin_amdgcn_s_setprio(1); _Pragma("unroll") for (int m = 0; m < 4; ++m) _Pragma("unroll") for (int n = 0; n < 2; ++n) _Pragma("unroll") for (int k = 0; k < 2; ++k) \
        acc[ai][bj][m][n] = __builtin_amdgcn_mfma_f32_16x16x32_bf16(Bt[n][k], At[m][k], acc[ai][bj][m][n], 0, 0, 0); __builtin_amdgcn_s_setprio(0); } while (0)
#define PG8_WAIT_V(n) asm volatile("s_waitcnt vmcnt(" #n ")" ::: "memory")
#define PG8_WAIT_L(n) asm volatile("s_waitcnt lgkmcnt(" #n ")" ::: "memory")
#define PG8_BAR __builtin_amdgcn_s_barrier()
#define PG8_SCHED __builtin_amdgcn_sched_barrier(0)
    Unit cur, nxt; int ui = 0;
    if (!S.next(0, cur)) return;
    f32x4 acc[2][2][4][2];
#pragma unroll
    for (int a = 0; a < 2; ++a)
#pragma unroll
        for (int b = 0; b < 2; ++b)
#pragma unroll
            for (int m = 0; m < 4; ++m)
#pragma unroll
                for (int n = 0; n < 2; ++n) acc[a][b][m][n] = (f32x4){0.f, 0.f, 0.f, 0.f};
    bf16x8 At[4][2], B0[2][2], B1[2][2];
    const char* cA = (const char*)J.A + (size_t)cur.pm * tstepA + (size_t)cur.pn * J.a_pn_step * 2; const char* cB = (const char*)J.Bt + (size_t)cur.pn * tstepB;
    PG8_STAGE(PG8_SB(0, 0), cB, voffB); PG8_STAGE(PG8_SB(0, 1), cB + hstepB, voffB); PG8_STAGE(PG8_SA(0, 0), cA, voffA); PG8_STAGE(PG8_SA(0, 1), cA + hstepA, voffA);
    if (wr == 1) PG8_BAR;
    PG8_WAIT_V(2); PG8_BAR;
    PG8_STAGE(PG8_SB(1, 0), cB + kstep, voffB); PG8_STAGE(PG8_SA(1, 0), cA + kstep, voffA); PG8_STAGE(PG8_SB(1, 1), cB + hstepB + kstep, voffB);
    PG8_WAIT_V(6); PG8_BAR;
    for (;;) {
        const bool has_next = S.next(ui + 1, nxt);
        const char* nA = has_next ? (const char*)J.A + (size_t)nxt.pm * tstepA + (size_t)nxt.pn * J.a_pn_step * 2 : cA; const char* nB = has_next ? (const char*)J.Bt + (size_t)nxt.pn * tstepB : cB;
        for (int t = 0; t < nt; t += 2) {
            const bool last = (t == nt - 2);
            const char* a1 = cA + (size_t)(t + 1) * kstep;
            const char* a2 = last ? nA : cA + (size_t)(t + 2) * kstep; const char* b2 = last ? nB : cB + (size_t)(t + 2) * kstep;
            const char* a3 = a2 + kstep; const char* b3 = b2 + kstep;
            PG8_LDB(B0, 0, 0); PG8_LDB(B1, 0, 1); PG8_SCHED; PG8_LDA(At, 0, 0); PG8_STAGE(PG8_SA(1, 1), a1 + hstepA, voffA);
            PG8_WAIT_V(8); PG8_WAIT_L(0); PG8_BAR; PG8_MMA(0, 0, At, B0); PG8_MMA(0, 1, At, B1); PG8_BAR; PG8_SCHED;
            PG8_LDA(At, 0, 1); PG8_STAGE(PG8_SB(0, 0), b2, voffB); PG8_STAGE(PG8_SB(0, 1), b2 + hstepB, voffB); PG8_STAGE(PG8_SA(0, 0), a2, voffA);
            PG8_WAIT_V(8); PG8_WAIT_L(0); PG8_BAR; PG8_MMA(1, 0, At, B0); PG8_MMA(1, 1, At, B1); PG8_BAR; PG8_SCHED;
            PG8_LDB(B0, 1, 0); PG8_LDB(B1, 1, 1); PG8_SCHED; PG8_LDA(At, 1, 0); PG8_STAGE(PG8_SA(0, 1), a2 + hstepA, voffA);
            PG8_WAIT_V(8); PG8_WAIT_L(0); PG8_BAR; PG8_MMA(0, 0, At, B0); PG8_MMA(0, 1, At, B1); PG8_BAR; PG8_SCHED;
            PG8_LDA(At, 1, 1); PG8_STAGE(PG8_SB(1, 0), b3, voffB); PG8_STAGE(PG8_SB(1, 1), b3 + hstepB, voffB); PG8_STAGE(PG8_SA(1, 0), a3, voffA);
            PG8_WAIT_V(8); PG8_WAIT_L(0); PG8_BAR; PG8_MMA(1, 0, At, B0); PG8_MMA(1, 1, At, B1); PG8_BAR; PG8_SCHED;
        }
        if (wr == 0) PG8_BAR;
        run_epi(J, acc, cur, wr, wc, fr, fq);
        if (!has_next) break;
#pragma unroll
        for (int a = 0; a < 2; ++a)
#pragma unroll
            for (int b = 0; b < 2; ++b)
#pragma unroll
                for (int m = 0; m < 4; ++m)
#pragma unroll
                    for (int n = 0; n < 2; ++n) acc[a][b][m][n] = (f32x4){0.f, 0.f, 0.f, 0.f};
        cur = nxt; cA = nA; cB = nB; ++ui;
        if (wr == 1) PG8_BAR;
    }
    PG8_WAIT_V(0);
    PG8_BAR;
#undef PG8_SA
#undef PG8_SB
#undef PG8_STAGE
#undef PG8_LDA
#undef PG8_LDB
#undef PG8_MMA
#undef PG8_WAIT_V
#undef PG8_WAIT_L
#undef PG8_BAR
#undef PG8_SCHED
}
}

struct Args { const float* in[29]; float* out; unsigned char* ws; int ph_lo, ph_hi; };
typedef const __attribute__((address_space(4))) Args* ArgsP;
enum { I_X = 0, I_P, I_ATTN_NORM, I_W_IN, I_MU_SHIFT, I_W_VRES_DN, I_MU_VRES, I_V0, I_V_UP, I_POOL_W, I_POOL_SCALE, I_W0, I_W_UP, I_A0, I_A_UP, I_G_UP,
       I_K_K, I_K_A, I_R_K, I_GN_G, I_GN_B, I_W_OUT, I_MLP_NORM, I_W_FFN_UP, I_W_FFN_DOWN, I_PLE_NORM, I_W_PLE_GATE, I_W_PLE_PROJ, I_FINAL_NORM };

__device__ __forceinline__ void p0_transpose_item(const float* W, int N, bf16_t* WT, int ldd, int row_off, LAS float* scr, int item, int nblk, int lane) {
    const int kb = item / nblk, nb = item % nblk, k0 = 64 * kb, n0 = 32 * nb;
#pragma unroll 8
    for (int i = 0; i < 32; ++i) { const int kk = 2 * i + (lane >> 5); scr[kk * 33 + (lane & 31)] = W[(size_t)(k0 + kk) * N + n0 + (lane & 31)]; }
    asm volatile("s_waitcnt lgkmcnt(0)" ::: "memory");
    const int c = lane & 7;
#pragma unroll
    for (int j = 0; j < 4; ++j) { const int n = (lane >> 3) + 8 * j; const LAS float* s = scr + (8 * c) * 33 + n;
        v4u o; o.x = cvt_pk_bf16(s[0 * 33], s[1 * 33]); o.y = cvt_pk_bf16(s[2 * 33], s[3 * 33]); o.z = cvt_pk_bf16(s[4 * 33], s[5 * 33]); o.w = cvt_pk_bf16(s[6 * 33], s[7 * 33]);
        *(v4u*)(WT + (size_t)(row_off + n0 + n) * ldd + k0 + 8 * c) = o; }
    asm volatile("s_waitcnt lgkmcnt(0)" ::: "memory");
}
__device__ __forceinline__ void cvt_job(const float* W, int K, int N, bf16_t* WT, int ldd, int row_off, LAS float* scr, int gw, int NW, int lane) {
    const int nblk = N / 32, nit = (K / 64) * nblk;
    for (int it = gw; it < nit; it += NW) p0_transpose_item(W, N, WT, ldd, row_off, scr, it, nblk, lane);
}
__device__ __forceinline__ void phase_convert(ArgsP a, LAS unsigned char* lds, const int tid, const int bx) {
    const int lane = tid & 63, wave = tid >> 6, G = gridDim.x;
    const int gw = bx * 8 + wave, NW = G * 8; const size_t gt = (size_t)bx * 512 + tid, NT = (size_t)G * 512;
    LAS float* scr = (LAS float*)(lds + wave * 8448);
    unsigned char* ws = a->ws;
    for (int l = 0; l < DEPTH; ++l) {
        bf16_t* win = (bf16_t*)(ws + WS_WIN) + (size_t)l * NZ * DM;
        cvt_job(a->in[I_W_IN] + (size_t)l * DM * INW, DM, INW, win, DM, 0, scr, gw, NW, lane);
        if (l > 0) cvt_job(a->in[I_W_VRES_DN] + (size_t)(l - 1) * DM * 32, DM, 32, win, DM, INW, scr, gw, NW, lane);
        { const int r0 = (l == 0) ? INW : INW + 32; const size_t n16 = (size_t)(NZ - r0) * DM / 8; v4u* z = (v4u*)(win + (size_t)r0 * DM);
          for (size_t i = gt; i < n16; i += NT) z[i] = (v4u){0u, 0u, 0u, 0u}; }
        cvt_job(a->in[I_W_OUT] + (size_t)l * DM * DM, DM, DM, (bf16_t*)(ws + WS_WOUT) + (size_t)l * DM * DM, DM, 0, scr, gw, NW, lane);
        cvt_job(a->in[I_W_FFN_UP] + (size_t)l * DM * DFF, DM, DFF, (bf16_t*)(ws + WS_WUP) + (size_t)l * DFF * DM, DM, 0, scr, gw, NW, lane);
        cvt_job(a->in[I_W_FFN_DOWN] + (size_t)l * DFF * DM, DFF, DM, (bf16_t*)(ws + WS_WDN) + (size_t)l * DM * DFF, DFF, 0, scr, gw, NW, lane);
        cvt_job(a->in[I_W_PLE_GATE] + (size_t)l * DM * DM, DM, DM, (bf16_t*)(ws + WS_WGATE) + (size_t)l * DM * DM, DM, 0, scr, gw, NW, lane);
        cvt_job(a->in[I_W_PLE_PROJ] + (size_t)l * DPLE * DM, DPLE, DM, (bf16_t*)(ws + WS_WPROJ) + (size_t)l * DM * DPLE, DPLE, 0, scr, gw, NW, lane);
        for (int gi = 0; gi < 4; ++gi)
            cvt_job(a->in[I_POOL_W] + ((size_t)l * 4 + gi) * 256 * 256, 256, 256, (bf16_t*)(ws + WS_WPOOL) + (size_t)l * 1024 * 256, 256, gi * 256, scr, gw, NW, lane);
        { bf16_t* wl = (bf16_t*)(ws + WS_WLORA) + (size_t)l * 4096 * KL;
          const float* wu = a->in[I_W_UP] + (size_t)l * 64 * RW; const float* au = a->in[I_A_UP] + (size_t)l * 64 * RW; const float* gu = a->in[I_G_UP] + (size_t)l * 160 * RW;
          const float* vu = a->in[I_V_UP] + (size_t)(l > 0 ? l - 1 : 0) * 32 * RW;
          for (size_t idx = gt; idx < (size_t)4096 * KL; idx += NT) { const int n = (int)(idx / KL), k = (int)(idx % KL), t = n >> 10, col = n & 1023; float v = 0.f;
              if (t == 0) { if (k < 64) v = wu[(size_t)k * RW + col]; }
              else if (t == 1) { if (k >= 64 && k < 128) v = au[(size_t)(k - 64) * RW + col]; }
              else if (t == 2) { if (k >= 128 && k < 288) v = gu[(size_t)(k - 128) * RW + col]; }
              else { if (l > 0 && k >= 288 && k < 320) v = vu[(size_t)(k - 288) * RW + col]; }
              wl[idx] = (bf16_t)(cvt_pk_bf16(v, 0.f) & 0xffffu); } }
    }
    { const float* p = a->in[I_P]; bf16_t* pb = (bf16_t*)(ws + WS_PB); const size_t n8 = (size_t)DEPTH * M * DPLE / 8;
      for (size_t i = gt; i < n8; i += NT) { const f32x8 v = ld8f(p + i * 8); *(v4u*)(pb + i * 8) = pk8(v); } }
}

__device__ __forceinline__ void phase_norm(const float* x, const float* g, bf16_t* H, float* outf, const int tid, const int bx) {
    const bool F32OUT = (outf != nullptr);
    const int lane = tid & 63, wave = tid >> 6; const int gw = bx * 8 + wave, NW = gridDim.x * 8;
    f32x4 gv[8];
#pragma unroll
    for (int j = 0; j < 8; ++j) gv[j] = ((const f32x4*)g)[lane + 64 * j];
    for (int row = gw; row < M; row += NW) {
        const f32x4* xr = (const f32x4*)(x + (size_t)row * DM) + lane;
        f32x4 v[8]; float s = 0.f;
#pragma unroll
        for (int j = 0; j < 8; ++j) { v[j] = xr[64 * j]; s += (v[j][0] * v[j][0] + v[j][1] * v[j][1]) + (v[j][2] * v[j][2] + v[j][3] * v[j][3]); }
        s = wave_sum(s);
        const float rs = rsqrtf(s * (1.0f / DM) + NORM_EPS);
#pragma unroll
        for (int j = 0; j < 8; ++j) { const f32x4 o = v[j] * rs * gv[j];
            if (F32OUT) ((f32x4*)(outf + (size_t)row * DM))[lane + 64 * j] = o;
            else { v2u w; w.x = cvt_pk_bf16(o[0], o[1]); w.y = cvt_pk_bf16(o[2], o[3]); ((v2u*)(H + (size_t)row * DM))[lane + 64 * j] = w; } }
    }
}

template <int WIN> __device__ __forceinline__ v4u pool_diff(const bf16_t* zp, int tpos) {
    const f32x8 u = up8(*(const v4u*)zp);
    v4u raw[WIN - 1];
#pragma unroll
    for (int q = 1; q < WIN; ++q) raw[q - 1] = *(const v4u*)(zp - (size_t)((q <= tpos) ? q : 0) * NZ);
    f32x8 s = u;
#pragma unroll
    for (int q = 1; q < WIN; ++q) { const float msk = (q <= tpos) ? 1.0f : 0.0f; s = s + up8(raw[q - 1]) * msk; }
    const int cnt = (tpos + 1 < WIN) ? tpos + 1 : WIN;
    return pk8(s * (1.0f / (float)cnt) - u);
}
__device__ __forceinline__ void phase_prepa(ArgsP a, int l, const int tid, const int bx) {
    const int G = gridDim.x;
    const bf16_t* Z = (const bf16_t*)(a->ws + WS_Z); bf16_t* DP = (bf16_t*)(a->ws + WS_DPOOL); bf16_t* AL = (bf16_t*)(a->ws + WS_ALORA);
    const float* mus = a->in[I_MU_SHIFT] + (size_t)l * SHIFTW; const float* muv = a->in[I_MU_VRES] + (size_t)(l > 0 ? l - 1 : 0) * 32;
    const int wave = __builtin_amdgcn_readfirstlane(tid >> 6), lane = tid & 63;
    const int gi = wave & 3, prow = (wave >> 2) * 2 + (lane >> 5), pcol = gi * 256 + 8 * (lane & 31);
    const int arow = tid / 48, acol = 8 * (tid % 48);
    for (int unit = bx; unit < M / 4; unit += G) {
        { const int row = unit * 4 + prow, tpos = row & (SEQ - 1);
          const bf16_t* zp = Z + (size_t)row * NZ + pcol; v4u d;
          if (gi == 0) d = pool_diff<2>(zp, tpos); else if (gi == 1) d = pool_diff<4>(zp, tpos); else if (gi == 2) d = pool_diff<8>(zp, tpos); else d = pool_diff<16>(zp, tpos);
          *(v4u*)(DP + (size_t)row * RW + pcol) = d; }
        if (tid < 192) {
            const int row = unit * 4 + arow, tpos = row & (SEQ - 1), c = acol; f32x8 o;
#pragma unroll
            for (int j = 0; j < 8; ++j) o[j] = 0.f;
            if (c < 288 || (c < 320 && l > 0)) {
                const bf16_t* zp = Z + (size_t)row * NZ + 4096 + c;
                const f32x8 zc = up8(*(const v4u*)zp); f32x8 zq;
                if (tpos > 0) zq = up8(*(const v4u*)(zp - NZ)); else {
#pragma unroll
                    for (int j = 0; j < 8; ++j) zq[j] = 0.f; }
                const f32x8 mu = (c < 288) ? ld8f(mus + 3072 + c) : ld8f(muv + (c - 288));
                const f32x8 zs = zc + (zq - zc) * mu;
                if (c < 64) {
#pragma unroll
                    for (int j = 0; j < 8; ++j) o[j] = 1.0f - 2.0f * __builtin_amdgcn_rcpf(1.0f + __expf(2.0f * zs[j])); }
                else if (c >= 128 && c < 288) {
#pragma unroll
                    for (int j = 0; j < 8; ++j) o[j] = sigm(zs[j]); }
                else o = zs;
            }
            *(v4u*)(AL + (size_t)row * KL + c) = pk8(o);
        }
    }
}

constexpr int TC = 32, STEPB = 1344, BUFB = TC * STEPB, YBB = TC * 16 * 4;
struct ScanRaw { v4u zr, zrp, zk, zkp, zv, zvp, ld, aa, vg, vf; };
__device__ __forceinline__ void scan_unit(ArgsP a, int l, int u, LAS unsigned char* lds, const int tid) {
    const int wave = __builtin_amdgcn_readfirstlane(tid >> 6), lane = tid & 63;
    const int bh = u >> 2, rg = u & 3, b = bh >> 4, h = bh & 15;
    const bool hasv = l > 0;
    constexpr int NC = SEQ / TC;
    const size_t rowbase = (size_t)b * SEQ;
    if (wave < 4) {
        const int rowl = 4 * wave + (lane >> 4), j = lane & 15;
        f32x2 s01 = {0.f, 0.f}, s23 = {0.f, 0.f};
        for (int c = 0; c < NC; ++c) {
            __syncthreads();
            const LAS unsigned char* buf = lds + (c & 1) * BUFB + 16 * j;
            const LAS unsigned char* vb = lds + (c & 1) * BUFB + 1280 + 4 * rowl;
            LAS float* yb = (LAS float*)(lds + 2 * BUFB + (c & 1) * YBB) + rowl + (15 - j) * 16;
            f32x4 R[3], W[3], K[3], A[3], B[3]; float V[3];
#define SC_LD(sl, tl) do { R[sl] = *(const LAS f32x4*)(buf + (tl) * STEPB); W[sl] = *(const LAS f32x4*)(buf + (tl) * STEPB + 256); K[sl] = *(const LAS f32x4*)(buf + (tl) * STEPB + 512); \
                A[sl] = *(const LAS f32x4*)(buf + (tl) * STEPB + 768); B[sl] = *(const LAS f32x4*)(buf + (tl) * STEPB + 1024); V[sl] = *(const LAS float*)(vb + (tl) * STEPB); } while (0)
            SC_LD(0, 0); SC_LD(1, 1);
            float yprev = 0.f, ysel = 0.f;
#pragma unroll
            for (int i = 0; i < TC; ++i) {
                const int sl = i % 3;
                if (i + 2 < TC) SC_LD((i + 2) % 3, i + 2);
                const f32x2 vv = {V[sl], V[sl]};
                f32x2 pp = s01 * (f32x2){A[sl][0], A[sl][1]}; pp = s23 * (f32x2){A[sl][2], A[sl][3]} + pp;
                float p = pp[0] + pp[1];
                f32x2 t01 = vv * (f32x2){K[sl][0], K[sl][1]}, t23 = vv * (f32x2){K[sl][2], K[sl][3]};
                t01 = s01 * (f32x2){W[sl][0], W[sl][1]} + t01; t23 = s23 * (f32x2){W[sl][2], W[sl][3]} + t23;
                if (i > 0) {
                    p += dpp1<0x128>(p); yprev += dpp1<0x128>(yprev);
                    p += dpp1<0x124>(p); yprev += dpp1<0x124>(yprev);
                    p += dpp1<0x122>(p); yprev += dpp1<0x122>(yprev);
                    p += dpp1<0x121>(p); yprev += dpp1<0x121>(yprev);
                    ysel = __builtin_bit_cast(float, __builtin_amdgcn_update_dpp(__builtin_bit_cast(int, yprev), __builtin_bit_cast(int, ysel), 0x111, 0xF, 0xF, false));
                    if ((i & 15) == 0) yb[((i >> 4) - 1) * 256] = ysel;
                } else {
                    p += dpp1<0x128>(p); p += dpp1<0x124>(p); p += dpp1<0x122>(p); p += dpp1<0x121>(p);
                }
                const f32x2 pv = {p, p};
                s01 = pv * (f32x2){B[sl][0], B[sl][1]} + t01; s23 = pv * (f32x2){B[sl][2], B[sl][3]} + t23;
                f32x2 yy = s01 * (f32x2){R[sl][0], R[sl][1]}; yy = s23 * (f32x2){R[sl][2], R[sl][3]} + yy;
                yprev = yy[0] + yy[1];
            }
            yprev += dpp1<0x128>(yprev); yprev += dpp1<0x124>(yprev); yprev += dpp1<0x122>(yprev); yprev += dpp1<0x121>(yprev);
            ysel = __builtin_bit_cast(float, __builtin_amdgcn_update_dpp(__builtin_bit_cast(int, yprev), __builtin_bit_cast(int, ysel), 0x111, 0xF, 0xF, false));
            yb[(TC / 16 - 1) * 256] = ysel;
#undef SC_LD
        }
        __syncthreads();
    } else {
        const int ltid = tid - 256, tl = ltid >> 3, cgp = ltid & 7;
        const int col0 = h * HS + 8 * cgp;
        const bf16_t* Z = (const bf16_t*)(a->ws + WS_Z); const bf16_t* PL = (const bf16_t*)(a->ws + WS_PLANES); const bf16_t* VF = (const bf16_t*)(a->ws + WS_VFIRST);
        bf16_t* Y = (bf16_t*)(a->ws + WS_DPOOL);
        const float* mus = a->in[I_MU_SHIFT] + (size_t)l * SHIFTW;
        const f32x8 mur = ld8f(mus + col0), muk = ld8f(mus + 1024 + col0), muv = ld8f(mus + 2048 + col0);
        const f32x8 kkc = ld8f(a->in[I_K_K] + (size_t)l * RW + col0), kac = ld8f(a->in[I_K_A] + (size_t)l * RW + col0);
        const bool vmine = (cgp >> 1) == rg;
#define SCAN_LOAD(R, cc) do { const int t_ = (cc) * TC + tl; const size_t row_ = rowbase + t_; const size_t rowp_ = (t_ > 0) ? row_ - 1 : row_; \
            const bf16_t* z_ = Z + row_ * NZ + col0; const bf16_t* zq_ = Z + rowp_ * NZ + col0; \
            R.zr = *(const v4u*)(z_ + 1024); R.zk = *(const v4u*)(z_ + 2048); R.zv = *(const v4u*)(z_ + 3072); \
            R.zrp = *(const v4u*)(zq_ + 1024); R.zkp = *(const v4u*)(zq_ + 2048); R.zvp = *(const v4u*)(zq_ + 3072); \
            R.ld = *(const v4u*)(PL + row_ * RW + col0); R.aa = *(const v4u*)(PL + PLANE + row_ * RW + col0); \
            if (hasv) { R.vg = *(const v4u*)(PL + 3 * PLANE + row_ * RW + col0); R.vf = *(const v4u*)(VF + row_ * RW + col0); } else { R.vg = R.ld; R.vf = R.ld; } } while (0)
#define SCAN_FLUSH(cc) do { const LAS float* yb_ = (const LAS float*)(lds + 2 * BUFB + ((cc) & 1) * YBB) + tl * 16 + 2 * cgp; \
            const unsigned w_ = cvt_pk_bf16(yb_[0], yb_[1]); *(unsigned*)(Y + (rowbase + (size_t)(cc) * TC + tl) * RW + h * HS + 16 * rg + 2 * cgp) = w_; } while (0)
        ScanRaw nx; SCAN_LOAD(nx, 0);
        for (int c = 0; c < NC; ++c) {
            const ScanRaw cu = nx;
            if (c + 1 < NC) SCAN_LOAD(nx, c + 1);
            const int t = c * TC + tl;
            const f32x8 zr = up8(cu.zr), zk = up8(cu.zk), zv = up8(cu.zv);
            f32x8 zrp = up8(cu.zrp), zkp = up8(cu.zkp), zvp = up8(cu.zvp);
            if (t == 0) {
#pragma unroll
                for (int q = 0; q < 8; ++q) { zrp[q] = 0.f; zkp[q] = 0.f; zvp[q] = 0.f; } }
            const f32x8 r = zr + (zrp - zr) * mur, k = zk + (zkp - zk) * muk; f32x8 v = zv + (zvp - zv) * muv;
            const f32x8 ld = up8(cu.ld), av = up8(cu.aa);
            if (hasv) v = v + (up8(cu.vf) - v) * up8(cu.vg);
            const f32x8 kk = k * kkc;
            float n2 = sum8(kk * kk); n2 += __shfl_xor(n2, 1); n2 += __shfl_xor(n2, 2); n2 += __shfl_xor(n2, 4);
            const float inv = 1.0f / fmaxf(sqrtf(n2), 1e-12f);
            const f32x8 kkn = kk * inv;
            const f32x8 kadj = k * (1.0f + (av - 1.0f) * kac);
            f32x8 dec;
#pragma unroll
            for (int q = 0; q < 8; ++q) dec[q] = __expf(ld[q]);
            const f32x8 avec = -kkn, bvec = kkn * av;
            LAS unsigned char* dst = lds + (c & 1) * BUFB + tl * STEPB + cgp * 32;
#define ST8(off, val) do { *(LAS f32x4*)(dst + (off)) = (f32x4){val[0], val[1], val[2], val[3]}; *(LAS f32x4*)(dst + (off) + 16) = (f32x4){val[4], val[5], val[6], val[7]}; } while (0)
            ST8(0, r); ST8(256, dec); ST8(512, kadj); ST8(768, avec); ST8(1024, bvec);
            if (vmine) { LAS unsigned char* dv = lds + (c & 1) * BUFB + tl * STEPB + 1280 + (cgp & 1) * 32;
                *(LAS f32x4*)(dv) = (f32x4){v[0], v[1], v[2], v[3]}; *(LAS f32x4*)(dv + 16) = (f32x4){v[4], v[5], v[6], v[7]}; }
#undef ST8
            if (c >= 2) SCAN_FLUSH(c - 2);
            __syncthreads();
        }
        __syncthreads();
        SCAN_FLUSH(NC - 2); SCAN_FLUSH(NC - 1);
#undef SCAN_LOAD
#undef SCAN_FLUSH
    }
    __syncthreads();
}

__device__ __forceinline__ void phase_post(ArgsP a, int l, const int tid, const int bx) {
    const int lane = tid & 63, wave = tid >> 6; const int gw = bx * 8 + wave, NW = gridDim.x * 8;
    const bf16_t* Z = (const bf16_t*)(a->ws + WS_Z); const bf16_t* PL = (const bf16_t*)(a->ws + WS_PLANES); bf16_t* VF = (bf16_t*)(a->ws + WS_VFIRST);
    const bf16_t* Y = (const bf16_t*)(a->ws + WS_DPOOL); bf16_t* MIX = (bf16_t*)(a->ws + WS_MIX);
    const float* mus = a->in[I_MU_SHIFT] + (size_t)l * SHIFTW;
    const bool hasv = l > 0;
    for (int it = gw; it < M * 2; it += NW) {
        const int row = it >> 1, h = (it & 1) * 8 + (lane >> 3), col = h * HS + 8 * (lane & 7), tpos = row & (SEQ - 1);
        const bf16_t* z = Z + (size_t)row * NZ + col; const bf16_t* zq = (tpos > 0) ? z - NZ : z;
        const f32x8 zr = up8(*(const v4u*)(z + 1024)), zk = up8(*(const v4u*)(z + 2048)), zv = up8(*(const v4u*)(z + 3072));
        f32x8 zrp = up8(*(const v4u*)(zq + 1024)), zkp = up8(*(const v4u*)(zq + 2048)), zvp = up8(*(const v4u*)(zq + 3072));
        if (tpos == 0) {
#pragma unroll
            for (int q = 0; q < 8; ++q) { zrp[q] = 0.f; zkp[q] = 0.f; zvp[q] = 0.f; } }
        const f32x8 r = zr + (zrp - zr) * ld8f(mus + col), k = zk + (zkp - zk) * ld8f(mus + 1024 + col); f32x8 v = zv + (zvp - zv) * ld8f(mus + 2048 + col);
        const size_t po = (size_t)row * RW + col;
        const f32x8 av = up8(*(const v4u*)(PL + PLANE + po)), gg = up8(*(const v4u*)(PL + 2 * PLANE + po));
        if (hasv) v = v + (up8(*(const v4u*)(VF + po)) - v) * up8(*(const v4u*)(PL + 3 * PLANE + po));
        else *(v4u*)(VF + po) = pk8(v);
        const f32x8 kadj = k * (1.0f + (av - 1.0f) * ld8f(a->in[I_K_A] + (size_t)l * RW + col));
        float bonus = sum8(r * kadj * ld8f(a->in[I_R_K] + (size_t)l * RW + col));
        bonus += __shfl_xor(bonus, 1); bonus += __shfl_xor(bonus, 2); bonus += __shfl_xor(bonus, 4);
        const f32x8 y = up8(*(const v4u*)(Y + po));
        float sm = sum8(y); sm += __shfl_xor(sm, 1); sm += __shfl_xor(sm, 2); sm += __shfl_xor(sm, 4);
        const float mean = sm * (1.0f / 64.0f);
        const f32x8 d = y - mean;
        float vs = sum8(d * d); vs += __shfl_xor(vs, 1); vs += __shfl_xor(vs, 2); vs += __shfl_xor(vs, 4);
        const float rstd = rsqrtf(vs * (1.0f / 64.0f) + GN_EPS);
        const f32x8 o = (d * rstd * ld8f(a->in[I_GN_G] + (size_t)l * RW + col) + ld8f(a->in[I_GN_B] + (size_t)l * RW + col) + bonus * v) * gg;
        *(v4u*)(MIX + (size_t)row * DM + 1024 + col) = pk8(o);
    }
}

#define XB_TMO      128
#define XB_XCNT(j)  (256  + 64 * (j))
#define XB_XSUB(j)  (1280 + 64 * (j))
#define XB_XGEN(j)  (2304 + 64 * (j))
#define XB_TOP      3328
#define XB_TOPGEN   3392
#define XCD_BAR_WORDS 3456
#define XB_SPIN_CAP (1u << 18)

__device__ __forceinline__ unsigned xb_ld(unsigned* p)              { return __hip_atomic_load(p, __ATOMIC_RELAXED, __HIP_MEMORY_SCOPE_AGENT); }
__device__ __forceinline__ unsigned xb_add(unsigned* p, unsigned v) { return __hip_atomic_fetch_add(p, v, __ATOMIC_RELAXED, __HIP_MEMORY_SCOPE_AGENT); }
__device__ __forceinline__ unsigned xb_xcc_id() { return (unsigned)__builtin_amdgcn_s_getreg((3 << 11) | 20) & 0xFu; }
#define XB_SPIN(cond, bar) do { unsigned _sp = 0; while (cond) { __builtin_amdgcn_s_sleep(1); \
    if ((++_sp & 255u) == 0u) { if (xb_ld(&(bar)[XB_TMO])) break; if (_sp > XB_SPIN_CAP) { atomicAdd(&(bar)[XB_TMO], 1u); break; } } } } while (0)

struct XcdBarrier {
    unsigned* bar; unsigned x;
    volatile LAS unsigned* st;
};

__device__ __forceinline__ XcdBarrier xcd_barrier_post(unsigned* bar, volatile LAS unsigned* st) {
    XcdBarrier b; b.bar = bar; b.x = xb_xcc_id(); b.st = st;
    if (threadIdx.x == 0) (void)xb_add(&bar[XB_XCNT(b.x)], 1u);
    return b;
}
__device__ __forceinline__ void xcd_barrier_complete(unsigned* bar, unsigned x, unsigned& nloc, unsigned& nx) {
    const unsigned G = gridDim.x * gridDim.y * gridDim.z;
    unsigned sum, cnt, mine, sp = 0u;
    for (;;) {
        sum = 0u; cnt = 0u; mine = 0u;
#pragma unroll
        for (unsigned j = 0; j < 16; ++j) { const unsigned c = xb_ld(&bar[XB_XCNT(j)]); sum += c; cnt += (c > 0u) ? 1u : 0u; mine = (j == x) ? c : mine; }
        if (sum == G) break;
        __builtin_amdgcn_s_sleep(1);
        if ((++sp & 255u) == 0u) { if (xb_ld(&bar[XB_TMO])) break; if (sp > XB_SPIN_CAP) { atomicAdd(&bar[XB_TMO], 1u); break; } }
    }
    nloc = mine > 0u ? mine : 1u; nx = cnt > 0u ? cnt : 1u;
}

__device__ __forceinline__ void xcd_barrier(const XcdBarrier& b) {
    asm volatile("s_waitcnt vmcnt(0)" ::: "memory");
    __syncthreads();
    if (threadIdx.x == 0) {
        unsigned* bar = b.bar;
        __builtin_amdgcn_s_waitcnt(0);
        unsigned nloc = b.st[0], nx = b.st[1];
        if (nloc == 0u) { xcd_barrier_complete(bar, b.x, nloc, nx); b.st[0] = nloc; b.st[1] = nx; }
        const unsigned old = xb_add(&bar[XB_XSUB(b.x)], 1u);
        const unsigned gen = old / nloc;
        if (old + 1u == (gen + 1u) * nloc) {
            __builtin_amdgcn_fence(__ATOMIC_RELEASE, "agent");
            asm volatile("s_waitcnt vmcnt(0)" ::: "memory");
            const unsigned og = xb_add(&bar[XB_TOP], 1u);
            const unsigned tg = og / nx;
            if (og + 1u == (tg + 1u) * nx) xb_add(&bar[XB_TOPGEN], 1u);
            else XB_SPIN(xb_ld(&bar[XB_TOPGEN]) == tg, bar);
            __builtin_amdgcn_fence(__ATOMIC_ACQUIRE, "agent");
            xb_add(&bar[XB_XGEN(b.x)], 1u);
            asm volatile("s_waitcnt vmcnt(0)" ::: "memory");
        } else {
            XB_SPIN(xb_ld(&bar[XB_XGEN(b.x)]) == gen, bar);
            __builtin_amdgcn_fence(__ATOMIC_ACQUIRE, "agent");
            asm volatile("s_waitcnt vmcnt(0)" ::: "memory");
        }
    }
    __syncthreads();
}


constexpr int N_PHASES = 2 + 12 * DEPTH;
__device__ __forceinline__ bool make_job(ArgsP a, int l, int s, int q, pg8::Job& J) {
    unsigned char* ws = a->ws; float* X = a->out;
    bf16_t* H = (bf16_t*)(ws + WS_H); bf16_t* MIX = (bf16_t*)(ws + WS_MIX); bf16_t* PP = (bf16_t*)(ws + WS_MIX);
    J.a_pn_step = 0; J.nM = M / 256; J.O = nullptr; J.ldc = DM; J.c0 = nullptr; J.c1 = nullptr; J.c2 = nullptr; J.base = nullptr; J.out = nullptr; J.pp = nullptr;
    if (s == 1 && q == 0) { J.A = H; J.Bt = (const bf16_t*)(ws + WS_WIN) + (size_t)l * NZ * DM; J.lda = DM; J.ldb = DM; J.K = DM; J.nN = NZ / 256; J.mode = 0; J.O = (bf16_t*)(ws + WS_Z); J.ldc = NZ; return true; }
    if (s == 3 && q == 0) { J.A = (const bf16_t*)(ws + WS_ALORA); J.Bt = (const bf16_t*)(ws + WS_WLORA) + (size_t)l * 4096 * KL; J.lda = KL; J.ldb = KL; J.K = KL; J.nN = 16; J.mode = 3; J.O = (bf16_t*)(ws + WS_PLANES); J.ldc = RW;
                            J.c0 = a->in[I_W0] + (size_t)l * RW; J.c1 = a->in[I_A0] + (size_t)l * RW; J.c2 = (l > 0) ? a->in[I_V0] + (size_t)(l - 1) * RW : nullptr; return true; }
    if (s == 3 && q == 1) { J.A = (const bf16_t*)(ws + WS_DPOOL); J.Bt = (const bf16_t*)(ws + WS_WPOOL) + (size_t)l * 1024 * 256; J.lda = RW; J.ldb = 256; J.K = 256; J.a_pn_step = 256; J.nN = 4; J.mode = 2; J.O = MIX; J.ldc = DM;
                            J.c0 = a->in[I_POOL_SCALE] + (size_t)l * 1024; return true; }
    if (s == 6 && q == 0) { J.A = MIX; J.Bt = (const bf16_t*)(ws + WS_WOUT) + (size_t)l * DM * DM; J.lda = DM; J.ldb = DM; J.K = DM; J.nN = DM / 256; J.mode = 4; J.base = (l == 0) ? a->in[I_X] : X; J.out = X; return true; }
    if (s == 8 && q == 0) { J.A = H; J.Bt = (const bf16_t*)(ws + WS_WUP) + (size_t)l * DFF * DM; J.lda = DM; J.ldb = DM; J.K = DM; J.nN = DFF / 256; J.mode = 1; J.O = (bf16_t*)(ws + WS_U); J.ldc = DFF; return true; }
    if (s == 8 && q == 1) { J.A = (const bf16_t*)(ws + WS_PB) + (size_t)l * M * DPLE; J.Bt = (const bf16_t*)(ws + WS_WPROJ) + (size_t)l * DM * DPLE; J.lda = DPLE; J.ldb = DPLE; J.K = DPLE; J.nN = DM / 256; J.mode = 0; J.O = PP; J.ldc = DM; return true; }
    if (s == 9 && q == 0) { J.A = (const bf16_t*)(ws + WS_U); J.Bt = (const bf16_t*)(ws + WS_WDN) + (size_t)l * DM * DFF; J.lda = DFF; J.ldb = DFF; J.K = DFF; J.nN = DM / 256; J.mode = 4; J.base = X; J.out = X; return true; }
    if (s == 11 && q == 0) { J.A = H; J.Bt = (const bf16_t*)(ws + WS_WGATE) + (size_t)l * DM * DM; J.lda = DM; J.ldb = DM; J.K = DM; J.nN = DM / 256; J.mode = 5; J.base = X; J.out = X; J.pp = PP; return true; }
    return false;
}
__global__ void __launch_bounds__(512, 2) fwd_megakernel(Args a_byval) {
    ArgsP a = (ArgsP)__builtin_amdgcn_kernarg_segment_ptr();
    extern __shared__ __attribute__((aligned(16))) unsigned char lds_raw[];
    LAS unsigned char* lds = (LAS unsigned char*)lds_raw;
    cg::grid_group grid = cg::this_grid();
    const int G = gridDim.x;
    if (threadIdx.x < 16) ((LAS unsigned*)(lds + BAR_LDS_OFF))[threadIdx.x] = 0u;
    __syncthreads();
    XcdBarrier xbar = xcd_barrier_post((unsigned*)a->ws, (volatile LAS unsigned*)(lds + BAR_LDS_OFF));
    const int ph_lo = a->ph_lo, ph_hi = a->ph_hi;
    for (int ph = ph_lo; ph < ph_hi; ++ph) {
        if (ph > ph_lo) { if (ph == ph_lo + 1) grid.sync(); else xcd_barrier(xbar); }
        asm volatile("" : "+s"(a) :: "memory");
        int tid = threadIdx.x, bx = blockIdx.x; asm volatile("" : "+v"(tid), "+s"(bx));
        float* X = a->out;
        const bool fin = (ph == N_PHASES - 1);
        const int l = (fin || ph == 0) ? 0 : (ph - 1) / 12, s = (ph == 0) ? 13 : fin ? 12 : (ph - 1) % 12;
        int nrep = 1;
        if (PROBE_REP & 1) { if (s == 4) nrep = 2; }
        if (PROBE_REP & 2) { if (s == 1 || s == 3 || s == 8) nrep = 2; }
        if (PROBE_REP & 4) { if (s == 0 || s == 7 || s == 10 || s == 2 || s == 5) nrep = 2; }
        if (PROBE_REP & 8) { if (s == 13) nrep = 2; }
        if (PROBE_REP & 16) { if (ph > ph_lo) xcd_barrier(xbar); }
        for (int rep = 0; rep < nrep; ++rep) {
        if (rep) __syncthreads();
        asm volatile("" : "+v"(tid), "+s"(bx), "+s"(a) :: "memory");
        if (s == 13) { phase_convert(a, lds, tid, bx); }
        else if (s == 0 || s == 7 || s == 10 || s == 12) {
            const float* xs = (s == 0 && l == 0) ? a->in[I_X] : X;
            const float* gp = (s == 0) ? a->in[I_ATTN_NORM] + (size_t)l * DM : (s == 7) ? a->in[I_MLP_NORM] + (size_t)l * DM : (s == 10) ? a->in[I_PLE_NORM] + (size_t)l * DM : a->in[I_FINAL_NORM];
            phase_norm(xs, gp, (bf16_t*)(a->ws + WS_H), fin ? X : nullptr, tid, bx);
        } else if (s == 2) { phase_prepa(a, l, tid, bx); }
        else if (s == 4) { const int vcu = (G % 8 == 0) ? (bx % 8) * (G / 8) + bx / 8 : bx; for (int u = vcu; u < 256; u += G) scan_unit(a, l, u, lds, tid); }
        else if (s == 5) { phase_post(a, l, tid, bx); }
        else {
            for (int q = 0; q < 2; ++q) { pg8::Job J; if (!make_job(a, l, s, q, J)) break;
                pg8::StaticOrder S; S.init(J.nM, J.nN, G, bx); pg8::gemm_phase(lds, J, S, tid); }
            if (PROBE_REP & 128) { if (s == 6 || s == 9 || s == 11) { pg8::Job J; make_job(a, l, s, 0, J); J.mode = 0; J.O = (bf16_t*)(a->ws + (size_t)919 * MiB); J.ldc = DM; __syncthreads();
                pg8::StaticOrder S; S.init(J.nM, J.nN, G, bx); pg8::gemm_phase(lds, J, S, tid); } }
        }
        }
    }
}

extern "C" void kernel_launch(void* const* d_in, const int* in_sizes, int n_in, void* d_out, int out_size, void* d_ws, size_t ws_size, hipStream_t stream) {
    static int grid = 0;
    if (grid == 0) {
        if (n_in != 29 || in_sizes[0] != M * DM || out_size != M * DM || ws_size < WS_END) {
            fprintf(stderr, "kernel_launch: unexpected shapes: n_in %d in0 %d out %d ws %zu (need %zu); nothing launched\n", n_in, n_in > 0 ? in_sizes[0] : -1, out_size, ws_size, (size_t)WS_END); grid = -1; return; }
        int dev = 0, cus = 0, per_cu = 0;
        if (hipGetDevice(&dev) != hipSuccess || hipDeviceGetAttribute(&cus, hipDeviceAttributeMultiprocessorCount, dev) != hipSuccess) { fprintf(stderr, "kernel_launch: device query failed\n"); grid = -1; return; }
        if (hipFuncSetAttribute((const void*)fwd_megakernel, hipFuncAttributeMaxDynamicSharedMemorySize, LDS_BYTES) != hipSuccess) { fprintf(stderr, "kernel_launch: hipFuncSetAttribute failed\n"); grid = -1; return; }
        if (hipOccupancyMaxActiveBlocksPerMultiprocessor(&per_cu, (const void*)fwd_megakernel, 512, LDS_BYTES) != hipSuccess || per_cu < 1) {
            fprintf(stderr, "kernel_launch: occupancy query says %d blocks/CU; using 1\n", per_cu); per_cu = 1; }
        (void)hipGetLastError();
        grid = cus * 1;
        if (grid > 256) grid = 256;
    }
    if (grid < 0) return;
    Args a{};
    for (int i = 0; i < 29; ++i) a.in[i] = (const float*)d_in[i];
    a.out = (float*)d_out; a.ws = (unsigned char*)d_ws;
    if (hipMemsetAsync(d_ws, 0, 65536, stream) != hipSuccess) { fprintf(stderr, "kernel_launch: memset of barrier words failed\n"); return; }
#if MK_PER_PHASE_LAUNCH
    for (int ph = 0; ph < N_PHASES; ++ph) {
        a.ph_lo = ph; a.ph_hi = ph + 1;
        hipLaunchKernelGGL(fwd_megakernel, dim3(grid), dim3(512), LDS_BYTES, stream, a);
    }
#else
    a.ph_lo = 0; a.ph_hi = N_PHASES;
    void* args[] = {&a};
    hipError_t e = hipLaunchCooperativeKernel((const void*)fwd_megakernel, dim3(grid), dim3(512), args, LDS_BYTES, stream);
    if (e != hipSuccess) fprintf(stderr, "cooperative launch failed: %s (grid %d)\n", hipGetErrorString(e), grid);
#endif
}
```

```cpp
#include <hip/hip_runtime.h>
#include <hip/hip_cooperative_groups.h>
#include <cstdio>
#include <cstdint>
namespace cg = cooperative_groups;

#ifndef MK_PER_PHASE_LAUNCH
#define MK_PER_PHASE_LAUNCH 0
#endif

#ifndef PROBE_DUP
#define PROBE_DUP 0
#endif
#define LAS __attribute__((address_space(3)))
typedef unsigned short bf16_t;
typedef short bf16x8 __attribute__((ext_vector_type(8)));
typedef float f32x4 __attribute__((ext_vector_type(4)));
typedef float f32x8 __attribute__((ext_vector_type(8)));
typedef float f32x2 __attribute__((ext_vector_type(2)));
typedef unsigned v4u __attribute__((ext_vector_type(4)));
typedef unsigned v2u __attribute__((ext_vector_type(2)));

constexpr int BATCH = 4, SEQ = 4096, DM = 2048, DEPTH = 4, M = BATCH * SEQ;
constexpr int RW = 1024, HS = 64, NH = 16, DFF = 8192, DPLE = 256;
constexpr int INW = 4384, NZ = 4608, SHIFTW = 3360, KL = 384;
constexpr float NORM_EPS = 1e-6f, GN_EPS = 64e-5f;

constexpr size_t MiB = 1u << 20;
constexpr size_t WS_WIN = 1 * MiB, WS_WOUT = 73 * MiB, WS_WUP = 105 * MiB, WS_WDN = 233 * MiB, WS_WGATE = 361 * MiB, WS_WPROJ = 393 * MiB,
                 WS_WLORA = 397 * MiB, WS_WPOOL = 409 * MiB, WS_PB = 411 * MiB, WS_H = 443 * MiB, WS_MIX = 507 * MiB  ,
                 WS_DPOOL = 571 * MiB  , WS_ALORA = 603 * MiB, WS_VFIRST = 615 * MiB, WS_Z = 647 * MiB, WS_PLANES = 791 * MiB,
                 WS_U = 647 * MiB  , WS_XQ = 919 * MiB, WS_SS = 983 * MiB  , WS_END = 985 * MiB;
typedef unsigned long long u64;
constexpr float SS_SCALE = 1048576.0f, SS_INV = 1.0f / (1048576.0f * 2048.0f);
constexpr size_t PLANE = (size_t)M * RW;

constexpr int LDS_BYTES = 135168, BAR_LDS_OFF = 131072 + 256;

__device__ __forceinline__ unsigned cvt_pk_bf16(float lo, float hi) { unsigned r; asm volatile("v_cvt_pk_bf16_f32 %0, %1, %2" : "=v"(r) : "v"(lo), "v"(hi)); return r; }
__device__ __forceinline__ float bf2f(unsigned h) { return __uint_as_float(h << 16); }
__device__ __forceinline__ f32x8 up8(v4u p) {
    f32x8 r;
    r[0] = __uint_as_float(p.x << 16); r[1] = __uint_as_float(p.x & 0xffff0000u);
    r[2] = __uint_as_float(p.y << 16); r[3] = __uint_as_float(p.y & 0xffff0000u);
    r[4] = __uint_as_float(p.z << 16); r[5] = __uint_as_float(p.z & 0xffff0000u);
    r[6] = __uint_as_float(p.w << 16); r[7] = __uint_as_float(p.w & 0xffff0000u);
    return r;
}
__device__ __forceinline__ v4u pk8(f32x8 v) { v4u o; o.x = cvt_pk_bf16(v[0], v[1]); o.y = cvt_pk_bf16(v[2], v[3]); o.z = cvt_pk_bf16(v[4], v[5]); o.w = cvt_pk_bf16(v[6], v[7]); return o; }
__device__ __forceinline__ f32x8 ld8f(const float* p) { const f32x4 a = *(const f32x4*)p, b = *(const f32x4*)(p + 4); f32x8 r; r[0] = a[0]; r[1] = a[1]; r[2] = a[2]; r[3] = a[3]; r[4] = b[0]; r[5] = b[1]; r[6] = b[2]; r[7] = b[3]; return r; }
__device__ __forceinline__ float sigm(float x) { return __builtin_amdgcn_rcpf(1.0f + __expf(-x)); }
__device__ __forceinline__ float wave_sum(float v) {
#pragma unroll
    for (int o = 1; o < 64; o <<= 1) v += __shfl_xor(v, o);
    return v;
}
__device__ __forceinline__ float sum8(f32x8 v) { return ((v[0] + v[1]) + (v[2] + v[3])) + ((v[4] + v[5]) + (v[6] + v[7])); }
template <int CTRL> __device__ __forceinline__ float dpp1(float x) { const int xi = __builtin_bit_cast(int, x); return __builtin_bit_cast(float, __builtin_amdgcn_update_dpp(0, xi, CTRL, 0xF, 0xF, true)); }
template <int CTRL> __device__ __forceinline__ float dpp_mov(float x) { const int xi = __builtin_bit_cast(int, x); return __builtin_bit_cast(float, __builtin_amdgcn_update_dpp(xi, xi, CTRL, 0xF, 0xF, false)); }
__device__ __forceinline__ float allreduce16(float x) {
    x += dpp_mov<0x128>(x); x += dpp_mov<0x124>(x); x += dpp_mov<0x122>(x); x += dpp_mov<0x121>(x); return x;
}

namespace pg8 {
constexpr int BM = 256, BK = 64, HALF = 128, HTB = HALF * BK * 2, STAGE_BYTES = 8 * HTB, NXCD = 8, WGM = 8;
__host__ __device__ __forceinline__ int lds_byte(int r, int c) { const int st = (r >> 4) * 2 + (c >> 5), rr = r & 15, cc = c & 31, ob = rr * 64 + cc * 2; return st * 1024 + (ob ^ (((ob >> 9) & 1) << 5)); }
__host__ __device__ __forceinline__ void stage_rc(int b, int& R, int& C) { const int st = b / 1024, sb = b % 1024, swz = sb ^ (((sb >> 9) & 1) << 5); R = (st >> 1) * 16 + swz / 64; C = (st & 1) * 32 + (swz % 64) / 2; }
__host__ __device__ __forceinline__ int perm32(int rho) { const int n = rho >> 4, i = rho & 15; return 8 * (i >> 2) + 4 * n + (i & 3); }

struct Unit { int pm, pn; };

struct StaticOrder {
    int nM, nN, nwg, G, c;
    __device__ void init(int nM_, int nN_, int G_, int c_) { nM = nM_; nN = nN_; nwg = nM * nN; G = G_; c = c_; }
    __device__ bool next(int i, Unit& u) const {
        const long L = (long)i * G + c; if (L >= nwg) return false;
        int wgid = (int)L; { const int q = nwg / NXCD, r = nwg % NXCD, xcd = wgid % NXCD, off = wgid / NXCD; wgid = (xcd < r ? xcd * (q + 1) : r * (q + 1) + (xcd - r) * q) + off; }
        const int nig = WGM * nN, gid = wgid / nig, fm = gid * WGM, gsz = (nM - fm) < WGM ? (nM - fm) : WGM;
        u.pm = fm + ((wgid % nig) % gsz); u.pn = (wgid % nig) / gsz; return true;
    }
};

template <int MODE> struct EpiB {
    static constexpr bool PERM = true;
    bf16_t* O; int ldc; const float* c0; const float* c1; const float* c2; size_t plane; const u64* ss;
    __device__ __forceinline__ void operator()(const f32x4 (&acc)[2][2][4][2], const Unit& u, int wr, int wc, int fr, int fq) const {
        const int row0 = u.pm * BM + wr * 64 + fr; int colt = u.pn * BM; bf16_t* base = O; int t = 0;
        if (MODE == 3) { t = colt >> 10; base += (size_t)t * plane; colt &= 1023; }
        const int col0 = colt + wc * 32 + 8 * fq;
        f32x4 cv[2][2];
#pragma unroll
        for (int bj = 0; bj < 2; ++bj)
#pragma unroll
            for (int n = 0; n < 2; ++n) {
                cv[bj][n] = (f32x4){0.f, 0.f, 0.f, 0.f};
                if (MODE == 2) cv[bj][n] = *(const f32x4*)(c0 + col0 + bj * HALF + 4 * n);
                if (MODE == 3) { const float* b = (t == 0) ? c0 : (t == 1) ? c1 : (t == 3) ? c2 : nullptr; if (b) cv[bj][n] = *(const f32x4*)(b + col0 + bj * HALF + 4 * n); }
            }
        float rsv[2][4];
#pragma unroll
        for (int ai = 0; ai < 2; ++ai)
#pragma unroll
            for (int m = 0; m < 4; ++m) { rsv[ai][m] = 1.0f; if (MODE < 2) { if (ss) rsv[ai][m] = rsqrtf((float)ss[row0 + ai * HALF + m * 16] * SS_INV + NORM_EPS); } }
#pragma unroll
        for (int ai = 0; ai < 2; ++ai)
#pragma unroll
            for (int m = 0; m < 4; ++m) { bf16_t* rowp = base + (size_t)(row0 + ai * HALF + m * 16) * ldc + col0;
                const float rs = rsv[ai][m];
#pragma unroll
                for (int bj = 0; bj < 2; ++bj) { f32x4 v0 = acc[ai][bj][m][0], v1 = acc[ai][bj][m][1];
                    if (MODE < 2) { v0 = v0 * rs; v1 = v1 * rs; }
                    if (MODE == 1) {
#pragma unroll
                        for (int j = 0; j < 4; ++j) { const float a = fmaxf(v0[j], 0.f), b = fmaxf(v1[j], 0.f); v0[j] = a * a; v1[j] = b * b; } }
                    if (MODE == 2) { v0 = v0 * cv[bj][0]; v1 = v1 * cv[bj][1]; }
                    if (MODE == 3) { v0 = v0 + cv[bj][0]; v1 = v1 + cv[bj][1];
                        if (t == 0) {
#pragma unroll
                            for (int j = 0; j < 4; ++j) { v0[j] = -0.6065306597f * sigm(v0[j]); v1[j] = -0.6065306597f * sigm(v1[j]); } }
                        else if (t != 2) {
#pragma unroll
                            for (int j = 0; j < 4; ++j) { v0[j] = sigm(v0[j]); v1[j] = sigm(v1[j]); } }
                    }
                    v4u w; w.x = cvt_pk_bf16(v0[0], v0[1]); w.y = cvt_pk_bf16(v0[2], v0[3]); w.z = cvt_pk_bf16(v1[0], v1[1]); w.w = cvt_pk_bf16(v1[2], v1[3]);
                    *(v4u*)(rowp + bj * HALF) = w; } }
    }
};
template <bool GATE> struct EpiX {
    static constexpr int RB = GATE ? 2 : 4;
    const bf16_t* base; bf16_t* out; const bf16_t* pp; int ldc; const u64* ss_in; u64* ss_out;
    __device__ __forceinline__ void operator()(const f32x4 (&acc)[2][2][4][2], const Unit& u, int wr, int wc, int fr, int fq) const {
        const int row0 = u.pm * BM + wr * 64 + fr, col0 = u.pn * BM + wc * 32 + 8 * fq;
        float rsv[2][4];
#pragma unroll
        for (int ai = 0; ai < 2; ++ai)
#pragma unroll
            for (int m = 0; m < 4; ++m) { rsv[ai][m] = 1.0f; if (GATE) rsv[ai][m] = rsqrtf((float)ss_in[row0 + ai * HALF + m * 16] * SS_INV + NORM_EPS); }
#pragma unroll
        for (int aim = 0; aim < 8 / RB; ++aim) { const int ai = (aim * RB) >> 2, m0 = (aim * RB) & 3;
            v4u bs[RB][2], q[RB][2];
#pragma unroll
            for (int mm = 0; mm < RB; ++mm) { const size_t off = (size_t)(row0 + ai * HALF + (m0 + mm) * 16) * ldc + col0;
#pragma unroll
                for (int bj = 0; bj < 2; ++bj) { bs[mm][bj] = *(const v4u*)(base + off + bj * HALF); if (GATE) q[mm][bj] = *(const v4u*)(pp + off + bj * HALF); } }
#pragma unroll
            for (int mm = 0; mm < RB; ++mm) { const int m = m0 + mm, row = row0 + ai * HALF + m * 16; const size_t off = (size_t)row * ldc + col0; const float rs = rsv[ai][m];
                float sq = 0.f;
#pragma unroll
                for (int bj = 0; bj < 2; ++bj) { const f32x8 b = up8(bs[mm][bj]); f32x4 a0 = acc[ai][bj][m][0], a1 = acc[ai][bj][m][1];
                    if (GATE) { const f32x8 qf = up8(q[mm][bj]); a0 = a0 * rs; a1 = a1 * rs;
#pragma unroll
                        for (int j = 0; j < 4; ++j) { a0[j] = sigm(a0[j]) * qf[j]; a1[j] = sigm(a1[j]) * qf[4 + j]; } }
                    f32x8 x;
#pragma unroll
                    for (int j = 0; j < 4; ++j) { x[j] = b[j] + a0[j]; x[4 + j] = b[4 + j] + a1[j]; }
                    const v4u w = pk8(x);
                    *(v4u*)(out + off + bj * HALF) = w;
                    const f32x8 xr = up8(w); sq += sum8(xr * xr); }
                sq += __shfl_xor(sq, 16); sq += __shfl_xor(sq, 32);
                if (fq == 0) __hip_atomic_fetch_add(ss_out + row, (u64)(sq * SS_SCALE), __ATOMIC_RELAXED, __HIP_MEMORY_SCOPE_AGENT); }
            asm volatile("" ::: "memory"); }
    }
};

struct Job { const bf16_t* A; const bf16_t* Bt; int lda, ldb, K, a_pn_step, nM, nN, mode;
             bf16_t* O; int ldc; const float* c0; const float* c1; const float* c2; const bf16_t* base; bf16_t* out; const bf16_t* pp;
             const u64* ss_in; u64* ss_out; };
__device__ __forceinline__ void run_epi(const Job& J, const f32x4 (&acc)[2][2][4][2], const Unit& u, int wr, int wc, int fr, int fq) {
    switch (J.mode) {
    case 0: { EpiB<0> E{J.O, J.ldc, nullptr, nullptr, nullptr, 0, J.ss_in}; E(acc, u, wr, wc, fr, fq); } break;
    case 1: { EpiB<1> E{J.O, J.ldc, nullptr, nullptr, nullptr, 0, J.ss_in}; E(acc, u, wr, wc, fr, fq); } break;
    case 2: { EpiB<2> E{J.O, J.ldc, J.c0, nullptr, nullptr, 0, nullptr}; E(acc, u, wr, wc, fr, fq); } break;
    case 3: { EpiB<3> E{J.O, J.ldc, J.c0, J.c1, J.c2, PLANE, nullptr}; E(acc, u, wr, wc, fr, fq); } break;
    case 4: { EpiX<false> E{J.base, J.out, nullptr, J.ldc, nullptr, J.ss_out}; E(acc, u, wr, wc, fr, fq); } break;
    default: { EpiX<true> E{J.base, J.out, J.pp, J.ldc, J.ss_in, J.ss_out}; E(acc, u, wr, wc, fr, fq); } break;
    }
}
__device__ __forceinline__ void gemm_phase(LAS unsigned char* lds, const Job& J, const StaticOrder& S, const int tid) {
    const int wid = __builtin_amdgcn_readfirstlane(tid >> 6), lane = tid & 63, wr = wid >> 2, wc = wid & 3, fr = lane & 15, fq = lane >> 4;
    const int K = J.K, nt = K / BK;
    unsigned voffA[2], voffB[2];
#pragma unroll
    for (int i = 0; i < 2; ++i) { int R, C; stage_rc(tid * 16 + i * 8192, R, C); const int Rb = (R & ~31) + perm32(R & 31);
        voffA[i] = (unsigned)(R * J.lda + C) * 2u; voffB[i] = (unsigned)(Rb * J.ldb + C) * 2u; }
    const size_t kstep = (size_t)(BK * 2);
    const size_t hstepA = (size_t)HALF * J.lda * 2, hstepB = (size_t)HALF * J.ldb * 2;
    const size_t tstepA = 2 * hstepA, tstepB = 2 * hstepB;
    const unsigned ldsw = (unsigned)wid * 1024u;
    const int aoff = lds_byte(wr * 64 + fr, fq * 8), boff = lds_byte(wc * 32 + fr, fq * 8);
#define PG8_SA(b, h) (((b) * 2 + (h)) * HTB)
#define PG8_SB(b, h) ((4 + (b) * 2 + (h)) * HTB)
#define PG8_STAGE(bufoff, gbase, voff) do { _Pragma("unroll") for (int _i = 0; _i < 2; ++_i) \
        __builtin_amdgcn_global_load_lds((const unsigned*)((const char*)(gbase) + (voff)[_i]), (LAS unsigned*)(lds + (bufoff) + ldsw + _i * 8192), 16, 0, 0); } while (0)
#define PG8_LDA(dst, b, h) do { _Pragma("unroll") for (int m = 0; m < 4; ++m) _Pragma("unroll") for (int k = 0; k < 2; ++k) dst[m][k] = *(const LAS bf16x8*)(lds + PG8_SA(b, h) + aoff + m * 2048 + k * 1024); } while (0)
#define PG8_LDB(dst, b, h) do { _Pragma("unroll") for (int n = 0; n < 2; ++n) _Pragma("unroll") for (int k = 0; k < 2; ++k) dst[n][k] = *(const LAS bf16x8*)(lds + PG8_SB(b, h) + boff + n * 2048 + k * 1024); } while (0)
#define PG8_MMA(ai, bj, At, Bt) do { __builtin_amdgcn_s_setprio(1); _Pragma("unroll") for (int m = 0; m < 4; ++m) _Pragma("unroll") for (int n = 0; n < 2; ++n) _Pragma("unroll") for (int k = 0; k < 2; ++k) \
        acc[ai][bj][m][n] = __builtin_amdgcn_mfma_f32_16x16x32_bf16(Bt[n][k], At[m][k], acc[ai][bj][m][n], 0, 0, 0); __builtin_amdgcn_s_setprio(0); } while (0)
#define PG8_WAIT_V(n) asm volatile("s_waitcnt vmcnt(" #n ")" ::: "memory")
#define PG8_WAIT_L(n) asm volatile("s_waitcnt lgkmcnt(" #n ")" ::: "memory")
#define PG8_BAR __builtin_amdgcn_s_barrier()
#define PG8_SCHED __builtin_amdgcn_sched_barrier(0)
    Unit cur, nxt; int ui = 0;
    if (!S.next(0, cur)) return;
    f32x4 acc[2][2][4][2];
#pragma unroll
    for (int a = 0; a < 2; ++a)
#pragma unroll
        for (int b = 0; b < 2; ++b)
#pragma unroll
            for (int m = 0; m < 4; ++m)
#pragma unroll
                for (int n = 0; n < 2; ++n) acc[a][b][m][n] = (f32x4){0.f, 0.f, 0.f, 0.f};
    bf16x8 At[4][2], B0[2][2], B1[2][2];
    const char* cA = (const char*)J.A + (size_t)cur.pm * tstepA + (size_t)cur.pn * J.a_pn_step * 2; const char* cB = (const char*)J.Bt + (size_t)cur.pn * tstepB;
    PG8_STAGE(PG8_SB(0, 0), cB, voffB); PG8_STAGE(PG8_SB(0, 1), cB + hstepB, voffB); PG8_STAGE(PG8_SA(0, 0), cA, voffA); PG8_STAGE(PG8_SA(0, 1), cA + hstepA, voffA);
    if (wr == 1) PG8_BAR;
    PG8_WAIT_V(2); PG8_BAR;
    PG8_STAGE(PG8_SB(1, 0), cB + kstep, voffB); PG8_STAGE(PG8_SA(1, 0), cA + kstep, voffA); PG8_STAGE(PG8_SB(1, 1), cB + hstepB + kstep, voffB);
    PG8_WAIT_V(6); PG8_BAR;
    for (;;) {
        const bool has_next = S.next(ui + 1, nxt);
        const char* nA = has_next ? (const char*)J.A + (size_t)nxt.pm * tstepA + (size_t)nxt.pn * J.a_pn_step * 2 : cA; const char* nB = has_next ? (const char*)J.Bt + (size_t)nxt.pn * tstepB : cB;
        for (int t = 0; t < nt; t += 2) {
            const bool last = (t == nt - 2);
            const char* a1 = cA + (size_t)(t + 1) * kstep;
            const char* a2 = last ? nA : cA + (size_t)(t + 2) * kstep; const char* b2 = last ? nB : cB + (size_t)(t + 2) * kstep;
            const char* a3 = a2 + kstep; const char* b3 = b2 + kstep;
            PG8_LDB(B0, 0, 0); PG8_LDB(B1, 0, 1); PG8_SCHED; PG8_LDA(At, 0, 0); PG8_STAGE(PG8_SA(1, 1), a1 + hstepA, voffA);
            PG8_WAIT_V(8); PG8_WAIT_L(0); PG8_BAR; PG8_MMA(0, 0, At, B0); PG8_MMA(0, 1, At, B1); PG8_BAR; PG8_SCHED;
            PG8_LDA(At, 0, 1); PG8_STAGE(PG8_SB(0, 0), b2, voffB); PG8_STAGE(PG8_SB(0, 1), b2 + hstepB, voffB); PG8_STAGE(PG8_SA(0, 0), a2, voffA);
            PG8_WAIT_V(8); PG8_WAIT_L(0); PG8_BAR; PG8_MMA(1, 0, At, B0); PG8_MMA(1, 1, At, B1); PG8_BAR; PG8_SCHED;
            PG8_LDB(B0, 1, 0); PG8_LDB(B1, 1, 1); PG8_SCHED; PG8_LDA(At, 1, 0); PG8_STAGE(PG8_SA(0, 1), a2 + hstepA, voffA);
            PG8_WAIT_V(8); PG8_WAIT_L(0); PG8_BAR; PG8_MMA(0, 0, At, B0); PG8_MMA(0, 1, At, B1); PG8_BAR; PG8_SCHED;
            PG8_LDA(At, 1, 1); PG8_STAGE(PG8_SB(1, 0), b3, voffB); PG8_STAGE(PG8_SB(1, 1), b3 + hstepB, voffB); PG8_STAGE(PG8_SA(1, 0), a3, voffA);
            PG8_WAIT_V(8); PG8_WAIT_L(0); PG8_BAR; PG8_MMA(1, 0, At, B0); PG8_MMA(1, 1, At, B1); PG8_BAR; PG8_SCHED;
        }
        if (wr == 0) PG8_BAR;
        run_epi(J, acc, cur, wr, wc, fr, fq);
        if (!has_next) break;
#pragma unroll
        for (int a = 0; a < 2; ++a)
#pragma unroll
            for (int b = 0; b < 2; ++b)
#pragma unroll
                for (int m = 0; m < 4; ++m)
#pragma unroll
                    for (int n = 0; n < 2; ++n) acc[a][b][m][n] = (f32x4){0.f, 0.f, 0.f, 0.f};
        cur = nxt; cA = nA; cB = nB; ++ui;
        if (wr == 1) PG8_BAR;
    }
    PG8_WAIT_V(0);
    PG8_BAR;
#undef PG8_SA
#undef PG8_SB
#undef PG8_STAGE
#undef PG8_LDA
#undef PG8_LDB
#undef PG8_MMA
#undef PG8_WAIT_V
#undef PG8_WAIT_L
#undef PG8_BAR
#undef PG8_SCHED
}
}

struct Args { const float* in[29]; float* out; unsigned char* ws; int ph_lo, ph_hi; };
typedef const __attribute__((address_space(4))) Args* ArgsP;
enum { I_X = 0, I_P, I_ATTN_NORM, I_W_IN, I_MU_SHIFT, I_W_VRES_DN, I_MU_VRES, I_V0, I_V_UP, I_POOL_W, I_POOL_SCALE, I_W0, I_W_UP, I_A0, I_A_UP, I_G_UP,
       I_K_K, I_K_A, I_R_K, I_GN_G, I_GN_B, I_W_OUT, I_MLP_NORM, I_W_FFN_UP, I_W_FFN_DOWN, I_PLE_NORM, I_W_PLE_GATE, I_W_PLE_PROJ, I_FINAL_NORM };

__device__ __forceinline__ void p0_transpose_item(const float* W, int N, bf16_t* WT, int ldd, int row_off, LAS float* scr, int item, int nblk, int lane, const float* gs) {
    const int kb = item / nblk, nb = item % nblk, k0 = 64 * kb, n0 = 32 * nb;
    const int c = lane & 7;
    f32x4 g0 = {1.f, 1.f, 1.f, 1.f}, g1 = {1.f, 1.f, 1.f, 1.f};
    if (gs) { g0 = *(const f32x4*)(gs + k0 + 8 * c); g1 = *(const f32x4*)(gs + k0 + 8 * c + 4); }
#pragma unroll 8
    for (int i = 0; i < 32; ++i) { const int kk = 2 * i + (lane >> 5); scr[kk * 33 + (lane & 31)] = W[(size_t)(k0 + kk) * N + n0 + (lane & 31)]; }
    asm volatile("s_waitcnt lgkmcnt(0)" ::: "memory");
#pragma unroll
    for (int j = 0; j < 4; ++j) { const int n = (lane >> 3) + 8 * j; const LAS float* s = scr + (8 * c) * 33 + n;
        v4u o; o.x = cvt_pk_bf16(s[0 * 33] * g0[0], s[1 * 33] * g0[1]); o.y = cvt_pk_bf16(s[2 * 33] * g0[2], s[3 * 33] * g0[3]); o.z = cvt_pk_bf16(s[4 * 33] * g1[0], s[5 * 33] * g1[1]); o.w = cvt_pk_bf16(s[6 * 33] * g1[2], s[7 * 33] * g1[3]);
        *(v4u*)(WT + (size_t)(row_off + n0 + n) * ldd + k0 + 8 * c) = o; }
    asm volatile("s_waitcnt lgkmcnt(0)" ::: "memory");
}
__device__ __forceinline__ void cvt_job(const float* W, int K, int N, bf16_t* WT, int ldd, int row_off, LAS float* scr, int gw, int NW, int lane, const float* gs = nullptr) {
    const int nblk = N / 32, nit = (K / 64) * nblk;
    for (int it = gw; it < nit; it += NW) p0_transpose_item(W, N, WT, ldd, row_off, scr, it, nblk, lane, gs);
}
__device__ __forceinline__ void phase_convert(ArgsP a, LAS unsigned char* lds, const int tid, const int bx) {
    const int lane = tid & 63, wave = tid >> 6, G = gridDim.x;
    const int gw = bx * 8 + wave, NW = G * 8; const size_t gt = (size_t)bx * 512 + tid, NT = (size_t)G * 512;
    LAS float* scr = (LAS float*)(lds + wave * 8448);
    unsigned char* ws = a->ws;
    for (int l = 0; l < DEPTH; ++l) {
        bf16_t* win = (bf16_t*)(ws + WS_WIN) + (size_t)l * NZ * DM;
        cvt_job(a->in[I_W_IN] + (size_t)l * DM * INW, DM, INW, win, DM, 0, scr, gw, NW, lane, a->in[I_ATTN_NORM] + (size_t)l * DM);
        if (l > 0) cvt_job(a->in[I_W_VRES_DN] + (size_t)(l - 1) * DM * 32, DM, 32, win, DM, INW, scr, gw, NW, lane, a->in[I_ATTN_NORM] + (size_t)l * DM);
        { const int r0 = (l == 0) ? INW : INW + 32; const size_t n16 = (size_t)(NZ - r0) * DM / 8; v4u* z = (v4u*)(win + (size_t)r0 * DM);
          for (size_t i = gt; i < n16; i += NT) z[i] = (v4u){0u, 0u, 0u, 0u}; }
        cvt_job(a->in[I_W_OUT] + (size_t)l * DM * DM, DM, DM, (bf16_t*)(ws + WS_WOUT) + (size_t)l * DM * DM, DM, 0, scr, gw, NW, lane);
        cvt_job(a->in[I_W_FFN_UP] + (size_t)l * DM * DFF, DM, DFF, (bf16_t*)(ws + WS_WUP) + (size_t)l * DFF * DM, DM, 0, scr, gw, NW, lane, a->in[I_MLP_NORM] + (size_t)l * DM);
        cvt_job(a->in[I_W_FFN_DOWN] + (size_t)l * DFF * DM, DFF, DM, (bf16_t*)(ws + WS_WDN) + (size_t)l * DM * DFF, DFF, 0, scr, gw, NW, lane);
        cvt_job(a->in[I_W_PLE_GATE] + (size_t)l * DM * DM, DM, DM, (bf16_t*)(ws + WS_WGATE) + (size_t)l * DM * DM, DM, 0, scr, gw, NW, lane, a->in[I_PLE_NORM] + (size_t)l * DM);
        cvt_job(a->in[I_W_PLE_PROJ] + (size_t)l * DPLE * DM, DPLE, DM, (bf16_t*)(ws + WS_WPROJ) + (size_t)l * DM * DPLE, DPLE, 0, scr, gw, NW, lane);
        for (int gi = 0; gi < 4; ++gi)
            cvt_job(a->in[I_POOL_W] + ((size_t)l * 4 + gi) * 256 * 256, 256, 256, (bf16_t*)(ws + WS_WPOOL) + (size_t)l * 1024 * 256, 256, gi * 256, scr, gw, NW, lane);
        { bf16_t* wl = (bf16_t*)(ws + WS_WLORA) + (size_t)l * 4096 * KL;
          const float* wu = a->in[I_W_UP] + (size_t)l * 64 * RW; const float* au = a->in[I_A_UP] + (size_t)l * 64 * RW; const float* gu = a->in[I_G_UP] + (size_t)l * 160 * RW;
          const float* vu = a->in[I_V_UP] + (size_t)(l > 0 ? l - 1 : 0) * 32 * RW;
          for (size_t idx = gt; idx < (size_t)4096 * KL; idx += NT) { const int n = (int)(idx / KL), k = (int)(idx % KL), t = n >> 10, col = n & 1023; float v = 0.f;
              if (t == 0) { if (k < 64) v = wu[(size_t)k * RW + col]; }
              else if (t == 1) { if (k >= 64 && k < 128) v = au[(size_t)(k - 64) * RW + col]; }
              else if (t == 2) { if (k >= 128 && k < 288) v = gu[(size_t)(k - 128) * RW + col]; }
              else { if (l > 0 && k >= 288 && k < 320) v = vu[(size_t)(k - 288) * RW + col]; }
              wl[idx] = (bf16_t)(cvt_pk_bf16(v, 0.f) & 0xffffu); } }
    }
    { u64* SS = (u64*)(ws + WS_SS); bf16_t* XP = (bf16_t*)(ws + WS_H); const float* x = a->in[I_X];
      for (size_t i = gt; i < (size_t)12 * M; i += NT) SS[M + i] = 0ull;
      for (int row = gw; row < M; row += NW) {
          const f32x4* xr = (const f32x4*)(x + (size_t)row * DM) + lane; float s = 0.f;
#pragma unroll
          for (int j = 0; j < 8; ++j) { const f32x4 v = xr[64 * j]; s += (v[0] * v[0] + v[1] * v[1]) + (v[2] * v[2] + v[3] * v[3]);
              v2u w; w.x = cvt_pk_bf16(v[0], v[1]); w.y = cvt_pk_bf16(v[2], v[3]); ((v2u*)(XP + (size_t)row * DM))[lane + 64 * j] = w; }
          s = wave_sum(s); if (lane == 0) SS[row] = (u64)(s * SS_SCALE); } }
    { const float* p = a->in[I_P]; bf16_t* pb = (bf16_t*)(ws + WS_PB); const size_t n8 = (size_t)DEPTH * M * DPLE / 8;
      for (size_t i = gt; i < n8; i += NT) { const f32x8 v = ld8f(p + i * 8); *(v4u*)(pb + i * 8) = pk8(v); } }
}

template <int WIN> __device__ __forceinline__ v4u pool_diff(const bf16_t* zp, int tpos) {
    const f32x8 u = up8(*(const v4u*)zp);
    v4u raw[WIN - 1];
#pragma unroll
    for (int q = 1; q < WIN; ++q) raw[q - 1] = *(const v4u*)(zp - (size_t)((q <= tpos) ? q : 0) * NZ);
    f32x8 s = u;
#pragma unroll
    for (int q = 1; q < WIN; ++q) { const float msk = (q <= tpos) ? 1.0f : 0.0f; s = s + up8(raw[q - 1]) * msk; }
    const int cnt = (tpos + 1 < WIN) ? tpos + 1 : WIN;
    return pk8(s * (1.0f / (float)cnt) - u);
}
__device__ __forceinline__ void phase_prepa(ArgsP a, int l, const int tid, const int bx) {
    const int G = gridDim.x;
    const bf16_t* Z = (const bf16_t*)(a->ws + WS_Z); bf16_t* DP = (bf16_t*)(a->ws + WS_DPOOL); bf16_t* AL = (bf16_t*)(a->ws + WS_ALORA);
    const float* mus = a->in[I_MU_SHIFT] + (size_t)l * SHIFTW; const float* muv = a->in[I_MU_VRES] + (size_t)(l > 0 ? l - 1 : 0) * 32;
    const int wave = __builtin_amdgcn_readfirstlane(tid >> 6), lane = tid & 63;
    const int gi = wave & 3, prow = (wave >> 2) * 2 + (lane >> 5), pcol = gi * 256 + 8 * (lane & 31);
    const int arow = tid / 48, acol = 8 * (tid % 48);
    for (int unit = bx; unit < M / 4; unit += G) {
        { const int row = unit * 4 + prow, tpos = row & (SEQ - 1);
          const bf16_t* zp = Z + (size_t)row * NZ + pcol; v4u d;
          if (gi == 0) d = pool_diff<2>(zp, tpos); else if (gi == 1) d = pool_diff<4>(zp, tpos); else if (gi == 2) d = pool_diff<8>(zp, tpos); else d = pool_diff<16>(zp, tpos);
          *(v4u*)(DP + (size_t)row * RW + pcol) = d; }
        if (tid < 192) {
            const int row = unit * 4 + arow, tpos = row & (SEQ - 1), c = acol; f32x8 o;
#pragma unroll
            for (int j = 0; j < 8; ++j) o[j] = 0.f;
            if (c < 288 || (c < 320 && l > 0)) {
                const bf16_t* zp = Z + (size_t)row * NZ + 4096 + c;
                const f32x8 zc = up8(*(const v4u*)zp); f32x8 zq;
                if (tpos > 0) zq = up8(*(const v4u*)(zp - NZ)); else {
#pragma unroll
                    for (int j = 0; j < 8; ++j) zq[j] = 0.f; }
                const f32x8 mu = (c < 288) ? ld8f(mus + 3072 + c) : ld8f(muv + (c - 288));
                const f32x8 zs = zc + (zq - zc) * mu;
                if (c < 64) {
#pragma unroll
                    for (int j = 0; j < 8; ++j) o[j] = 1.0f - 2.0f * __builtin_amdgcn_rcpf(1.0f + __expf(2.0f * zs[j])); }
                else if (c >= 128 && c < 288) {
#pragma unroll
                    for (int j = 0; j < 8; ++j) o[j] = sigm(zs[j]); }
                else o = zs;
            }
            *(v4u*)(AL + (size_t)row * KL + c) = pk8(o);
        }
    }
}

constexpr int TC = 32, STEPB = 1344, BUFB = TC * STEPB, YBB = TC * 16 * 4;
struct ScanRaw { v4u zr, zrp, zk, zkp, zv, zvp, ld, aa, vg, vf; };
__device__ __forceinline__ void scan_unit(ArgsP a, int l, int u, LAS unsigned char* lds, const int tid) {
    const int wave = __builtin_amdgcn_readfirstlane(tid >> 6), lane = tid & 63;
    const int bh = u >> 2, rg = u & 3, b = bh >> 4, h = bh & 15;
    const bool hasv = l > 0;
    constexpr int NC = SEQ / TC;
    const size_t rowbase = (size_t)b * SEQ;
    if (wave < 4) {
        const int rowl = 4 * wave + (lane >> 4), j = lane & 15;
        f32x2 s01 = {0.f, 0.f}, s23 = {0.f, 0.f};
        for (int c = 0; c < NC; ++c) {
            __syncthreads();
            const LAS unsigned char* buf = lds + (c & 1) * BUFB + 16 * j;
            const LAS unsigned char* vb = lds + (c & 1) * BUFB + 1280 + 4 * rowl;
            LAS float* yb = (LAS float*)(lds + 2 * BUFB + (c & 1) * YBB) + rowl + (15 - j) * 16;
            f32x4 R[3], W[3], K[3], A[3], B[3]; float V[3];
#define SC_LD(sl, tl) do { R[sl] = *(const LAS f32x4*)(buf + (tl) * STEPB); W[sl] = *(const LAS f32x4*)(buf + (tl) * STEPB + 256); K[sl] = *(const LAS f32x4*)(buf + (tl) * STEPB + 512); \
                A[sl] = *(const LAS f32x4*)(buf + (tl) * STEPB + 768); B[sl] = *(const LAS f32x4*)(buf + (tl) * STEPB + 1024); V[sl] = *(const LAS float*)(vb + (tl) * STEPB); } while (0)
            SC_LD(0, 0); SC_LD(1, 1);
            float yprev = 0.f, ysel = 0.f;
#pragma unroll
            for (int i = 0; i < TC; ++i) {
                const int sl = i % 3;
                if (i + 2 < TC) SC_LD((i + 2) % 3, i + 2);
                const f32x2 vv = {V[sl], V[sl]};
                f32x2 pp = s01 * (f32x2){A[sl][0], A[sl][1]}; pp = s23 * (f32x2){A[sl][2], A[sl][3]} + pp;
                float p = pp[0] + pp[1];
                f32x2 t01 = vv * (f32x2){K[sl][0], K[sl][1]}, t23 = vv * (f32x2){K[sl][2], K[sl][3]};
                t01 = s01 * (f32x2){W[sl][0], W[sl][1]} + t01; t23 = s23 * (f32x2){W[sl][2], W[sl][3]} + t23;
                if (i > 0) {
                    p += dpp1<0x128>(p); yprev += dpp1<0x128>(yprev);
                    p += dpp1<0x124>(p); yprev += dpp1<0x124>(yprev);
                    p += dpp1<0x122>(p); yprev += dpp1<0x122>(yprev);
                    p += dpp1<0x121>(p); yprev += dpp1<0x121>(yprev);
                    ysel = __builtin_bit_cast(float, __builtin_amdgcn_update_dpp(__builtin_bit_cast(int, yprev), __builtin_bit_cast(int, ysel), 0x111, 0xF, 0xF, false));
                    if ((i & 15) == 0) yb[((i >> 4) - 1) * 256] = ysel;
                } else {
                    p += dpp1<0x128>(p); p += dpp1<0x124>(p); p += dpp1<0x122>(p); p += dpp1<0x121>(p);
                }
                const f32x2 pv = {p, p};
                s01 = pv * (f32x2){B[sl][0], B[sl][1]} + t01; s23 = pv * (f32x2){B[sl][2], B[sl][3]} + t23;
                f32x2 yy = s01 * (f32x2){R[sl][0], R[sl][1]}; yy = s23 * (f32x2){R[sl][2], R[sl][3]} + yy;
                yprev = yy[0] + yy[1];
            }
            yprev += dpp1<0x128>(yprev); yprev += dpp1<0x124>(yprev); yprev += dpp1<0x122>(yprev); yprev += dpp1<0x121>(yprev);
            ysel = __builtin_bit_cast(float, __builtin_amdgcn_update_dpp(__builtin_bit_cast(int, yprev), __builtin_bit_cast(int, ysel), 0x111, 0xF, 0xF, false));
            yb[(TC / 16 - 1) * 256] = ysel;
#undef SC_LD
        }
        __syncthreads();
    } else {
        const int ltid = tid - 256, tl = ltid >> 3, cgp = ltid & 7;
        const int col0 = h * HS + 8 * cgp;
        const bf16_t* Z = (const bf16_t*)(a->ws + WS_Z); const bf16_t* PL = (const bf16_t*)(a->ws + WS_PLANES); const bf16_t* VF = (const bf16_t*)(a->ws + WS_VFIRST);
        bf16_t* Y = (bf16_t*)(a->ws + WS_DPOOL);
        const float* mus = a->in[I_MU_SHIFT] + (size_t)l * SHIFTW;
        const f32x8 mur = ld8f(mus + col0), muk = ld8f(mus + 1024 + col0), muv = ld8f(mus + 2048 + col0);
        const f32x8 kkc = ld8f(a->in[I_K_K] + (size_t)l * RW + col0), kac = ld8f(a->in[I_K_A] + (size_t)l * RW + col0);
        const bool vmine = (cgp >> 1) == rg;
#define SCAN_LOAD(R, cc) do { const int t_ = (cc) * TC + tl; const size_t row_ = rowbase + t_; const size_t rowp_ = (t_ > 0) ? row_ - 1 : row_; \
            const bf16_t* z_ = Z + row_ * NZ + col0; const bf16_t* zq_ = Z + rowp_ * NZ + col0; \
            R.zr = *(const v4u*)(z_ + 1024); R.zk = *(const v4u*)(z_ + 2048); R.zv = *(const v4u*)(z_ + 3072); \
            R.zrp = *(const v4u*)(zq_ + 1024); R.zkp = *(const v4u*)(zq_ + 2048); R.zvp = *(const v4u*)(zq_ + 3072); \
            R.ld = *(const v4u*)(PL + row_ * RW + col0); R.aa = *(const v4u*)(PL + PLANE + row_ * RW + col0); \
            if (hasv) { R.vg = *(const v4u*)(PL + 3 * PLANE + row_ * RW + col0); R.vf = *(const v4u*)(VF + row_ * RW + col0); } else { R.vg = R.ld; R.vf = R.ld; } } while (0)
#define SCAN_FLUSH(cc) do { const LAS float* yb_ = (const LAS float*)(lds + 2 * BUFB + ((cc) & 1) * YBB) + tl * 16 + 2 * cgp; \
            const unsigned w_ = cvt_pk_bf16(yb_[0], yb_[1]); *(unsigned*)(Y + (rowbase + (size_t)(cc) * TC + tl) * RW + h * HS + 16 * rg + 2 * cgp) = w_; } while (0)
        ScanRaw nx; SCAN_LOAD(nx, 0);
        for (int c = 0; c < NC; ++c) {
            const ScanRaw cu = nx;
            if (c + 1 < NC) SCAN_LOAD(nx, c + 1);
            const int t = c * TC + tl;
            const f32x8 zr = up8(cu.zr), zk = up8(cu.zk), zv = up8(cu.zv);
            f32x8 zrp = up8(cu.zrp), zkp = up8(cu.zkp), zvp = up8(cu.zvp);
            if (t == 0) {
#pragma unroll
                for (int q = 0; q < 8; ++q) { zrp[q] = 0.f; zkp[q] = 0.f; zvp[q] = 0.f; } }
            const f32x8 r = zr + (zrp - zr) * mur, k = zk + (zkp - zk) * muk; f32x8 v = zv + (zvp - zv) * muv;
            const f32x8 ld = up8(cu.ld), av = up8(cu.aa);
            if (hasv) v = v + (up8(cu.vf) - v) * up8(cu.vg);
            const f32x8 kk = k * kkc;
            float n2 = sum8(kk * kk); n2 += __shfl_xor(n2, 1); n2 += __shfl_xor(n2, 2); n2 += __shfl_xor(n2, 4);
            const float inv = 1.0f / fmaxf(sqrtf(n2), 1e-12f);
            const f32x8 kkn = kk * inv;
            const f32x8 kadj = k * (1.0f + (av - 1.0f) * kac);
            f32x8 dec;
#pragma unroll
            for (int q = 0; q < 8; ++q) dec[q] = __expf(ld[q]);
            const f32x8 avec = -kkn, bvec = kkn * av;
            LAS unsigned char* dst = lds + (c & 1) * BUFB + tl * STEPB + cgp * 32;
#define ST8(off, val) do { *(LAS f32x4*)(dst + (off)) = (f32x4){val[0], val[1], val[2], val[3]}; *(LAS f32x4*)(dst + (off) + 16) = (f32x4){val[4], val[5], val[6], val[7]}; } while (0)
            ST8(0, r); ST8(256, dec); ST8(512, kadj); ST8(768, avec); ST8(1024, bvec);
            if (vmine) { LAS unsigned char* dv = lds + (c & 1) * BUFB + tl * STEPB + 1280 + (cgp & 1) * 32;
                *(LAS f32x4*)(dv) = (f32x4){v[0], v[1], v[2], v[3]}; *(LAS f32x4*)(dv + 16) = (f32x4){v[4], v[5], v[6], v[7]}; }
#undef ST8
            if (c >= 2) SCAN_FLUSH(c - 2);
            __syncthreads();
        }
        __syncthreads();
        SCAN_FLUSH(NC - 2); SCAN_FLUSH(NC - 1);
#undef SCAN_LOAD
#undef SCAN_FLUSH
    }
    __syncthreads();
}

__device__ __forceinline__ void phase_post(ArgsP a, int l, const int tid, const int bx) {
    const int lane = tid & 63, wave = tid >> 6; const int gw = bx * 8 + wave, NW = gridDim.x * 8;
    const bf16_t* Z = (const bf16_t*)(a->ws + WS_Z); const bf16_t* PL = (const bf16_t*)(a->ws + WS_PLANES); bf16_t* VF = (bf16_t*)(a->ws + WS_VFIRST);
    const bf16_t* Y = (const bf16_t*)(a->ws + WS_DPOOL); bf16_t* MIX = (bf16_t*)(a->ws + WS_MIX);
    const float* mus = a->in[I_MU_SHIFT] + (size_t)l * SHIFTW;
    const bool hasv = l > 0;
    for (int it = gw; it < M * 2; it += NW) {
        const int row = it >> 1, h = (it & 1) * 8 + (lane >> 3), col = h * HS + 8 * (lane & 7), tpos = row & (SEQ - 1);
        const bf16_t* z = Z + (size_t)row * NZ + col; const bf16_t* zq = (tpos > 0) ? z - NZ : z;
        const f32x8 zr = up8(*(const v4u*)(z + 1024)), zk = up8(*(const v4u*)(z + 2048)), zv = up8(*(const v4u*)(z + 3072));
        f32x8 zrp = up8(*(const v4u*)(zq + 1024)), zkp = up8(*(const v4u*)(zq + 2048)), zvp = up8(*(const v4u*)(zq + 3072));
        if (tpos == 0) {
#pragma unroll
            for (int q = 0; q < 8; ++q) { zrp[q] = 0.f; zkp[q] = 0.f; zvp[q] = 0.f; } }
        const f32x8 r = zr + (zrp - zr) * ld8f(mus + col), k = zk + (zkp - zk) * ld8f(mus + 1024 + col); f32x8 v = zv + (zvp - zv) * ld8f(mus + 2048 + col);
        const size_t po = (size_t)row * RW + col;
        const f32x8 av = up8(*(const v4u*)(PL + PLANE + po)), gg = up8(*(const v4u*)(PL + 2 * PLANE + po));
        if (hasv) v = v + (up8(*(const v4u*)(VF + po)) - v) * up8(*(const v4u*)(PL + 3 * PLANE + po));
        else *(v4u*)(VF + po) = pk8(v);
        const f32x8 kadj = k * (1.0f + (av - 1.0f) * ld8f(a->in[I_K_A] + (size_t)l * RW + col));
        float bonus = sum8(r * kadj * ld8f(a->in[I_R_K] + (size_t)l * RW + col));
        bonus += __shfl_xor(bonus, 1); bonus += __shfl_xor(bonus, 2); bonus += __shfl_xor(bonus, 4);
        const f32x8 y = up8(*(const v4u*)(Y + po));
        float sm = sum8(y); sm += __shfl_xor(sm, 1); sm += __shfl_xor(sm, 2); sm += __shfl_xor(sm, 4);
        const float mean = sm * (1.0f / 64.0f);
        const f32x8 d = y - mean;
        float vs = sum8(d * d); vs += __shfl_xor(vs, 1); vs += __shfl_xor(vs, 2); vs += __shfl_xor(vs, 4);
        const float rstd = rsqrtf(vs * (1.0f / 64.0f) + GN_EPS);
        const f32x8 o = (d * rstd * ld8f(a->in[I_GN_G] + (size_t)l * RW + col) + ld8f(a->in[I_GN_B] + (size_t)l * RW + col) + bonus * v) * gg;
        *(v4u*)(MIX + (size_t)row * DM + 1024 + col) = pk8(o);
    }
}

#define XB_TMO      128
#define XB_XCNT(j)  (256  + 64 * (j))
#define XB_XSUB(j)  (1280 + 64 * (j))
#define XB_XGEN(j)  (2304 + 64 * (j))
#define XB_TOP      3328
#define XB_TOPGEN   3392
#define XCD_BAR_WORDS 3456
#define XB_SPIN_CAP (1u << 18)

__device__ __forceinline__ unsigned xb_ld(unsigned* p)              { return __hip_atomic_load(p, __ATOMIC_RELAXED, __HIP_MEMORY_SCOPE_AGENT); }
__device__ __forceinline__ unsigned xb_add(unsigned* p, unsigned v) { return __hip_atomic_fetch_add(p, v, __ATOMIC_RELAXED, __HIP_MEMORY_SCOPE_AGENT); }
__device__ __forceinline__ unsigned xb_xcc_id() { return (unsigned)__builtin_amdgcn_s_getreg((3 << 11) | 20) & 0xFu; }
#define XB_SPIN(cond, bar) do { unsigned _sp = 0; while (cond) { __builtin_amdgcn_s_sleep(1); \
    if ((++_sp & 255u) == 0u) { if (xb_ld(&(bar)[XB_TMO])) break; if (_sp > XB_SPIN_CAP) { atomicAdd(&(bar)[XB_TMO], 1u); break; } } } } while (0)

struct XcdBarrier {
    unsigned* bar; unsigned x;
    volatile LAS unsigned* st;
};

__device__ __forceinline__ XcdBarrier xcd_barrier_post(unsigned* bar, volatile LAS unsigned* st) {
    XcdBarrier b; b.bar = bar; b.x = xb_xcc_id(); b.st = st;
    if (threadIdx.x == 0) (void)xb_add(&bar[XB_XCNT(b.x)], 1u);
    return b;
}
__device__ __forceinline__ void xcd_barrier_complete(unsigned* bar, unsigned x, unsigned& nloc, unsigned& nx) {
    const unsigned G = gridDim.x * gridDim.y * gridDim.z;
    unsigned sum, cnt, mine, sp = 0u;
    for (;;) {
        sum = 0u; cnt = 0u; mine = 0u;
#pragma unroll
        for (unsigned j = 0; j < 16; ++j) { const unsigned c = xb_ld(&bar[XB_XCNT(j)]); sum += c; cnt += (c > 0u) ? 1u : 0u; mine = (j == x) ? c : mine; }
        if (sum == G) break;
        __builtin_amdgcn_s_sleep(1);
        if ((++sp & 255u) == 0u) { if (xb_ld(&bar[XB_TMO])) break; if (sp > XB_SPIN_CAP) { atomicAdd(&bar[XB_TMO], 1u); break; } }
    }
    nloc = mine > 0u ? mine : 1u; nx = cnt > 0u ? cnt : 1u;
}

__device__ __forceinline__ void xcd_barrier(const XcdBarrier& b) {
    asm volatile("s_waitcnt vmcnt(0)" ::: "memory");
    __syncthreads();
    if (threadIdx.x == 0) {
        unsigned* bar = b.bar;
        __builtin_amdgcn_s_waitcnt(0);
        unsigned nloc = b.st[0], nx = b.st[1];
        if (nloc == 0u) { xcd_barrier_complete(bar, b.x, nloc, nx); b.st[0] = nloc; b.st[1] = nx; }
        const unsigned old = xb_add(&bar[XB_XSUB(b.x)], 1u);
        const unsigned gen = old / nloc;
        if (old + 1u == (gen + 1u) * nloc) {
            __builtin_amdgcn_fence(__ATOMIC_RELEASE, "agent");
            asm volatile("s_waitcnt vmcnt(0)" ::: "memory");
            const unsigned og = xb_add(&bar[XB_TOP], 1u);
            const unsigned tg = og / nx;
            if (og + 1u == (tg + 1u) * nx) xb_add(&bar[XB_TOPGEN], 1u);
            else XB_SPIN(xb_ld(&bar[XB_TOPGEN]) == tg, bar);
            __builtin_amdgcn_fence(__ATOMIC_ACQUIRE, "agent");
            xb_add(&bar[XB_XGEN(b.x)], 1u);
            asm volatile("s_waitcnt vmcnt(0)" ::: "memory");
        } else {
            XB_SPIN(xb_ld(&bar[XB_XGEN(b.x)]) == gen, bar);
            __builtin_amdgcn_fence(__ATOMIC_ACQUIRE, "agent");
            asm volatile("s_waitcnt vmcnt(0)" ::: "memory");
        }
    }
    __syncthreads();
}


constexpr int N_PHASES = 2 + 9 * DEPTH;
__device__ __forceinline__ bool make_job(ArgsP a, int l, int s, int q, pg8::Job& J) {
    unsigned char* ws = a->ws; u64* SS = (u64*)(ws + WS_SS);
    bf16_t* XC = (bf16_t*)(ws + ((l & 1) ? WS_XQ : WS_H)); bf16_t* XN = (bf16_t*)(ws + ((l & 1) ? WS_H : WS_XQ));
    bf16_t* MIX = (bf16_t*)(ws + WS_MIX); bf16_t* PP = (bf16_t*)(ws + WS_MIX);
    J.a_pn_step = 0; J.nM = M / 256; J.O = nullptr; J.ldc = DM; J.c0 = nullptr; J.c1 = nullptr; J.c2 = nullptr; J.base = nullptr; J.out = nullptr; J.pp = nullptr; J.ss_in = nullptr; J.ss_out = nullptr;
    if (s == 0 && q == 0) { J.A = XC; J.Bt = (const bf16_t*)(ws + WS_WIN) + (size_t)l * NZ * DM; J.lda = DM; J.ldb = DM; J.K = DM; J.nN = NZ / 256; J.mode = 0; J.O = (bf16_t*)(ws + WS_Z); J.ldc = NZ; J.ss_in = SS + (size_t)(3 * l) * M; return true; }
    if (s == 2 && q == 0) { J.A = (const bf16_t*)(ws + WS_ALORA); J.Bt = (const bf16_t*)(ws + WS_WLORA) + (size_t)l * 4096 * KL; J.lda = KL; J.ldb = KL; J.K = KL; J.nN = 16; J.mode = 3; J.O = (bf16_t*)(ws + WS_PLANES); J.ldc = RW;
                            J.c0 = a->in[I_W0] + (size_t)l * RW; J.c1 = a->in[I_A0] + (size_t)l * RW; J.c2 = (l > 0) ? a->in[I_V0] + (size_t)(l - 1) * RW : nullptr; return true; }
    if (s == 2 && q == 1) { J.A = (const bf16_t*)(ws + WS_DPOOL); J.Bt = (const bf16_t*)(ws + WS_WPOOL) + (size_t)l * 1024 * 256; J.lda = RW; J.ldb = 256; J.K = 256; J.a_pn_step = 256; J.nN = 4; J.mode = 2; J.O = MIX; J.ldc = DM;
                            J.c0 = a->in[I_POOL_SCALE] + (size_t)l * 1024; return true; }
    if (s == 5 && q == 0) { J.A = MIX; J.Bt = (const bf16_t*)(ws + WS_WOUT) + (size_t)l * DM * DM; J.lda = DM; J.ldb = DM; J.K = DM; J.nN = DM / 256; J.mode = 4; J.base = XC; J.out = XC; J.ss_out = SS + (size_t)(3 * l + 1) * M; return true; }
    if (s == 6 && q == 0) { J.A = XC; J.Bt = (const bf16_t*)(ws + WS_WUP) + (size_t)l * DFF * DM; J.lda = DM; J.ldb = DM; J.K = DM; J.nN = DFF / 256; J.mode = 1; J.O = (bf16_t*)(ws + WS_U); J.ldc = DFF; J.ss_in = SS + (size_t)(3 * l + 1) * M; return true; }
    if (s == 6 && q == 1) { J.A = (const bf16_t*)(ws + WS_PB) + (size_t)l * M * DPLE; J.Bt = (const bf16_t*)(ws + WS_WPROJ) + (size_t)l * DM * DPLE; J.lda = DPLE; J.ldb = DPLE; J.K = DPLE; J.nN = DM / 256; J.mode = 0; J.O = PP; J.ldc = DM; return true; }
    if (s == 7 && q == 0) { J.A = (const bf16_t*)(ws + WS_U); J.Bt = (const bf16_t*)(ws + WS_WDN) + (size_t)l * DM * DFF; J.lda = DFF; J.ldb = DFF; J.K = DFF; J.nN = DM / 256; J.mode = 4; J.base = XC; J.out = XC; J.ss_out = SS + (size_t)(3 * l + 2) * M; return true; }
    if (s == 8 && q == 0) { J.A = XC; J.Bt = (const bf16_t*)(ws + WS_WGATE) + (size_t)l * DM * DM; J.lda = DM; J.ldb = DM; J.K = DM; J.nN = DM / 256; J.mode = 5; J.base = XC; J.out = XN; J.pp = PP; J.ss_in = SS + (size_t)(3 * l + 2) * M;
                            J.ss_out = SS + (size_t)(3 * l + 3) * M; return true; }
    return false;
}
__device__ __forceinline__ void phase_final(ArgsP a, const int tid, const int bx) {
    const int lane = tid & 63, wave = tid >> 6; const int gw = bx * 8 + wave, NW = gridDim.x * 8;
    const bf16_t* X = (const bf16_t*)(a->ws + ((DEPTH & 1) ? WS_XQ : WS_H)); const u64* SS = (const u64*)(a->ws + WS_SS) + (size_t)(3 * DEPTH) * M; const float* g = a->in[I_FINAL_NORM]; float* out = a->out;
    f32x8 gv[4];
#pragma unroll
    for (int j = 0; j < 4; ++j) gv[j] = ld8f(g + 8 * lane + 512 * j);
    for (int row = gw; row < M; row += NW) {
        const float rs = rsqrtf((float)SS[row] * SS_INV + NORM_EPS);
#pragma unroll
        for (int j = 0; j < 4; ++j) { const f32x8 o = up8(*(const v4u*)(X + (size_t)row * DM + 8 * lane + 512 * j)) * rs * gv[j]; float* op = out + (size_t)row * DM + 8 * lane + 512 * j;
            *(f32x4*)op = (f32x4){o[0], o[1], o[2], o[3]}; *(f32x4*)(op + 4) = (f32x4){o[4], o[5], o[6], o[7]}; }
    }
}
constexpr int dup_count() { int c = 0; for (int s = 0; s < 9; ++s) c += (PROBE_DUP >> s) & 1; return c; }
constexpr int SUBS = 9 + dup_count(), PRE = 1 + ((PROBE_DUP >> 9) & 1);
constexpr int N_PHASES_RUN = PRE + SUBS * DEPTH + 1;
__global__ void __launch_bounds__(512, 2) fwd_megakernel(Args a_byval) {
    ArgsP a = (ArgsP)__builtin_amdgcn_kernarg_segment_ptr();
    extern __shared__ __attribute__((aligned(16))) unsigned char lds_raw[];
    LAS unsigned char* lds = (LAS unsigned char*)lds_raw;
    cg::grid_group grid = cg::this_grid();
    const int G = gridDim.x;
    if (threadIdx.x < 16) ((LAS unsigned*)(lds + BAR_LDS_OFF))[threadIdx.x] = 0u;
    __syncthreads();
    XcdBarrier xbar = xcd_barrier_post((unsigned*)a->ws, (volatile LAS unsigned*)(lds + BAR_LDS_OFF));
    const int ph_lo = a->ph_lo, ph_hi = a->ph_hi;
    if (ph_lo < 0) grid.sync();
    for (int ph = ph_lo; ph < ph_hi; ++ph) {
        if (ph > ph_lo) xcd_barrier(xbar);
        asm volatile("" : "+s"(a) :: "memory");
        int tid = threadIdx.x, bx = blockIdx.x; asm volatile("" : "+v"(tid), "+s"(bx));
        int l = 0, s;
        if (ph < PRE) s = 13;
        else if (ph == N_PHASES_RUN - 1) s = 12;
        else { l = (ph - PRE) / SUBS; const int qq = (ph - PRE) % SUBS; int c = 0; s = 0;
               for (; s < 9; ++s) { const int n = 1 + ((PROBE_DUP >> s) & 1); if (qq < c + n) break; c += n; } }
        if (s == 13) { phase_convert(a, lds, tid, bx); }
        else if (s == 12) { phase_final(a, tid, bx); }
        else if (s == 1) { phase_prepa(a, l, tid, bx); }
        else if (s == 3) { const int vcu = (G % 8 == 0) ? (bx % 8) * (G / 8) + bx / 8 : bx; for (int u = vcu; u < 256; u += G) scan_unit(a, l, u, lds, tid); }
        else if (s == 4) { phase_post(a, l, tid, bx); }
        else {
            for (int q = 0; q < 2; ++q) { pg8::Job J; if (!make_job(a, l, s, q, J)) break;
                pg8::StaticOrder S; S.init(J.nM, J.nN, G, bx); pg8::gemm_phase(lds, J, S, tid); }
        }
    }
}

extern "C" void kernel_launch(void* const* d_in, const int* in_sizes, int n_in, void* d_out, int out_size, void* d_ws, size_t ws_size, hipStream_t stream) {
    static int grid = 0;
    if (grid == 0) {
        if (n_in != 29 || in_sizes[0] != M * DM || out_size != M * DM || ws_size < WS_END) {
            fprintf(stderr, "kernel_launch: unexpected shapes: n_in %d in0 %d out %d ws %zu (need %zu); nothing launched\n", n_in, n_in > 0 ? in_sizes[0] : -1, out_size, ws_size, (size_t)WS_END); grid = -1; return; }
        int dev = 0, cus = 0, per_cu = 0;
        if (hipGetDevice(&dev) != hipSuccess || hipDeviceGetAttribute(&cus, hipDeviceAttributeMultiprocessorCount, dev) != hipSuccess) { fprintf(stderr, "kernel_launch: device query failed\n"); grid = -1; return; }
        if (hipFuncSetAttribute((const void*)fwd_megakernel, hipFuncAttributeMaxDynamicSharedMemorySize, LDS_BYTES) != hipSuccess) { fprintf(stderr, "kernel_launch: hipFuncSetAttribute failed\n"); grid = -1; return; }
        if (hipOccupancyMaxActiveBlocksPerMultiprocessor(&per_cu, (const void*)fwd_megakernel, 512, LDS_BYTES) != hipSuccess || per_cu < 1) {
            fprintf(stderr, "kernel_launch: occupancy query says %d blocks/CU; using 1\n", per_cu); per_cu = 1; }
        (void)hipGetLastError();
        grid = cus * 1;
        if (grid > 256) grid = 256;
    }
    if (grid < 0) return;
    Args a{};
    for (int i = 0; i < 29; ++i) a.in[i] = (const float*)d_in[i];
    a.out = (float*)d_out; a.ws = (unsigned char*)d_ws;
    if (hipMemsetAsync(d_ws, 0, 65536, stream) != hipSuccess) { fprintf(stderr, "kernel_launch: memset of barrier words failed\n"); return; }
#if MK_PER_PHASE_LAUNCH
    for (int ph = 0; ph < N_PHASES_RUN; ++ph) {
        a.ph_lo = ph; a.ph_hi = ph + 1;
        hipLaunchKernelGGL(fwd_megakernel, dim3(grid), dim3(512), LDS_BYTES, stream, a);
    }
#else
    a.ph_lo = 0; a.ph_hi = N_PHASES_RUN;
    void* args[] = {&a};
    hipError_t e = hipLaunchCooperativeKernel((const void*)fwd_megakernel, dim3(grid), dim3(512), args, LDS_BYTES, stream);
    if (e != hipSuccess) fprintf(stderr, "cooperative launch failed: %s (grid %d)\n", hipGetErrorString(e), grid);
#endif
}
```

```cpp
#include <hip/hip_runtime.h>
#include <hip/hip_cooperative_groups.h>
#include <cstdio>
#include <cstdint>
namespace cg = cooperative_groups;

#ifndef MK_PER_PHASE_LAUNCH
#define MK_PER_PHASE_LAUNCH 0
#endif

#ifndef PROBE_DUP
#define PROBE_DUP 0
#endif
#define LAS __attribute__((address_space(3)))
typedef unsigned short bf16_t;
typedef short bf16x8 __attribute__((ext_vector_type(8)));
typedef float f32x4 __attribute__((ext_vector_type(4)));
typedef float f32x8 __attribute__((ext_vector_type(8)));
typedef float f32x2 __attribute__((ext_vector_type(2)));
typedef unsigned v4u __attribute__((ext_vector_type(4)));
typedef unsigned v2u __attribute__((ext_vector_type(2)));

constexpr int BATCH = 4, SEQ = 4096, DM = 2048, DEPTH = 4, M = BATCH * SEQ;
constexpr int RW = 1024, HS = 64, NH = 16, DFF = 8192, DPLE = 256;
constexpr int INW = 4384, NZ = 4608, SHIFTW = 3360, KL = 384;
constexpr float NORM_EPS = 1e-6f, GN_EPS = 64e-5f;

constexpr size_t MiB = 1u << 20;
constexpr size_t WS_WIN = 1 * MiB, WS_WOUT = 73 * MiB, WS_WUP = 105 * MiB, WS_WDN = 233 * MiB, WS_WGATE = 361 * MiB, WS_WPROJ = 393 * MiB,
                 WS_WLORA = 397 * MiB, WS_WPOOL = 409 * MiB, WS_PB = 411 * MiB, WS_H = 443 * MiB, WS_MIX = 507 * MiB  ,
                 WS_DPOOL = 571 * MiB  , WS_ALORA = 603 * MiB, WS_VFIRST = 615 * MiB, WS_Z = 647 * MiB, WS_PLANES = 791 * MiB,
                 WS_U = 647 * MiB  , WS_XQ = 919 * MiB, WS_SS = 983 * MiB  , WS_END = 985 * MiB;
typedef unsigned long long u64;
constexpr float SS_SCALE = 1048576.0f, SS_INV = 1.0f / (1048576.0f * 2048.0f);
constexpr size_t PLANE = (size_t)M * RW;

constexpr int LDS_BYTES = 135168, BAR_LDS_OFF = 131072 + 256;

__device__ __forceinline__ unsigned cvt_pk_bf16(float lo, float hi) { unsigned r; asm volatile("v_cvt_pk_bf16_f32 %0, %1, %2" : "=v"(r) : "v"(lo), "v"(hi)); return r; }
__device__ __forceinline__ float bf2f(unsigned h) { return __uint_as_float(h << 16); }
__device__ __forceinline__ f32x8 up8(v4u p) {
    f32x8 r;
    r[0] = __uint_as_float(p.x << 16); r[1] = __uint_as_float(p.x & 0xffff0000u);
    r[2] = __uint_as_float(p.y << 16); r[3] = __uint_as_float(p.y & 0xffff0000u);
    r[4] = __uint_as_float(p.z << 16); r[5] = __uint_as_float(p.z & 0xffff0000u);
    r[6] = __uint_as_float(p.w << 16); r[7] = __uint_as_float(p.w & 0xffff0000u);
    return r;
}
__device__ __forceinline__ v4u pk8(f32x8 v) { v4u o; o.x = cvt_pk_bf16(v[0], v[1]); o.y = cvt_pk_bf16(v[2], v[3]); o.z = cvt_pk_bf16(v[4], v[5]); o.w = cvt_pk_bf16(v[6], v[7]); return o; }
__device__ __forceinline__ f32x8 ld8f(const float* p) { const f32x4 a = *(const f32x4*)p, b = *(const f32x4*)(p + 4); f32x8 r; r[0] = a[0]; r[1] = a[1]; r[2] = a[2]; r[3] = a[3]; r[4] = b[0]; r[5] = b[1]; r[6] = b[2]; r[7] = b[3]; return r; }
__device__ __forceinline__ float sigm(float x) { return __builtin_amdgcn_rcpf(1.0f + __expf(-x)); }
__device__ __forceinline__ float wave_sum(float v) {
#pragma unroll
    for (int o = 1; o < 64; o <<= 1) v += __shfl_xor(v, o);
    return v;
}
__device__ __forceinline__ float sum8(f32x8 v) { return ((v[0] + v[1]) + (v[2] + v[3])) + ((v[4] + v[5]) + (v[6] + v[7])); }
template <int CTRL> __device__ __forceinline__ float dpp1(float x) { const int xi = __builtin_bit_cast(int, x); return __builtin_bit_cast(float, __builtin_amdgcn_update_dpp(0, xi, CTRL, 0xF, 0xF, true)); }
template <int CTRL> __device__ __forceinline__ float dpp_mov(float x) { const int xi = __builtin_bit_cast(int, x); return __builtin_bit_cast(float, __builtin_amdgcn_update_dpp(xi, xi, CTRL, 0xF, 0xF, false)); }
__device__ __forceinline__ float allreduce16(float x) {
    x += dpp_mov<0x128>(x); x += dpp_mov<0x124>(x); x += dpp_mov<0x122>(x); x += dpp_mov<0x121>(x); return x;
}

namespace pg8 {
constexpr int BM = 256, BK = 64, HALF = 128, HTB = HALF * BK * 2, STAGE_BYTES = 8 * HTB, NXCD = 8, WGM = 8;
__host__ __device__ __forceinline__ int lds_byte(int r, int c) { const int st = (r >> 4) * 2 + (c >> 5), rr = r & 15, cc = c & 31, ob = rr * 64 + cc * 2; return st * 1024 + (ob ^ (((ob >> 9) & 1) << 5)); }
__host__ __device__ __forceinline__ void stage_rc(int b, int& R, int& C) { const int st = b / 1024, sb = b % 1024, swz = sb ^ (((sb >> 9) & 1) << 5); R = (st >> 1) * 16 + swz / 64; C = (st & 1) * 32 + (swz % 64) / 2; }
__host__ __device__ __forceinline__ int perm32(int rho) { const int n = rho >> 4, i = rho & 15; return 8 * (i >> 2) + 4 * n + (i & 3); }

struct Unit { int pm, pn; };

struct StaticOrder {
    int nM, nN, nwg, G, c;
    __device__ void init(int nM_, int nN_, int G_, int c_) { nM = nM_; nN = nN_; nwg = nM * nN; G = G_; c = c_; }
    __device__ bool next(int i, Unit& u) const {
        const long L = (long)i * G + c; if (L >= nwg) return false;
        int wgid = (int)L; { const int q = nwg / NXCD, r = nwg % NXCD, xcd = wgid % NXCD, off = wgid / NXCD; wgid = (xcd < r ? xcd * (q + 1) : r * (q + 1) + (xcd - r) * q) + off; }
        const int nig = WGM * nN, gid = wgid / nig, fm = gid * WGM, gsz = (nM - fm) < WGM ? (nM - fm) : WGM;
        u.pm = fm + ((wgid % nig) % gsz); u.pn = (wgid % nig) / gsz; return true;
    }
};

template <int MODE> struct EpiB {
    static constexpr bool PERM = true;
    bf16_t* O; int ldc; const float* c0; const float* c1; const float* c2; size_t plane; const u64* ss;
    __device__ __forceinline__ void operator()(const f32x4 (&acc)[2][2][4][2], const Unit& u, int wr, int wc, int fr, int fq) const {
        const int row0 = u.pm * BM + wr * 64 + fr; int colt = u.pn * BM; bf16_t* base = O; int t = 0;
        if (MODE == 3) { t = colt >> 10; base += (size_t)t * plane; colt &= 1023; }
        const int col0 = colt + wc * 32 + 8 * fq;
        f32x4 cv[2][2];
#pragma unroll
        for (int bj = 0; bj < 2; ++bj)
#pragma unroll
            for (int n = 0; n < 2; ++n) {
                cv[bj][n] = (f32x4){0.f, 0.f, 0.f, 0.f};
                if (MODE == 2) cv[bj][n] = *(const f32x4*)(c0 + col0 + bj * HALF + 4 * n);
                if (MODE == 3) { const float* b = (t == 0) ? c0 : (t == 1) ? c1 : (t == 3) ? c2 : nullptr; if (b) cv[bj][n] = *(const f32x4*)(b + col0 + bj * HALF + 4 * n); }
            }
        float rsv[2][4];
#pragma unroll
        for (int ai = 0; ai < 2; ++ai)
#pragma unroll
            for (int m = 0; m < 4; ++m) { rsv[ai][m] = 1.0f; if (MODE < 2) { if (ss) rsv[ai][m] = rsqrtf((float)ss[row0 + ai * HALF + m * 16] * SS_INV + NORM_EPS); } }
#pragma unroll
        for (int ai = 0; ai < 2; ++ai)
#pragma unroll
            for (int m = 0; m < 4; ++m) { bf16_t* rowp = base + (size_t)(row0 + ai * HALF + m * 16) * ldc + col0;
                const float rs = rsv[ai][m];
#pragma unroll
                for (int bj = 0; bj < 2; ++bj) { f32x4 v0 = acc[ai][bj][m][0], v1 = acc[ai][bj][m][1];
                    if (MODE < 2) { v0 = v0 * rs; v1 = v1 * rs; }
                    if (MODE == 1) {
#pragma unroll
                        for (int j = 0; j < 4; ++j) { const float a = fmaxf(v0[j], 0.f), b = fmaxf(v1[j], 0.f); v0[j] = a * a; v1[j] = b * b; } }
                    if (MODE == 2) { v0 = v0 * cv[bj][0]; v1 = v1 * cv[bj][1]; }
                    if (MODE == 3) { v0 = v0 + cv[bj][0]; v1 = v1 + cv[bj][1];
                        if (t == 0) {
#pragma unroll
                            for (int j = 0; j < 4; ++j) { v0[j] = -0.6065306597f * sigm(v0[j]); v1[j] = -0.6065306597f * sigm(v1[j]); } }
                        else if (t != 2) {
#pragma unroll
                            for (int j = 0; j < 4; ++j) { v0[j] = sigm(v0[j]); v1[j] = sigm(v1[j]); } }
                    }
                    v4u w; w.x = cvt_pk_bf16(v0[0], v0[1]); w.y = cvt_pk_bf16(v0[2], v0[3]); w.z = cvt_pk_bf16(v1[0], v1[1]); w.w = cvt_pk_bf16(v1[2], v1[3]);
                    *(v4u*)(rowp + bj * HALF) = w; } }
    }
};
template <bool GATE> struct EpiX {
    static constexpr int RB = GATE ? 2 : 4;
    const bf16_t* base; bf16_t* out; const bf16_t* pp; int ldc; const u64* ss_in; u64* ss_out;
    __device__ __forceinline__ void operator()(const f32x4 (&acc)[2][2][4][2], const Unit& u, int wr, int wc, int fr, int fq) const {
        const int row0 = u.pm * BM + wr * 64 + fr, col0 = u.pn * BM + wc * 32 + 8 * fq;
        float rsv[2][4];
#pragma unroll
        for (int ai = 0; ai < 2; ++ai)
#pragma unroll
            for (int m = 0; m < 4; ++m) { rsv[ai][m] = 1.0f; if (GATE) rsv[ai][m] = rsqrtf((float)ss_in[row0 + ai * HALF + m * 16] * SS_INV + NORM_EPS); }
#pragma unroll
        for (int aim = 0; aim < 8 / RB; ++aim) { const int ai = (aim * RB) >> 2, m0 = (aim * RB) & 3;
            v4u bs[RB][2], q[RB][2];
#pragma unroll
            for (int mm = 0; mm < RB; ++mm) { const size_t off = (size_t)(row0 + ai * HALF + (m0 + mm) * 16) * ldc + col0;
#pragma unroll
                for (int bj = 0; bj < 2; ++bj) { bs[mm][bj] = *(const v4u*)(base + off + bj * HALF); if (GATE) q[mm][bj] = *(const v4u*)(pp + off + bj * HALF); } }
#pragma unroll
            for (int mm = 0; mm < RB; ++mm) { const int m = m0 + mm, row = row0 + ai * HALF + m * 16; const size_t off = (size_t)row * ldc + col0; const float rs = rsv[ai][m];
                float sq = 0.f;
#pragma unroll
                for (int bj = 0; bj < 2; ++bj) { const f32x8 b = up8(bs[mm][bj]); f32x4 a0 = acc[ai][bj][m][0], a1 = acc[ai][bj][m][1];
                    if (GATE) { const f32x8 qf = up8(q[mm][bj]); a0 = a0 * rs; a1 = a1 * rs;
#pragma unroll
                        for (int j = 0; j < 4; ++j) { a0[j] = sigm(a0[j]) * qf[j]; a1[j] = sigm(a1[j]) * qf[4 + j]; } }
                    f32x8 x;
#pragma unroll
                    for (int j = 0; j < 4; ++j) { x[j] = b[j] + a0[j]; x[4 + j] = b[4 + j] + a1[j]; }
                    const v4u w = pk8(x);
                    *(v4u*)(out + off + bj * HALF) = w;
                    const f32x8 xr = up8(w); sq += sum8(xr * xr); }
                sq += __shfl_xor(sq, 16); sq += __shfl_xor(sq, 32);
                if (fq == 0) __hip_atomic_fetch_add(ss_out + row, (u64)(sq * SS_SCALE), __ATOMIC_RELAXED, __HIP_MEMORY_SCOPE_AGENT); }
            asm volatile("" ::: "memory"); }
    }
};

struct Job { const bf16_t* A; const bf16_t* Bt; int lda, ldb, K, a_pn_step, nM, nN, mode;
             bf16_t* O; int ldc; const float* c0; const float* c1; const float* c2; const bf16_t* base; bf16_t* out; const bf16_t* pp;
             const u64* ss_in; u64* ss_out; };
__device__ __forceinline__ void run_epi(const Job& J, const f32x4 (&acc)[2][2][4][2], const Unit& u, int wr, int wc, int fr, int fq) {
    switch (J.mode) {
    case 0: { EpiB<0> E{J.O, J.ldc, nullptr, nullptr, nullptr, 0, J.ss_in}; E(acc, u, wr, wc, fr, fq); } break;
    case 1: { EpiB<1> E{J.O, J.ldc, nullptr, nullptr, nullptr, 0, J.ss_in}; E(acc, u, wr, wc, fr, fq); } break;
    case 2: { EpiB<2> E{J.O, J.ldc, J.c0, nullptr, nullptr, 0, nullptr}; E(acc, u, wr, wc, fr, fq); } break;
    case 3: { EpiB<3> E{J.O, J.ldc, J.c0, J.c1, J.c2, PLANE, nullptr}; E(acc, u, wr, wc, fr, fq); } break;
    case 4: { EpiX<false> E{J.base, J.out, nullptr, J.ldc, nullptr, J.ss_out}; E(acc, u, wr, wc, fr, fq); } break;
    default: { EpiX<true> E{J.base, J.out, J.pp, J.ldc, J.ss_in, J.ss_out}; E(acc, u, wr, wc, fr, fq); } break;
    }
}
__device__ __forceinline__ void gemm_phase(LAS unsigned char* lds, const Job& J, const StaticOrder& S, const int tid) {
    const int wid = __builtin_amdgcn_readfirstlane(tid >> 6), lane = tid & 63, wr = wid >> 2, wc = wid & 3, fr = lane & 15, fq = lane >> 4;
    const int K = J.K, nt = K / BK;
    unsigned voffA[2], voffB[2];
#pragma unroll
    for (int i = 0; i < 2; ++i) { int R, C; stage_rc(tid * 16 + i * 8192, R, C); const int Rb = (R & ~31) + perm32(R & 31);
        voffA[i] = (unsigned)(R * J.lda + C) * 2u; voffB[i] = (unsigned)(Rb * J.ldb + C) * 2u; }
    const size_t kstep = (size_t)(BK * 2);
    const size_t hstepA = (size_t)HALF * J.lda * 2, hstepB = (size_t)HALF * J.ldb * 2;
    const size_t tstepA = 2 * hstepA, tstepB = 2 * hstepB;
    const unsigned ldsw = (unsigned)wid * 1024u;
    const int aoff = lds_byte(wr * 64 + fr, fq * 8), boff = lds_byte(wc * 32 + fr, fq * 8);
#define PG8_SA(b, h) (((b) * 2 + (h)) * HTB)
#define PG8_SB(b, h) ((4 + (b) * 2 + (h)) * HTB)
#define PG8_STAGE(bufoff, gbase, voff) do { _Pragma("unroll") for (int _i = 0; _i < 2; ++_i) \
        __builtin_amdgcn_global_load_lds((const unsigned*)((const char*)(gbase) + (voff)[_i]), (LAS unsigned*)(lds + (bufoff) + ldsw + _i * 8192), 16, 0, 0); } while (0)
#define PG8_LDA(dst, b, h) do { _Pragma("unroll") for (int m = 0; m < 4; ++m) _Pragma("unroll") for (int k = 0; k < 2; ++k) dst[m][k] = *(const LAS bf16x8*)(lds + PG8_SA(b, h) + aoff + m * 2048 + k * 1024); } while (0)
#define PG8_LDB(dst, b, h) do { _Pragma("unroll") for (int n = 0; n < 2; ++n) _Pragma("unroll") for (int k = 0; k < 2; ++k) dst[n][k] = *(const LAS bf16x8*)(lds + PG8_SB(b, h) + boff + n * 2048 + k * 1024); } while (0)
#define PG8_MMA(ai, bj, At, Bt) do { __builtin_amdgcn_s_setprio(1); _Pragma("unroll") for (int m = 0; m < 4; ++m) _Pragma("unroll") for (int n = 0; n < 2; ++n) _Pragma("unroll") for (int k = 0; k < 2; ++k) \
        acc[ai][bj][m][n] = __builtin_amdgcn_mfma_f32_16x16x32_bf16(Bt[n][k], At[m][k], acc[ai][bj][m][n], 0, 0, 0); __builtin_amdgcn_s_setprio(0); } while (0)
#define PG8_WAIT_V(n) asm volatile("s_waitcnt vmcnt(" #n ")" ::: "memory")
#define PG8_WAIT_L(n) asm volatile("s_waitcnt lgkmcnt(" #n ")" ::: "memory")
#define PG8_BAR __builtin_amdgcn_s_barrier()
#define PG8_SCHED __builtin_amdgcn_sched_barrier(0)
    Unit cur, nxt; int ui = 0;
    if (!S.next(0, cur)) return;
    f32x4 acc[2][2][4][2];
#pragma unroll
    for (int a = 0; a < 2; ++a)
#pragma unroll
        for (int b = 0; b < 2; ++b)
#pragma unroll
            for (int m = 0; m < 4; ++m)
#pragma unroll
                for (int n = 0; n < 2; ++n) acc[a][b][m][n] = (f32x4){0.f, 0.f, 0.f, 0.f};
    bf16x8 At[4][2], B0[2][2], B1[2][2];
    const char* cA = (const char*)J.A + (size_t)cur.pm * tstepA + (size_t)cur.pn * J.a_pn_step * 2; const char* cB = (const char*)J.Bt + (size_t)cur.pn * tstepB;
    PG8_STAGE(PG8_SB(0, 0), cB, voffB); PG8_STAGE(PG8_SB(0, 1), cB + hstepB, voffB); PG8_STAGE(PG8_SA(0, 0), cA, voffA); PG8_STAGE(PG8_SA(0, 1), cA + hstepA, voffA);
    if (wr == 1) PG8_BAR;
    PG8_WAIT_V(2); PG8_BAR;
    PG8_STAGE(PG8_SB(1, 0), cB + kstep, voffB); PG8_STAGE(PG8_SA(1, 0), cA + kstep, voffA); PG8_STAGE(PG8_SB(1, 1), cB + hstepB + kstep, voffB);
    PG8_WAIT_V(6); PG8_BAR;
    for (;;) {
        const bool has_next = S.next(ui + 1, nxt);
        const char* nA = has_next ? (const char*)J.A + (size_t)nxt.pm * tstepA + (size_t)nxt.pn * J.a_pn_step * 2 : cA; const char* nB = has_next ? (const char*)J.Bt + (size_t)nxt.pn * tstepB : cB;
        for (int t = 0; t < nt; t += 2) {
            const bool last = (t == nt - 2);
            const char* a1 = cA + (size_t)(t + 1) * kstep;
            const char* a2 = last ? nA : cA + (size_t)(t + 2) * kstep; const char* b2 = last ? nB : cB + (size_t)(t + 2) * kstep;
            const char* a3 = a2 + kstep; const char* b3 = b2 + kstep;
            PG8_LDB(B0, 0, 0); PG8_LDB(B1, 0, 1); PG8_SCHED; PG8_LDA(At, 0, 0); PG8_STAGE(PG8_SA(1, 1), a1 + hstepA, voffA);
            PG8_WAIT_V(8); PG8_WAIT_L(0); PG8_BAR; PG8_MMA(0, 0, At, B0); PG8_MMA(0, 1, At, B1); PG8_BAR; PG8_SCHED;
            PG8_LDA(At, 0, 1); PG8_STAGE(PG8_SB(0, 0), b2, voffB); PG8_STAGE(PG8_SB(0, 1), b2 + hstepB, voffB); PG8_STAGE(PG8_SA(0, 0), a2, voffA);
            PG8_WAIT_V(8); PG8_WAIT_L(0); PG8_BAR; PG8_MMA(1, 0, At, B0); PG8_MMA(1, 1, At, B1); PG8_BAR; PG8_SCHED;
            PG8_LDB(B0, 1, 0); PG8_LDB(B1, 1, 1); PG8_SCHED; PG8_LDA(At, 1, 0); PG8_STAGE(PG8_SA(0, 1), a2 + hstepA, voffA);
            PG8_WAIT_V(8); PG8_WAIT_L(0); PG8_BAR; PG8_MMA(0, 0, At, B0); PG8_MMA(0, 1, At, B1); PG8_BAR; PG8_SCHED;
            PG8_LDA(At, 1, 1); PG8_STAGE(PG8_SB(1, 0), b3, voffB); PG8_STAGE(PG8_SB(1, 1), b3 + hstepB, voffB); PG8_STAGE(PG8_SA(1, 0), a3, voffA);
            PG8_WAIT_V(8); PG8_WAIT_L(0); PG8_BAR; PG8_MMA(1, 0, At, B0); PG8_MMA(1, 1, At, B1); PG8_BAR; PG8_SCHED;
        }
        if (wr == 0) PG8_BAR;
        run_epi(J, acc, cur, wr, wc, fr, fq);
        if (!has_next) break;
#pragma unroll
        for (int a = 0; a < 2; ++a)
#pragma unroll
            for (int b = 0; b < 2; ++b)
#pragma unroll
                for (int m = 0; m < 4; ++m)
#pragma unroll
                    for (int n = 0; n < 2; ++n) acc[a][b][m][n] = (f32x4){0.f, 0.f, 0.f, 0.f};
        cur = nxt; cA = nA; cB = nB; ++ui;
        if (wr == 1) PG8_BAR;
    }
    PG8_WAIT_V(0);
    PG8_BAR;
#undef PG8_SA
#undef PG8_SB
#undef PG8_STAGE
#undef PG8_LDA
#undef PG8_LDB
#undef PG8_MMA
#undef PG8_WAIT_V
#undef PG8_WAIT_L
#undef PG8_BAR
#undef PG8_SCHED
}
}

struct Args { const float* in[29]; float* out; unsigned char* ws; int ph_lo, ph_hi; };
typedef const __attribute__((address_space(4))) Args* ArgsP;
enum { I_X = 0, I_P, I_ATTN_NORM, I_W_IN, I_MU_SHIFT, I_W_VRES_DN, I_MU_VRES, I_V0, I_V_UP, I_POOL_W, I_POOL_SCALE, I_W0, I_W_UP, I_A0, I_A_UP, I_G_UP,
       I_K_K, I_K_A, I_R_K, I_GN_G, I_GN_B, I_W_OUT, I_MLP_NORM, I_W_FFN_UP, I_W_FFN_DOWN, I_PLE_NORM, I_W_PLE_GATE, I_W_PLE_PROJ, I_FINAL_NORM };

__device__ __forceinline__ void p0_transpose_item(const float* W, int N, bf16_t* WT, int ldd, int row_off, LAS float* scr, int item, int nblk, int lane, const float* gs) {
    const int kb = item / nblk, nb = item % nblk, k0 = 64 * kb, n0 = 32 * nb;
    const int c = lane & 7;
    f32x4 g0 = {1.f, 1.f, 1.f, 1.f}, g1 = {1.f, 1.f, 1.f, 1.f};
    if (gs) { g0 = *(const f32x4*)(gs + k0 + 8 * c); g1 = *(const f32x4*)(gs + k0 + 8 * c + 4); }
#pragma unroll
    for (int hb = 0; hb < 2; ++hb) {
        float wv[16];
#pragma unroll
        for (int i = 0; i < 16; ++i) { const int kk = 2 * (16 * hb + i) + (lane >> 5); wv[i] = W[(size_t)(k0 + kk) * N + n0 + (lane & 31)]; }
#pragma unroll
        for (int i = 0; i < 16; ++i) { const int kk = 2 * (16 * hb + i) + (lane >> 5); scr[kk * 33 + (lane & 31)] = wv[i]; }
    }
    asm volatile("s_waitcnt lgkmcnt(0)" ::: "memory");
#pragma unroll
    for (int j = 0; j < 4; ++j) { const int n = (lane >> 3) + 8 * j; const LAS float* s = scr + (8 * c) * 33 + n;
        v4u o; o.x = cvt_pk_bf16(s[0 * 33] * g0[0], s[1 * 33] * g0[1]); o.y = cvt_pk_bf16(s[2 * 33] * g0[2], s[3 * 33] * g0[3]); o.z = cvt_pk_bf16(s[4 * 33] * g1[0], s[5 * 33] * g1[1]); o.w = cvt_pk_bf16(s[6 * 33] * g1[2], s[7 * 33] * g1[3]);
        *(v4u*)(WT + (size_t)(row_off + n0 + n) * ldd + k0 + 8 * c) = o; }
    asm volatile("s_waitcnt lgkmcnt(0)" ::: "memory");
}
__device__ __forceinline__ void cvt_job(const float* W, int K, int N, bf16_t* WT, int ldd, int row_off, LAS float* scr, int gw, int NW, int lane, const float* gs = nullptr) {
    const int nblk = N / 32, nit = (K / 64) * nblk;
    for (int it = gw; it < nit; it += NW) p0_transpose_item(W, N, WT, ldd, row_off, scr, it, nblk, lane, gs);
}
__device__ __forceinline__ void phase_convert(ArgsP a, LAS unsigned char* lds, const int tid, const int bx) {
    const int lane = tid & 63, wave = tid >> 6, G = gridDim.x;
    const int gw = bx * 8 + wave, NW = G * 8; const size_t gt = (size_t)bx * 512 + tid, NT = (size_t)G * 512;
    LAS float* scr = (LAS float*)(lds + wave * 8448);
    unsigned char* ws = a->ws;
    for (int l = 0; l < DEPTH; ++l) {
        bf16_t* win = (bf16_t*)(ws + WS_WIN) + (size_t)l * NZ * DM;
        cvt_job(a->in[I_W_IN] + (size_t)l * DM * INW, DM, INW, win, DM, 0, scr, gw, NW, lane, a->in[I_ATTN_NORM] + (size_t)l * DM);
        if (l > 0) cvt_job(a->in[I_W_VRES_DN] + (size_t)(l - 1) * DM * 32, DM, 32, win, DM, INW, scr, gw, NW, lane, a->in[I_ATTN_NORM] + (size_t)l * DM);
        { const int r0 = (l == 0) ? INW : INW + 32; const size_t n16 = (size_t)(NZ - r0) * DM / 8; v4u* z = (v4u*)(win + (size_t)r0 * DM);
          for (size_t i = gt; i < n16; i += NT) z[i] = (v4u){0u, 0u, 0u, 0u}; }
        cvt_job(a->in[I_W_OUT] + (size_t)l * DM * DM, DM, DM, (bf16_t*)(ws + WS_WOUT) + (size_t)l * DM * DM, DM, 0, scr, gw, NW, lane);
        cvt_job(a->in[I_W_FFN_UP] + (size_t)l * DM * DFF, DM, DFF, (bf16_t*)(ws + WS_WUP) + (size_t)l * DFF * DM, DM, 0, scr, gw, NW, lane, a->in[I_MLP_NORM] + (size_t)l * DM);
        cvt_job(a->in[I_W_FFN_DOWN] + (size_t)l * DFF * DM, DFF, DM, (bf16_t*)(ws + WS_WDN) + (size_t)l * DM * DFF, DFF, 0, scr, gw, NW, lane);
        cvt_job(a->in[I_W_PLE_GATE] + (size_t)l * DM * DM, DM, DM, (bf16_t*)(ws + WS_WGATE) + (size_t)l * DM * DM, DM, 0, scr, gw, NW, lane, a->in[I_PLE_NORM] + (size_t)l * DM);
        cvt_job(a->in[I_W_PLE_PROJ] + (size_t)l * DPLE * DM, DPLE, DM, (bf16_t*)(ws + WS_WPROJ) + (size_t)l * DM * DPLE, DPLE, 0, scr, gw, NW, lane);
        for (int gi = 0; gi < 4; ++gi)
            cvt_job(a->in[I_POOL_W] + ((size_t)l * 4 + gi) * 256 * 256, 256, 256, (bf16_t*)(ws + WS_WPOOL) + (size_t)l * 1024 * 256, 256, gi * 256, scr, gw, NW, lane);
        { bf16_t* wl = (bf16_t*)(ws + WS_WLORA) + (size_t)l * 4096 * KL;
          const float* wu = a->in[I_W_UP] + (size_t)l * 64 * RW; const float* au = a->in[I_A_UP] + (size_t)l * 64 * RW; const float* gu = a->in[I_G_UP] + (size_t)l * 160 * RW;
          const float* vu = a->in[I_V_UP] + (size_t)(l > 0 ? l - 1 : 0) * 32 * RW;
          for (size_t idx = gt; idx < (size_t)4096 * KL; idx += NT) { const int n = (int)(idx / KL), k = (int)(idx % KL), t = n >> 10, col = n & 1023; float v = 0.f;
              if (t == 0) { if (k < 64) v = wu[(size_t)k * RW + col]; }
              else if (t == 1) { if (k >= 64 && k < 128) v = au[(size_t)(k - 64) * RW + col]; }
              else if (t == 2) { if (k >= 128 && k < 288) v = gu[(size_t)(k - 128) * RW + col]; }
              else { if (l > 0 && k >= 288 && k < 320) v = vu[(size_t)(k - 288) * RW + col]; }
              wl[idx] = (bf16_t)(cvt_pk_bf16(v, 0.f) & 0xffffu); } }
    }
    { u64* SS = (u64*)(ws + WS_SS); bf16_t* XP = (bf16_t*)(ws + WS_H); const float* x = a->in[I_X];
      for (size_t i = gt; i < (size_t)12 * M; i += NT) SS[M + i] = 0ull;
      for (int row = gw; row < M; row += NW) {
          const f32x4* xr = (const f32x4*)(x + (size_t)row * DM) + lane; float s = 0.f;
#pragma unroll
          for (int j = 0; j < 8; ++j) { const f32x4 v = xr[64 * j]; s += (v[0] * v[0] + v[1] * v[1]) + (v[2] * v[2] + v[3] * v[3]);
              v2u w; w.x = cvt_pk_bf16(v[0], v[1]); w.y = cvt_pk_bf16(v[2], v[3]); ((v2u*)(XP + (size_t)row * DM))[lane + 64 * j] = w; }
          s = wave_sum(s); if (lane == 0) SS[row] = (u64)(s * SS_SCALE); } }
    { const float* p = a->in[I_P]; bf16_t* pb = (bf16_t*)(ws + WS_PB); const size_t n8 = (size_t)DEPTH * M * DPLE / 8;
      for (size_t i = gt; i < n8; i += NT) { const f32x8 v = ld8f(p + i * 8); *(v4u*)(pb + i * 8) = pk8(v); } }
}

template <int WIN> __device__ __forceinline__ v4u pool_diff(const bf16_t* zp, int tpos) {
    const f32x8 u = up8(*(const v4u*)zp);
    v4u raw[WIN - 1];
#pragma unroll
    for (int q = 1; q < WIN; ++q) raw[q - 1] = *(const v4u*)(zp - (size_t)((q <= tpos) ? q : 0) * NZ);
    f32x8 s = u;
#pragma unroll
    for (int q = 1; q < WIN; ++q) { const float msk = (q <= tpos) ? 1.0f : 0.0f; s = s + up8(raw[q - 1]) * msk; }
    const int cnt = (tpos + 1 < WIN) ? tpos + 1 : WIN;
    return pk8(s * (1.0f / (float)cnt) - u);
}
__device__ __forceinline__ void phase_prepa(ArgsP a, int l, const int tid, const int bx) {
    const int G = gridDim.x;
    const bf16_t* Z = (const bf16_t*)(a->ws + WS_Z); bf16_t* DP = (bf16_t*)(a->ws + WS_DPOOL); bf16_t* AL = (bf16_t*)(a->ws + WS_ALORA);
    const float* mus = a->in[I_MU_SHIFT] + (size_t)l * SHIFTW; const float* muv = a->in[I_MU_VRES] + (size_t)(l > 0 ? l - 1 : 0) * 32;
    const int wave = __builtin_amdgcn_readfirstlane(tid >> 6), lane = tid & 63;
    const int gi = wave & 3, prow = (wave >> 2) * 2 + (lane >> 5), pcol = gi * 256 + 8 * (lane & 31);
    const int arow = tid / 48, acol = 8 * (tid % 48);
    for (int unit = bx; unit < M / 4; unit += G) {
        { const int row = unit * 4 + prow, tpos = row & (SEQ - 1);
          const bf16_t* zp = Z + (size_t)row * NZ + pcol; v4u d;
          if (gi == 0) d = pool_diff<2>(zp, tpos); else if (gi == 1) d = pool_diff<4>(zp, tpos); else if (gi == 2) d = pool_diff<8>(zp, tpos); else d = pool_diff<16>(zp, tpos);
          *(v4u*)(DP + (size_t)row * RW + pcol) = d; }
        if (tid < 192) {
            const int row = unit * 4 + arow, tpos = row & (SEQ - 1), c = acol; f32x8 o;
#pragma unroll
            for (int j = 0; j < 8; ++j) o[j] = 0.f;
            if (c < 288 || (c < 320 && l > 0)) {
                const bf16_t* zp = Z + (size_t)row * NZ + 4096 + c;
                const f32x8 zc = up8(*(const v4u*)zp); f32x8 zq;
                if (tpos > 0) zq = up8(*(const v4u*)(zp - NZ)); else {
#pragma unroll
                    for (int j = 0; j < 8; ++j) zq[j] = 0.f; }
                const f32x8 mu = (c < 288) ? ld8f(mus + 3072 + c) : ld8f(muv + (c - 288));
                const f32x8 zs = zc + (zq - zc) * mu;
                if (c < 64) {
#pragma unroll
                    for (int j = 0; j < 8; ++j) o[j] = 1.0f - 2.0f * __builtin_amdgcn_rcpf(1.0f + __expf(2.0f * zs[j])); }
                else if (c >= 128 && c < 288) {
#pragma unroll
                    for (int j = 0; j < 8; ++j) o[j] = sigm(zs[j]); }
                else o = zs;
            }
            *(v4u*)(AL + (size_t)row * KL + c) = pk8(o);
        }
    }
}

constexpr int TC = 32, STEPB = 1344, BUFB = TC * STEPB, YBB = TC * 16 * 4;
struct ScanRaw { v4u zr, zrp, zk, zkp, zv, zvp, ld, aa, vg, vf; };
__device__ __forceinline__ void scan_unit(ArgsP a, int l, int u, LAS unsigned char* lds, const int tid) {
    const int wave = __builtin_amdgcn_readfirstlane(tid >> 6), lane = tid & 63;
    const int bh = u >> 2, rg = u & 3, b = bh >> 4, h = bh & 15;
    const bool hasv = l > 0;
    constexpr int NC = SEQ / TC;
    const size_t rowbase = (size_t)b * SEQ;
    if (wave < 4) {
        const int rowl = 4 * wave + (lane >> 4), j = lane & 15;
        f32x2 s01 = {0.f, 0.f}, s23 = {0.f, 0.f};
        for (int c = 0; c < NC; ++c) {
            __syncthreads();
            const LAS unsigned char* buf = lds + (c & 1) * BUFB + 16 * j;
            const LAS unsigned char* vb = lds + (c & 1) * BUFB + 1280 + 4 * rowl;
            LAS float* yb = (LAS float*)(lds + 2 * BUFB + (c & 1) * YBB) + rowl + (15 - j) * 16;
            f32x4 R[3], W[3], K[3], A[3], B[3]; float V[3];
#define SC_LD(sl, tl) do { R[sl] = *(const LAS f32x4*)(buf + (tl) * STEPB); W[sl] = *(const LAS f32x4*)(buf + (tl) * STEPB + 256); K[sl] = *(const LAS f32x4*)(buf + (tl) * STEPB + 512); \
                A[sl] = *(const LAS f32x4*)(buf + (tl) * STEPB + 768); B[sl] = *(const LAS f32x4*)(buf + (tl) * STEPB + 1024); V[sl] = *(const LAS float*)(vb + (tl) * STEPB); } while (0)
            SC_LD(0, 0); SC_LD(1, 1);
            float yprev = 0.f, ysel = 0.f;
#pragma unroll
            for (int i = 0; i < TC; ++i) {
                const int sl = i % 3;
                if (i + 2 < TC) SC_LD((i + 2) % 3, i + 2);
                const f32x2 vv = {V[sl], V[sl]};
                f32x2 pp = s01 * (f32x2){A[sl][0], A[sl][1]}; pp = s23 * (f32x2){A[sl][2], A[sl][3]} + pp;
                float p = pp[0] + pp[1];
                f32x2 t01 = vv * (f32x2){K[sl][0], K[sl][1]}, t23 = vv * (f32x2){K[sl][2], K[sl][3]};
                t01 = s01 * (f32x2){W[sl][0], W[sl][1]} + t01; t23 = s23 * (f32x2){W[sl][2], W[sl][3]} + t23;
                if (i > 0) {
                    p += dpp1<0x128>(p); yprev += dpp1<0x128>(yprev);
                    p += dpp1<0x124>(p); yprev += dpp1<0x124>(yprev);
                    p += dpp1<0x122>(p); yprev += dpp1<0x122>(yprev);
                    p += dpp1<0x121>(p); yprev += dpp1<0x121>(yprev);
                    ysel = __builtin_bit_cast(float, __builtin_amdgcn_update_dpp(__builtin_bit_cast(int, yprev), __builtin_bit_cast(int, ysel), 0x111, 0xF, 0xF, false));
                    if ((i & 15) == 0) yb[((i >> 4) - 1) * 256] = ysel;
                } else {
                    p += dpp1<0x128>(p); p += dpp1<0x124>(p); p += dpp1<0x122>(p); p += dpp1<0x121>(p);
                }
                const f32x2 pv = {p, p};
                s01 = pv * (f32x2){B[sl][0], B[sl][1]} + t01; s23 = pv * (f32x2){B[sl][2], B[sl][3]} + t23;
                f32x2 yy = s01 * (f32x2){R[sl][0], R[sl][1]}; yy = s23 * (f32x2){R[sl][2], R[sl][3]} + yy;
                yprev = yy[0] + yy[1];
            }
            yprev += dpp1<0x128>(yprev); yprev += dpp1<0x124>(yprev); yprev += dpp1<0x122>(yprev); yprev += dpp1<0x121>(yprev);
            ysel = __builtin_bit_cast(float, __builtin_amdgcn_update_dpp(__builtin_bit_cast(int, yprev), __builtin_bit_cast(int, ysel), 0x111, 0xF, 0xF, false));
            yb[(TC / 16 - 1) * 256] = ysel;
#undef SC_LD
        }
        __syncthreads();
    } else {
        const int ltid = tid - 256, tl = ltid >> 3, cgp = ltid & 7;
        const int col0 = h * HS + 8 * cgp;
        const bf16_t* Z = (const bf16_t*)(a->ws + WS_Z); const bf16_t* PL = (const bf16_t*)(a->ws + WS_PLANES); const bf16_t* VF = (const bf16_t*)(a->ws + WS_VFIRST);
        bf16_t* Y = (bf16_t*)(a->ws + WS_DPOOL);
        const float* mus = a->in[I_MU_SHIFT] + (size_t)l * SHIFTW;
        const f32x8 mur = ld8f(mus + col0), muk = ld8f(mus + 1024 + col0), muv = ld8f(mus + 2048 + col0);
        const f32x8 kkc = ld8f(a->in[I_K_K] + (size_t)l * RW + col0), kac = ld8f(a->in[I_K_A] + (size_t)l * RW + col0);
        const bool vmine = (cgp >> 1) == rg;
#define SCAN_LOAD(R, cc) do { const int t_ = (cc) * TC + tl; const size_t row_ = rowbase + t_; const size_t rowp_ = (t_ > 0) ? row_ - 1 : row_; \
            const bf16_t* z_ = Z + row_ * NZ + col0; const bf16_t* zq_ = Z + rowp_ * NZ + col0; \
            R.zr = *(const v4u*)(z_ + 1024); R.zk = *(const v4u*)(z_ + 2048); R.zv = *(const v4u*)(z_ + 3072); \
            R.zrp = *(const v4u*)(zq_ + 1024); R.zkp = *(const v4u*)(zq_ + 2048); R.zvp = *(const v4u*)(zq_ + 3072); \
            R.ld = *(const v4u*)(PL + row_ * RW + col0); R.aa = *(const v4u*)(PL + PLANE + row_ * RW + col0); \
            if (hasv) { R.vg = *(const v4u*)(PL + 3 * PLANE + row_ * RW + col0); R.vf = *(const v4u*)(VF + row_ * RW + col0); } else { R.vg = R.ld; R.vf = R.ld; } } while (0)
#define SCAN_FLUSH(cc) do { const LAS float* yb_ = (const LAS float*)(lds + 2 * BUFB + ((cc) & 1) * YBB) + tl * 16 + 2 * cgp; \
            const unsigned w_ = cvt_pk_bf16(yb_[0], yb_[1]); *(unsigned*)(Y + (rowbase + (size_t)(cc) * TC + tl) * RW + h * HS + 16 * rg + 2 * cgp) = w_; } while (0)
        ScanRaw nx; SCAN_LOAD(nx, 0);
        for (int c = 0; c < NC; ++c) {
            const ScanRaw cu = nx;
            if (c + 1 < NC) SCAN_LOAD(nx, c + 1);
            const int t = c * TC + tl;
            const f32x8 zr = up8(cu.zr), zk = up8(cu.zk), zv = up8(cu.zv);
            f32x8 zrp = up8(cu.zrp), zkp = up8(cu.zkp), zvp = up8(cu.zvp);
            if (t == 0) {
#pragma unroll
                for (int q = 0; q < 8; ++q) { zrp[q] = 0.f; zkp[q] = 0.f; zvp[q] = 0.f; } }
            const f32x8 r = zr + (zrp - zr) * mur, k = zk + (zkp - zk) * muk; f32x8 v = zv + (zvp - zv) * muv;
            const f32x8 ld = up8(cu.ld), av = up8(cu.aa);
            if (hasv) v = v + (up8(cu.vf) - v) * up8(cu.vg);
            const f32x8 kk = k * kkc;
            float n2 = sum8(kk * kk); n2 += __shfl_xor(n2, 1); n2 += __shfl_xor(n2, 2); n2 += __shfl_xor(n2, 4);
            const float inv = 1.0f / fmaxf(sqrtf(n2), 1e-12f);
            const f32x8 kkn = kk * inv;
            const f32x8 kadj = k * (1.0f + (av - 1.0f) * kac);
            f32x8 dec;
#pragma unroll
            for (int q = 0; q < 8; ++q) dec[q] = __expf(ld[q]);
            const f32x8 avec = -kkn, bvec = kkn * av;
            LAS unsigned char* dst = lds + (c & 1) * BUFB + tl * STEPB + cgp * 32;
#define ST8(off, val) do { *(LAS f32x4*)(dst + (off)) = (f32x4){val[0], val[1], val[2], val[3]}; *(LAS f32x4*)(dst + (off) + 16) = (f32x4){val[4], val[5], val[6], val[7]}; } while (0)
            ST8(0, r); ST8(256, dec); ST8(512, kadj); ST8(768, avec); ST8(1024, bvec);
            if (vmine) { LAS unsigned char* dv = lds + (c & 1) * BUFB + tl * STEPB + 1280 + (cgp & 1) * 32;
                *(LAS f32x4*)(dv) = (f32x4){v[0], v[1], v[2], v[3]}; *(LAS f32x4*)(dv + 16) = (f32x4){v[4], v[5], v[6], v[7]}; }
#undef ST8
            if (c >= 2) SCAN_FLUSH(c - 2);
            __syncthreads();
        }
        __syncthreads();
        SCAN_FLUSH(NC - 2); SCAN_FLUSH(NC - 1);
#undef SCAN_LOAD
#undef SCAN_FLUSH
    }
    __syncthreads();
}

__device__ __forceinline__ void phase_post(ArgsP a, int l, const int tid, const int bx) {
    const int lane = tid & 63, wave = tid >> 6; const int gw = bx * 8 + wave, NW = gridDim.x * 8;
    const bf16_t* Z = (const bf16_t*)(a->ws + WS_Z); const bf16_t* PL = (const bf16_t*)(a->ws + WS_PLANES); bf16_t* VF = (bf16_t*)(a->ws + WS_VFIRST);
    const bf16_t* Y = (const bf16_t*)(a->ws + WS_DPOOL); bf16_t* MIX = (bf16_t*)(a->ws + WS_MIX);
    const float* mus = a->in[I_MU_SHIFT] + (size_t)l * SHIFTW;
    const bool hasv = l > 0;
    for (int it = gw; it < M * 2; it += NW) {
        const int row = it >> 1, h = (it & 1) * 8 + (lane >> 3), col = h * HS + 8 * (lane & 7), tpos = row & (SEQ - 1);
        const bf16_t* z = Z + (size_t)row * NZ + col; const bf16_t* zq = (tpos > 0) ? z - NZ : z;
        const f32x8 zr = up8(*(const v4u*)(z + 1024)), zk = up8(*(const v4u*)(z + 2048)), zv = up8(*(const v4u*)(z + 3072));
        f32x8 zrp = up8(*(const v4u*)(zq + 1024)), zkp = up8(*(const v4u*)(zq + 2048)), zvp = up8(*(const v4u*)(zq + 3072));
        if (tpos == 0) {
#pragma unroll
            for (int q = 0; q < 8; ++q) { zrp[q] = 0.f; zkp[q] = 0.f; zvp[q] = 0.f; } }
        const f32x8 r = zr + (zrp - zr) * ld8f(mus + col), k = zk + (zkp - zk) * ld8f(mus + 1024 + col); f32x8 v = zv + (zvp - zv) * ld8f(mus + 2048 + col);
        const size_t po = (size_t)row * RW + col;
        const f32x8 av = up8(*(const v4u*)(PL + PLANE + po)), gg = up8(*(const v4u*)(PL + 2 * PLANE + po));
        if (hasv) v = v + (up8(*(const v4u*)(VF + po)) - v) * up8(*(const v4u*)(PL + 3 * PLANE + po));
        else *(v4u*)(VF + po) = pk8(v);
        const f32x8 kadj = k * (1.0f + (av - 1.0f) * ld8f(a->in[I_K_A] + (size_t)l * RW + col));
        float bonus = sum8(r * kadj * ld8f(a->in[I_R_K] + (size_t)l * RW + col));
        bonus += __shfl_xor(bonus, 1); bonus += __shfl_xor(bonus, 2); bonus += __shfl_xor(bonus, 4);
        const f32x8 y = up8(*(const v4u*)(Y + po));
        float sm = sum8(y); sm += __shfl_xor(sm, 1); sm += __shfl_xor(sm, 2); sm += __shfl_xor(sm, 4);
        const float mean = sm * (1.0f / 64.0f);
        const f32x8 d = y - mean;
        float vs = sum8(d * d); vs += __shfl_xor(vs, 1); vs += __shfl_xor(vs, 2); vs += __shfl_xor(vs, 4);
        const float rstd = rsqrtf(vs * (1.0f / 64.0f) + GN_EPS);
        const f32x8 o = (d * rstd * ld8f(a->in[I_GN_G] + (size_t)l * RW + col) + ld8f(a->in[I_GN_B] + (size_t)l * RW + col) + bonus * v) * gg;
        *(v4u*)(MIX + (size_t)row * DM + 1024 + col) = pk8(o);
    }
}

#define XB_TMO      128
#define XB_XCNT(j)  (256  + 64 * (j))
#define XB_XSUB(j)  (1280 + 64 * (j))
#define XB_XGEN(j)  (2304 + 64 * (j))
#define XB_TOP      3328
#define XB_TOPGEN   3392
#define XCD_BAR_WORDS 3456
#define XB_SPIN_CAP (1u << 18)

__device__ __forceinline__ unsigned xb_ld(unsigned* p)              { return __hip_atomic_load(p, __ATOMIC_RELAXED, __HIP_MEMORY_SCOPE_AGENT); }
__device__ __forceinline__ unsigned xb_add(unsigned* p, unsigned v) { return __hip_atomic_fetch_add(p, v, __ATOMIC_RELAXED, __HIP_MEMORY_SCOPE_AGENT); }
__device__ __forceinline__ unsigned xb_xcc_id() { return (unsigned)__builtin_amdgcn_s_getreg((3 << 11) | 20) & 0xFu; }
#define XB_SPIN(cond, bar) do { unsigned _sp = 0; while (cond) { __builtin_amdgcn_s_sleep(1); \
    if ((++_sp & 255u) == 0u) { if (xb_ld(&(bar)[XB_TMO])) break; if (_sp > XB_SPIN_CAP) { atomicAdd(&(bar)[XB_TMO], 1u); break; } } } } while (0)

struct XcdBarrier {
    unsigned* bar; unsigned x;
    volatile LAS unsigned* st;
};

__device__ __forceinline__ XcdBarrier xcd_barrier_post(unsigned* bar, volatile LAS unsigned* st) {
    XcdBarrier b; b.bar = bar; b.x = xb_xcc_id(); b.st = st;
    if (threadIdx.x == 0) (void)xb_add(&bar[XB_XCNT(b.x)], 1u);
    return b;
}
__device__ __forceinline__ void xcd_barrier_complete(unsigned* bar, unsigned x, unsigned& nloc, unsigned& nx) {
    const unsigned G = gridDim.x * gridDim.y * gridDim.z;
    unsigned sum, cnt, mine, sp = 0u;
    for (;;) {
        sum = 0u; cnt = 0u; mine = 0u;
#pragma unroll
        for (unsigned j = 0; j < 16; ++j) { const unsigned c = xb_ld(&bar[XB_XCNT(j)]); sum += c; cnt += (c > 0u) ? 1u : 0u; mine = (j == x) ? c : mine; }
        if (sum == G) break;
        __builtin_amdgcn_s_sleep(1);
        if ((++sp & 255u) == 0u) { if (xb_ld(&bar[XB_TMO])) break; if (sp > XB_SPIN_CAP) { atomicAdd(&bar[XB_TMO], 1u); break; } }
    }
    nloc = mine > 0u ? mine : 1u; nx = cnt > 0u ? cnt : 1u;
}

__device__ __forceinline__ void xcd_barrier(const XcdBarrier& b) {
    asm volatile("s_waitcnt vmcnt(0)" ::: "memory");
    __syncthreads();
    if (threadIdx.x == 0) {
        unsigned* bar = b.bar;
        __builtin_amdgcn_s_waitcnt(0);
        unsigned nloc = b.st[0], nx = b.st[1];
        if (nloc == 0u) { xcd_barrier_complete(bar, b.x, nloc, nx); b.st[0] = nloc; b.st[1] = nx; }
        const unsigned old = xb_add(&bar[XB_XSUB(b.x)], 1u);
        const unsigned gen = old / nloc;
        if (old + 1u == (gen + 1u) * nloc) {
            __builtin_amdgcn_fence(__ATOMIC_RELEASE, "agent");
            asm volatile("s_waitcnt vmcnt(0)" ::: "memory");
            const unsigned og = xb_add(&bar[XB_TOP], 1u);
            const unsigned tg = og / nx;
            if (og + 1u == (tg + 1u) * nx) xb_add(&bar[XB_TOPGEN], 1u);
            else XB_SPIN(xb_ld(&bar[XB_TOPGEN]) == tg, bar);
            __builtin_amdgcn_fence(__ATOMIC_ACQUIRE, "agent");
            xb_add(&bar[XB_XGEN(b.x)], 1u);
            asm volatile("s_waitcnt vmcnt(0)" ::: "memory");
        } else {
            XB_SPIN(xb_ld(&bar[XB_XGEN(b.x)]) == gen, bar);
            __builtin_amdgcn_fence(__ATOMIC_ACQUIRE, "agent");
            asm volatile("s_waitcnt vmcnt(0)" ::: "memory");
        }
    }
    __syncthreads();
}


constexpr int N_PHASES = 2 + 9 * DEPTH;
__device__ __forceinline__ bool make_job(ArgsP a, int l, int s, int q, pg8::Job& J) {
    unsigned char* ws = a->ws; u64* SS = (u64*)(ws + WS_SS);
    bf16_t* XC = (bf16_t*)(ws + ((l & 1) ? WS_XQ : WS_H)); bf16_t* XN = (bf16_t*)(ws + ((l & 1) ? WS_H : WS_XQ));
    bf16_t* MIX = (bf16_t*)(ws + WS_MIX); bf16_t* PP = (bf16_t*)(ws + WS_MIX);
    J.a_pn_step = 0; J.nM = M / 256; J.O = nullptr; J.ldc = DM; J.c0 = nullptr; J.c1 = nullptr; J.c2 = nullptr; J.base = nullptr; J.out = nullptr; J.pp = nullptr; J.ss_in = nullptr; J.ss_out = nullptr;
    if (s == 0 && q == 0) { J.A = XC; J.Bt = (const bf16_t*)(ws + WS_WIN) + (size_t)l * NZ * DM; J.lda = DM; J.ldb = DM; J.K = DM; J.nN = NZ / 256; J.mode = 0; J.O = (bf16_t*)(ws + WS_Z); J.ldc = NZ; J.ss_in = SS + (size_t)(3 * l) * M; return true; }
    if (s == 2 && q == 0) { J.A = (const bf16_t*)(ws + WS_ALORA); J.Bt = (const bf16_t*)(ws + WS_WLORA) + (size_t)l * 4096 * KL; J.lda = KL; J.ldb = KL; J.K = KL; J.nN = 16; J.mode = 3; J.O = (bf16_t*)(ws + WS_PLANES); J.ldc = RW;
                            J.c0 = a->in[I_W0] + (size_t)l * RW; J.c1 = a->in[I_A0] + (size_t)l * RW; J.c2 = (l > 0) ? a->in[I_V0] + (size_t)(l - 1) * RW : nullptr; return true; }
    if (s == 2 && q == 1) { J.A = (const bf16_t*)(ws + WS_DPOOL); J.Bt = (const bf16_t*)(ws + WS_WPOOL) + (size_t)l * 1024 * 256; J.lda = RW; J.ldb = 256; J.K = 256; J.a_pn_step = 256; J.nN = 4; J.mode = 2; J.O = MIX; J.ldc = DM;
                            J.c0 = a->in[I_POOL_SCALE] + (size_t)l * 1024; return true; }
    if (s == 5 && q == 0) { J.A = MIX; J.Bt = (const bf16_t*)(ws + WS_WOUT) + (size_t)l * DM * DM; J.lda = DM; J.ldb = DM; J.K = DM; J.nN = DM / 256; J.mode = 4; J.base = XC; J.out = XC; J.ss_out = SS + (size_t)(3 * l + 1) * M; return true; }
    if (s == 6 && q == 0) { J.A = XC; J.Bt = (const bf16_t*)(ws + WS_WUP) + (size_t)l * DFF * DM; J.lda = DM; J.ldb = DM; J.K = DM; J.nN = DFF / 256; J.mode = 1; J.O = (bf16_t*)(ws + WS_U); J.ldc = DFF; J.ss_in = SS + (size_t)(3 * l + 1) * M; return true; }
    if (s == 6 && q == 1) { J.A = (const bf16_t*)(ws + WS_PB) + (size_t)l * M * DPLE; J.Bt = (const bf16_t*)(ws + WS_WPROJ) + (size_t)l * DM * DPLE; J.lda = DPLE; J.ldb = DPLE; J.K = DPLE; J.nN = DM / 256; J.mode = 0; J.O = PP; J.ldc = DM; return true; }
    if (s == 7 && q == 0) { J.A = (const bf16_t*)(ws + WS_U); J.Bt = (const bf16_t*)(ws + WS_WDN) + (size_t)l * DM * DFF; J.lda = DFF; J.ldb = DFF; J.K = DFF; J.nN = DM / 256; J.mode = 4; J.base = XC; J.out = XC; J.ss_out = SS + (size_t)(3 * l + 2) * M; return true; }
    if (s == 8 && q == 0) { J.A = XC; J.Bt = (const bf16_t*)(ws + WS_WGATE) + (size_t)l * DM * DM; J.lda = DM; J.ldb = DM; J.K = DM; J.nN = DM / 256; J.mode = 5; J.base = XC; J.out = XN; J.pp = PP; J.ss_in = SS + (size_t)(3 * l + 2) * M;
                            J.ss_out = SS + (size_t)(3 * l + 3) * M; return true; }
    return false;
}
__device__ __forceinline__ void phase_final(ArgsP a, const int tid, const int bx) {
    const int lane = tid & 63, wave = tid >> 6; const int gw = bx * 8 + wave, NW = gridDim.x * 8;
    const bf16_t* X = (const bf16_t*)(a->ws + ((DEPTH & 1) ? WS_XQ : WS_H)); const u64* SS = (const u64*)(a->ws + WS_SS) + (size_t)(3 * DEPTH) * M; const float* g = a->in[I_FINAL_NORM]; float* out = a->out;
    f32x8 gv[4];
#pragma unroll
    for (int j = 0; j < 4; ++j) gv[j] = ld8f(g + 8 * lane + 512 * j);
    for (int row = gw; row < M; row += NW) {
        const float rs = rsqrtf((float)SS[row] * SS_INV + NORM_EPS);
#pragma unroll
        for (int j = 0; j < 4; ++j) { const f32x8 o = up8(*(const v4u*)(X + (size_t)row * DM + 8 * lane + 512 * j)) * rs * gv[j]; float* op = out + (size_t)row * DM + 8 * lane + 512 * j;
            *(f32x4*)op = (f32x4){o[0], o[1], o[2], o[3]}; *(f32x4*)(op + 4) = (f32x4){o[4], o[5], o[6], o[7]}; }
    }
}
constexpr int dup_count() { int c = 0; for (int s = 0; s < 9; ++s) c += (PROBE_DUP >> s) & 1; return c; }
constexpr int SUBS = 9 + dup_count(), PRE = 1 + ((PROBE_DUP >> 9) & 1);
constexpr int N_PHASES_RUN = PRE + SUBS * DEPTH + 1;
__global__ void __launch_bounds__(512, 2) fwd_megakernel(Args a_byval) {
    ArgsP a = (ArgsP)__builtin_amdgcn_kernarg_segment_ptr();
    extern __shared__ __attribute__((aligned(16))) unsigned char lds_raw[];
    LAS unsigned char* lds = (LAS unsigned char*)lds_raw;
    cg::grid_group grid = cg::this_grid();
    const int G = gridDim.x;
    if (threadIdx.x < 16) ((LAS unsigned*)(lds + BAR_LDS_OFF))[threadIdx.x] = 0u;
    __syncthreads();
    XcdBarrier xbar = xcd_barrier_post((unsigned*)a->ws, (volatile LAS unsigned*)(lds + BAR_LDS_OFF));
    const int ph_lo = a->ph_lo, ph_hi = a->ph_hi;
    const int wave_s = __builtin_amdgcn_readfirstlane((int)threadIdx.x >> 6);
    if (ph_lo < 0) grid.sync();
    for (int ph = ph_lo; ph < ph_hi; ++ph) {
        if (ph > ph_lo) xcd_barrier(xbar);
        asm volatile("" : "+s"(a) :: "memory");
        int tid = (wave_s << 6) + (int)__builtin_amdgcn_mbcnt_hi(~0u, __builtin_amdgcn_mbcnt_lo(~0u, 0u)), bx = blockIdx.x; asm volatile("" : "+v"(tid), "+s"(bx));
        int l = 0, s;
        if (ph < PRE) s = 13;
        else if (ph == N_PHASES_RUN - 1) s = 12;
        else { l = (ph - PRE) / SUBS; const int qq = (ph - PRE) % SUBS; int c = 0; s = 0;
               for (; s < 9; ++s) { const int n = 1 + ((PROBE_DUP >> s) & 1); if (qq < c + n) break; c += n; } }
        if (s == 13) { phase_convert(a, lds, tid, bx); }
        else if (s == 12) { phase_final(a, tid, bx); }
        else if (s == 1) { phase_prepa(a, l, tid, bx); }
        else if (s == 3) { const int vcu = (G % 8 == 0) ? (bx % 8) * (G / 8) + bx / 8 : bx; for (int u = vcu; u < 256; u += G) scan_unit(a, l, u, lds, tid); }
        else if (s == 4) { phase_post(a, l, tid, bx); }
        else {
            for (int q = 0; q < 2; ++q) { pg8::Job J; if (!make_job(a, l, s, q, J)) break;
                pg8::StaticOrder S; S.init(J.nM, J.nN, G, bx); pg8::gemm_phase(lds, J, S, tid); }
        }
    }
}

extern "C" void kernel_launch(void* const* d_in, const int* in_sizes, int n_in, void* d_out, int out_size, void* d_ws, size_t ws_size, hipStream_t stream) {
    static int grid = 0;
    if (grid == 0) {
        if (n_in != 29 || in_sizes[0] != M * DM || out_size != M * DM || ws_size < WS_END) {
            fprintf(stderr, "kernel_launch: unexpected shapes: n_in %d in0 %d out %d ws %zu (need %zu); nothing launched\n", n_in, n_in > 0 ? in_sizes[0] : -1, out_size, ws_size, (size_t)WS_END); grid = -1; return; }
        int dev = 0, cus = 0, per_cu = 0;
        if (hipGetDevice(&dev) != hipSuccess || hipDeviceGetAttribute(&cus, hipDeviceAttributeMultiprocessorCount, dev) != hipSuccess) { fprintf(stderr, "kernel_launch: device query failed\n"); grid = -1; return; }
        if (hipFuncSetAttribute((const void*)fwd_megakernel, hipFuncAttributeMaxDynamicSharedMemorySize, LDS_BYTES) != hipSuccess) { fprintf(stderr, "kernel_launch: hipFuncSetAttribute failed\n"); grid = -1; return; }
        if (hipOccupancyMaxActiveBlocksPerMultiprocessor(&per_cu, (const void*)fwd_megakernel, 512, LDS_BYTES) != hipSuccess || per_cu < 1) {
            fprintf(stderr, "kernel_launch: occupancy query says %d blocks/CU; using 1\n", per_cu); per_cu = 1; }
        (void)hipGetLastError();
        grid = cus * 1;
        if (grid > 256) grid = 256;
    }
    if (grid < 0) return;
    Args a{};
    for (int i = 0; i < 29; ++i) a.in[i] = (const float*)d_in[i];
    a.out = (float*)d_out; a.ws = (unsigned char*)d_ws;
    if (hipMemsetAsync(d_ws, 0, 65536, stream) != hipSuccess) { fprintf(stderr, "kernel_launch: memset of barrier words failed\n"); return; }
#if MK_PER_PHASE_LAUNCH
    for (int ph = 0; ph < N_PHASES_RUN; ++ph) {
        a.ph_lo = ph; a.ph_hi = ph + 1;
        hipLaunchKernelGGL(fwd_megakernel, dim3(grid), dim3(512), LDS_BYTES, stream, a);
    }
#else
    a.ph_lo = 0; a.ph_hi = N_PHASES_RUN;
    void* args[] = {&a};
    hipError_t e = hipLaunchCooperativeKernel((const void*)fwd_megakernel, dim3(grid), dim3(512), args, LDS_BYTES, stream);
    if (e != hipSuccess) fprintf(stderr, "cooperative launch failed: %s (grid %d)\n", hipGetErrorString(e), grid);
#endif
}
```

```cpp
#include <hip/hip_runtime.h>
#include <hip/hip_cooperative_groups.h>
#include <cstdio>
#include <cstdint>
namespace cg = cooperative_groups;

#ifndef MK_PER_PHASE_LAUNCH
#define MK_PER_PHASE_LAUNCH 0
#endif

#ifndef PROBE_DUP
#define PROBE_DUP 0
#endif
#define LAS __attribute__((address_space(3)))
typedef unsigned short bf16_t;
typedef short bf16x8 __attribute__((ext_vector_type(8)));
typedef float f32x4 __attribute__((ext_vector_type(4)));
typedef float f32x8 __attribute__((ext_vector_type(8)));
typedef float f32x2 __attribute__((ext_vector_type(2)));
typedef unsigned v4u __attribute__((ext_vector_type(4)));
typedef unsigned v2u __attribute__((ext_vector_type(2)));

constexpr int BATCH = 4, SEQ = 4096, DM = 2048, DEPTH = 4, M = BATCH * SEQ;
constexpr int RW = 1024, HS = 64, NH = 16, DFF = 8192, DPLE = 256;
constexpr int INW = 4384, NZ = 4608, SHIFTW = 3360, KL = 384;
constexpr float NORM_EPS = 1e-6f, GN_EPS = 64e-5f;

constexpr size_t MiB = 1u << 20;
constexpr size_t WS_WIN = 1 * MiB, WS_WOUT = 73 * MiB, WS_WUP = 105 * MiB, WS_WDN = 233 * MiB, WS_WGATE = 361 * MiB, WS_WPROJ = 393 * MiB,
                 WS_WLORA = 397 * MiB, WS_WPOOL = 409 * MiB, WS_PB = 411 * MiB, WS_H = 443 * MiB, WS_MIX = 507 * MiB  ,
                 WS_DPOOL = 571 * MiB  , WS_ALORA = 603 * MiB, WS_VFIRST = 615 * MiB, WS_Z = 647 * MiB, WS_PLANES = 791 * MiB,
                 WS_U = 647 * MiB  , WS_XQ = 919 * MiB, WS_SS = 983 * MiB  , WS_END = 985 * MiB;
typedef unsigned long long u64;
constexpr float SS_SCALE = 1048576.0f, SS_INV = 1.0f / (1048576.0f * 2048.0f);
constexpr size_t PLANE = (size_t)M * RW;

constexpr int LDS_BYTES = 135168, BAR_LDS_OFF = 131072 + 256;

__device__ __forceinline__ unsigned cvt_pk_bf16(float lo, float hi) { unsigned r; asm volatile("v_cvt_pk_bf16_f32 %0, %1, %2" : "=v"(r) : "v"(lo), "v"(hi)); return r; }
__device__ __forceinline__ float bf2f(unsigned h) { return __uint_as_float(h << 16); }
__device__ __forceinline__ f32x8 up8(v4u p) {
    f32x8 r;
    r[0] = __uint_as_float(p.x << 16); r[1] = __uint_as_float(p.x & 0xffff0000u);
    r[2] = __uint_as_float(p.y << 16); r[3] = __uint_as_float(p.y & 0xffff0000u);
    r[4] = __uint_as_float(p.z << 16); r[5] = __uint_as_float(p.z & 0xffff0000u);
    r[6] = __uint_as_float(p.w << 16); r[7] = __uint_as_float(p.w & 0xffff0000u);
    return r;
}
__device__ __forceinline__ v4u pk8(f32x8 v) { v4u o; o.x = cvt_pk_bf16(v[0], v[1]); o.y = cvt_pk_bf16(v[2], v[3]); o.z = cvt_pk_bf16(v[4], v[5]); o.w = cvt_pk_bf16(v[6], v[7]); return o; }
__device__ __forceinline__ f32x8 ld8f(const float* p) { const f32x4 a = *(const f32x4*)p, b = *(const f32x4*)(p + 4); f32x8 r; r[0] = a[0]; r[1] = a[1]; r[2] = a[2]; r[3] = a[3]; r[4] = b[0]; r[5] = b[1]; r[6] = b[2]; r[7] = b[3]; return r; }
__device__ __forceinline__ float sigm(float x) { return __builtin_amdgcn_rcpf(1.0f + __expf(-x)); }
__device__ __forceinline__ float wave_sum(float v) {
#pragma unroll
    for (int o = 1; o < 64; o <<= 1) v += __shfl_xor(v, o);
    return v;
}
__device__ __forceinline__ float sum8(f32x8 v) { return ((v[0] + v[1]) + (v[2] + v[3])) + ((v[4] + v[5]) + (v[6] + v[7])); }
template <int CTRL> __device__ __forceinline__ float dpp1(float x) { const int xi = __builtin_bit_cast(int, x); return __builtin_bit_cast(float, __builtin_amdgcn_update_dpp(0, xi, CTRL, 0xF, 0xF, true)); }
template <int CTRL> __device__ __forceinline__ float dpp_mov(float x) { const int xi = __builtin_bit_cast(int, x); return __builtin_bit_cast(float, __builtin_amdgcn_update_dpp(xi, xi, CTRL, 0xF, 0xF, false)); }
__device__ __forceinline__ float allreduce16(float x) {
    x += dpp_mov<0x128>(x); x += dpp_mov<0x124>(x); x += dpp_mov<0x122>(x); x += dpp_mov<0x121>(x); return x;
}

namespace pg8 {
constexpr int BM = 256, BK = 64, HALF = 128, HTB = HALF * BK * 2, STAGE_BYTES = 8 * HTB, NXCD = 8, WGM = 8;
__host__ __device__ __forceinline__ int lds_byte(int r, int c) { const int st = (r >> 4) * 2 + (c >> 5), rr = r & 15, cc = c & 31, ob = rr * 64 + cc * 2; return st * 1024 + (ob ^ (((ob >> 9) & 1) << 5)); }
__host__ __device__ __forceinline__ void stage_rc(int b, int& R, int& C) { const int st = b / 1024, sb = b % 1024, swz = sb ^ (((sb >> 9) & 1) << 5); R = (st >> 1) * 16 + swz / 64; C = (st & 1) * 32 + (swz % 64) / 2; }
__host__ __device__ __forceinline__ int perm32(int rho) { const int n = rho >> 4, i = rho & 15; return 8 * (i >> 2) + 4 * n + (i & 3); }

struct Unit { int pm, pn; };

struct StaticOrder {
    int nM, nN, nwg, G, c;
    __device__ void init(int nM_, int nN_, int G_, int c_) { nM = nM_; nN = nN_; nwg = nM * nN; G = G_; c = c_; }
    __device__ bool next(int i, Unit& u) const {
        const long L = (long)i * G + c; if (L >= nwg) return false;
        int wgid = (int)L; { const int q = nwg / NXCD, r = nwg % NXCD, xcd = wgid % NXCD, off = wgid / NXCD; wgid = (xcd < r ? xcd * (q + 1) : r * (q + 1) + (xcd - r) * q) + off; }
        const int nig = WGM * nN, gid = wgid / nig, fm = gid * WGM, gsz = (nM - fm) < WGM ? (nM - fm) : WGM;
        u.pm = __builtin_amdgcn_readfirstlane(fm + ((wgid % nig) % gsz)); u.pn = __builtin_amdgcn_readfirstlane((wgid % nig) / gsz); return true;
    }
};

template <int MODE> struct EpiB {
    static constexpr bool PERM = true;
    bf16_t* O; int ldc; const float* c0; const float* c1; const float* c2; size_t plane; const u64* ss;
    __device__ __forceinline__ void operator()(const f32x4 (&acc)[2][2][4][2], const Unit& u, int wr, int wc, int fr, int fq) const {
        const int row0 = u.pm * BM + wr * 64 + fr; int colt = u.pn * BM; bf16_t* base = O; int t = 0;
        if (MODE == 3) { t = colt >> 10; base += (size_t)t * plane; colt &= 1023; }
        const int col0 = colt + wc * 32 + 8 * fq;
        f32x4 cv[2][2];
#pragma unroll
        for (int bj = 0; bj < 2; ++bj)
#pragma unroll
            for (int n = 0; n < 2; ++n) {
                cv[bj][n] = (f32x4){0.f, 0.f, 0.f, 0.f};
                if (MODE == 2) cv[bj][n] = *(const f32x4*)(c0 + col0 + bj * HALF + 4 * n);
                if (MODE == 3) { const float* b = (t == 0) ? c0 : (t == 1) ? c1 : (t == 3) ? c2 : nullptr; if (b) cv[bj][n] = *(const f32x4*)(b + col0 + bj * HALF + 4 * n); }
            }
        float rsv[2][4];
#pragma unroll
        for (int ai = 0; ai < 2; ++ai)
#pragma unroll
            for (int m = 0; m < 4; ++m) { rsv[ai][m] = 1.0f; if (MODE < 2) { if (ss) rsv[ai][m] = rsqrtf((float)ss[row0 + ai * HALF + m * 16] * SS_INV + NORM_EPS); } }
#pragma unroll
        for (int ai = 0; ai < 2; ++ai)
#pragma unroll
            for (int m = 0; m < 4; ++m) { bf16_t* rowp = base + (size_t)(row0 + ai * HALF + m * 16) * ldc + col0;
                const float rs = rsv[ai][m];
#pragma unroll
                for (int bj = 0; bj < 2; ++bj) { f32x4 v0 = acc[ai][bj][m][0], v1 = acc[ai][bj][m][1];
                    if (MODE < 2) { v0 = v0 * rs; v1 = v1 * rs; }
                    if (MODE == 1) {
#pragma unroll
                        for (int j = 0; j < 4; ++j) { const float a = fmaxf(v0[j], 0.f), b = fmaxf(v1[j], 0.f); v0[j] = a * a; v1[j] = b * b; } }
                    if (MODE == 2) { v0 = v0 * cv[bj][0]; v1 = v1 * cv[bj][1]; }
                    if (MODE == 3) { v0 = v0 + cv[bj][0]; v1 = v1 + cv[bj][1];
                        if (t == 0) {
#pragma unroll
                            for (int j = 0; j < 4; ++j) { v0[j] = -0.6065306597f * sigm(v0[j]); v1[j] = -0.6065306597f * sigm(v1[j]); } }
                        else if (t != 2) {
#pragma unroll
                            for (int j = 0; j < 4; ++j) { v0[j] = sigm(v0[j]); v1[j] = sigm(v1[j]); } }
                    }
                    v4u w; w.x = cvt_pk_bf16(v0[0], v0[1]); w.y = cvt_pk_bf16(v0[2], v0[3]); w.z = cvt_pk_bf16(v1[0], v1[1]); w.w = cvt_pk_bf16(v1[2], v1[3]);
                    *(v4u*)(rowp + bj * HALF) = w; } }
    }
};
template <bool GATE> struct EpiX {
    static constexpr int RB = GATE ? 2 : 4;
    const bf16_t* base; bf16_t* out; const bf16_t* pp; int ldc; const u64* ss_in; u64* ss_out;
    __device__ __forceinline__ void operator()(const f32x4 (&acc)[2][2][4][2], const Unit& u, int wr, int wc, int fr, int fq) const {
        const int row0 = u.pm * BM + wr * 64 + fr, col0 = u.pn * BM + wc * 32 + 8 * fq;
        float rsv[2][4];
#pragma unroll
        for (int ai = 0; ai < 2; ++ai)
#pragma unroll
            for (int m = 0; m < 4; ++m) { rsv[ai][m] = 1.0f; if (GATE) rsv[ai][m] = rsqrtf((float)ss_in[row0 + ai * HALF + m * 16] * SS_INV + NORM_EPS); }
#pragma unroll
        for (int aim = 0; aim < 8 / RB; ++aim) { const int ai = (aim * RB) >> 2, m0 = (aim * RB) & 3;
            v4u bs[RB][2], q[RB][2];
#pragma unroll
            for (int mm = 0; mm < RB; ++mm) { const size_t off = (size_t)(row0 + ai * HALF + (m0 + mm) * 16) * ldc + col0;
#pragma unroll
                for (int bj = 0; bj < 2; ++bj) { bs[mm][bj] = *(const v4u*)(base + off + bj * HALF); if (GATE) q[mm][bj] = *(const v4u*)(pp + off + bj * HALF); } }
#pragma unroll
            for (int mm = 0; mm < RB; ++mm) { const int m = m0 + mm, row = row0 + ai * HALF + m * 16; const size_t off = (size_t)row * ldc + col0; const float rs = rsv[ai][m];
                float sq = 0.f;
#pragma unroll
                for (int bj = 0; bj < 2; ++bj) { const f32x8 b = up8(bs[mm][bj]); f32x4 a0 = acc[ai][bj][m][0], a1 = acc[ai][bj][m][1];
                    if (GATE) { const f32x8 qf = up8(q[mm][bj]); a0 = a0 * rs; a1 = a1 * rs;
#pragma unroll
                        for (int j = 0; j < 4; ++j) { a0[j] = sigm(a0[j]) * qf[j]; a1[j] = sigm(a1[j]) * qf[4 + j]; } }
                    f32x8 x;
#pragma unroll
                    for (int j = 0; j < 4; ++j) { x[j] = b[j] + a0[j]; x[4 + j] = b[4 + j] + a1[j]; }
                    const v4u w = pk8(x);
                    *(v4u*)(out + off + bj * HALF) = w;
                    const f32x8 xr = up8(w); sq += sum8(xr * xr); }
                sq += __shfl_xor(sq, 16); sq += __shfl_xor(sq, 32);
                if (fq == 0) __hip_atomic_fetch_add(ss_out + row, (u64)(sq * SS_SCALE), __ATOMIC_RELAXED, __HIP_MEMORY_SCOPE_AGENT); }
            asm volatile("" ::: "memory"); }
    }
};

struct Job { const bf16_t* A; const bf16_t* Bt; int lda, ldb, K, a_pn_step, nM, nN, mode;
             bf16_t* O; int ldc; const float* c0; const float* c1; const float* c2; const bf16_t* base; bf16_t* out; const bf16_t* pp;
             const u64* ss_in; u64* ss_out; };
__device__ __forceinline__ void run_epi(const Job& J, const f32x4 (&acc)[2][2][4][2], const Unit& u, int wr, int wc, int fr, int fq) {
    switch (J.mode) {
    case 0: { EpiB<0> E{J.O, J.ldc, nullptr, nullptr, nullptr, 0, J.ss_in}; E(acc, u, wr, wc, fr, fq); } break;
    case 1: { EpiB<1> E{J.O, J.ldc, nullptr, nullptr, nullptr, 0, J.ss_in}; E(acc, u, wr, wc, fr, fq); } break;
    case 2: { EpiB<2> E{J.O, J.ldc, J.c0, nullptr, nullptr, 0, nullptr}; E(acc, u, wr, wc, fr, fq); } break;
    case 3: { EpiB<3> E{J.O, J.ldc, J.c0, J.c1, J.c2, PLANE, nullptr}; E(acc, u, wr, wc, fr, fq); } break;
    case 4: { EpiX<false> E{J.base, J.out, nullptr, J.ldc, nullptr, J.ss_out}; E(acc, u, wr, wc, fr, fq); } break;
    default: { EpiX<true> E{J.base, J.out, J.pp, J.ldc, J.ss_in, J.ss_out}; E(acc, u, wr, wc, fr, fq); } break;
    }
}
__device__ __forceinline__ void gemm_phase(LAS unsigned char* lds, const Job& J, const StaticOrder& S, const int tid) {
    const int wid = __builtin_amdgcn_readfirstlane(tid >> 6), lane = tid & 63, wr = wid >> 2, wc = wid & 3, fr = lane & 15, fq = lane >> 4;
    const int K = J.K, nt = K / BK;
    unsigned voffA[2], voffB[2];
#pragma unroll
    for (int i = 0; i < 2; ++i) { int R, C; stage_rc(tid * 16 + i * 8192, R, C); const int Rb = (R & ~31) + perm32(R & 31);
        voffA[i] = (unsigned)(R * J.lda + C) * 2u; voffB[i] = (unsigned)(Rb * J.ldb + C) * 2u; }
    const unsigned kstep = (unsigned)(BK * 2);
    const unsigned hstepA = (unsigned)HALF * J.lda * 2, hstepB = (unsigned)HALF * J.ldb * 2;
    const unsigned tstepA = 2 * hstepA, tstepB = 2 * hstepB;
    const __amdgpu_buffer_rsrc_t rsA = __builtin_amdgcn_make_buffer_rsrc((void*)J.A, 0, 0x7fffffff, 0x00020000);
    const __amdgpu_buffer_rsrc_t rsB = __builtin_amdgcn_make_buffer_rsrc((void*)J.Bt, 0, 0x7fffffff, 0x00020000);
    const unsigned ldsw = (unsigned)wid * 1024u;
    const int aoff = lds_byte(wr * 64 + fr, fq * 8), boff = lds_byte(wc * 32 + fr, fq * 8);
#define PG8_SA(b, h) (((b) * 2 + (h)) * HTB)
#define PG8_SB(b, h) ((4 + (b) * 2 + (h)) * HTB)
#define PG8_STAGE(bufoff, goff, voff) do { _Pragma("unroll") for (int _i = 0; _i < 2; ++_i) \
        __builtin_amdgcn_raw_ptr_buffer_load_lds(PG8_RS_##voff, (LAS unsigned*)(lds + (bufoff) + ldsw + _i * 8192), 16, (voff)[_i], (goff), 0, 0); } while (0)
#define PG8_RS_voffA rsA
#define PG8_RS_voffB rsB
#define PG8_LDA(dst, b, h) do { _Pragma("unroll") for (int m = 0; m < 4; ++m) _Pragma("unroll") for (int k = 0; k < 2; ++k) dst[m][k] = *(const LAS bf16x8*)(lds + PG8_SA(b, h) + aoff + m * 2048 + k * 1024); } while (0)
#define PG8_LDB(dst, b, h) do { _Pragma("unroll") for (int n = 0; n < 2; ++n) _Pragma("unroll") for (int k = 0; k < 2; ++k) dst[n][k] = *(const LAS bf16x8*)(lds + PG8_SB(b, h) + boff + n * 2048 + k * 1024); } while (0)
#define PG8_MMA(ai, bj, At, Bt) do { __builtin_amdgcn_s_setprio(1); _Pragma("unroll") for (int m = 0; m < 4; ++m) _Pragma("unroll") for (int n = 0; n < 2; ++n) _Pragma("unroll") for (int k = 0; k < 2; ++k) \
        acc[ai][bj][m][n] = __builtin_amdgcn_mfma_f32_16x16x32_bf16(Bt[n][k], At[m][k], acc[ai][bj][m][n], 0, 0, 0); __builtin_amdgcn_s_setprio(0); } while (0)
#define PG8_WAIT_V(n) asm volatile("s_waitcnt vmcnt(" #n ")" ::: "memory")
#define PG8_WAIT_L(n) asm volatile("s_waitcnt lgkmcnt(" #n ")" ::: "memory")
#define PG8_BAR __builtin_amdgcn_s_barrier()
#define PG8_SCHED __builtin_amdgcn_sched_barrier(0)
    Unit cur, nxt; int ui = 0;
    if (!S.next(0, cur)) return;
    f32x4 acc[2][2][4][2];
#pragma unroll
    for (int a = 0; a < 2; ++a)
#pragma unroll
        for (int b = 0; b < 2; ++b)
#pragma unroll
            for (int m = 0; m < 4; ++m)
#pragma unroll
                for (int n = 0; n < 2; ++n) acc[a][b][m][n] = (f32x4){0.f, 0.f, 0.f, 0.f};
    bf16x8 At[4][2], B0[2][2], B1[2][2];
    unsigned cA = (unsigned)cur.pm * tstepA + (unsigned)cur.pn * J.a_pn_step * 2; unsigned cB = (unsigned)cur.pn * tstepB;
    PG8_STAGE(PG8_SB(0, 0), cB, voffB); PG8_STAGE(PG8_SB(0, 1), cB + hstepB, voffB); PG8_STAGE(PG8_SA(0, 0), cA, voffA); PG8_STAGE(PG8_SA(0, 1), cA + hstepA, voffA);
    if (wr == 1) PG8_BAR;
    PG8_WAIT_V(2); PG8_BAR;
    PG8_STAGE(PG8_SB(1, 0), cB + kstep, voffB); PG8_STAGE(PG8_SA(1, 0), cA + kstep, voffA); PG8_STAGE(PG8_SB(1, 1), cB + hstepB + kstep, voffB);
    PG8_WAIT_V(6); PG8_BAR;
    for (;;) {
        const bool has_next = S.next(ui + 1, nxt);
        const unsigned nA = has_next ? (unsigned)nxt.pm * tstepA + (unsigned)nxt.pn * J.a_pn_step * 2 : cA; const unsigned nB = has_next ? (unsigned)nxt.pn * tstepB : cB;
        for (int t = 0; t < nt; t += 2) {
            const bool last = (t == nt - 2);
            const unsigned a1 = cA + (unsigned)(t + 1) * kstep;
            const unsigned a2 = last ? nA : cA + (unsigned)(t + 2) * kstep; const unsigned b2 = last ? nB : cB + (unsigned)(t + 2) * kstep;
            const unsigned a3 = a2 + kstep; const unsigned b3 = b2 + kstep;
            PG8_LDB(B0, 0, 0); PG8_LDB(B1, 0, 1); PG8_SCHED; PG8_LDA(At, 0, 0); PG8_STAGE(PG8_SA(1, 1), a1 + hstepA, voffA);
            PG8_WAIT_V(8); PG8_WAIT_L(0); PG8_BAR; PG8_MMA(0, 0, At, B0); PG8_MMA(0, 1, At, B1); PG8_BAR; PG8_SCHED;
            PG8_LDA(At, 0, 1); PG8_STAGE(PG8_SB(0, 0), b2, voffB); PG8_STAGE(PG8_SB(0, 1), b2 + hstepB, voffB); PG8_STAGE(PG8_SA(0, 0), a2, voffA);
            PG8_WAIT_V(8); PG8_WAIT_L(0); PG8_BAR; PG8_MMA(1, 0, At, B0); PG8_MMA(1, 1, At, B1); PG8_BAR; PG8_SCHED;
            PG8_LDB(B0, 1, 0); PG8_LDB(B1, 1, 1); PG8_SCHED; PG8_LDA(At, 1, 0); PG8_STAGE(PG8_SA(0, 1), a2 + hstepA, voffA);
            PG8_WAIT_V(8); PG8_WAIT_L(0); PG8_BAR; PG8_MMA(0, 0, At, B0); PG8_MMA(0, 1, At, B1); PG8_BAR; PG8_SCHED;
            PG8_LDA(At, 1, 1); PG8_STAGE(PG8_SB(1, 0), b3, voffB); PG8_STAGE(PG8_SB(1, 1), b3 + hstepB, voffB); PG8_STAGE(PG8_SA(1, 0), a3, voffA);
            PG8_WAIT_V(8); PG8_WAIT_L(0); PG8_BAR; PG8_MMA(1, 0, At, B0); PG8_MMA(1, 1, At, B1); PG8_BAR; PG8_SCHED;
        }
        if (wr == 0) PG8_BAR;
        run_epi(J, acc, cur, wr, wc, fr, fq);
        if (!has_next) break;
#pragma unroll
        for (int a = 0; a < 2; ++a)
#pragma unroll
            for (int b = 0; b < 2; ++b)
#pragma unroll
                for (int m = 0; m < 4; ++m)
#pragma unroll
                    for (int n = 0; n < 2; ++n) acc[a][b][m][n] = (f32x4){0.f, 0.f, 0.f, 0.f};
        cur = nxt; cA = nA; cB = nB; ++ui;
        if (wr == 1) PG8_BAR;
    }
    PG8_WAIT_V(0);
    PG8_BAR;
#undef PG8_SA
#undef PG8_SB
#undef PG8_STAGE
#undef PG8_RS_voffA
#undef PG8_RS_voffB
#undef PG8_LDA
#undef PG8_LDB
#undef PG8_MMA
#undef PG8_WAIT_V
#undef PG8_WAIT_L
#undef PG8_BAR
#undef PG8_SCHED
}
}

struct Args { const float* in[29]; float* out; unsigned char* ws; int ph_lo, ph_hi; };
typedef const __attribute__((address_space(4))) Args* ArgsP;
enum { I_X = 0, I_P, I_ATTN_NORM, I_W_IN, I_MU_SHIFT, I_W_VRES_DN, I_MU_VRES, I_V0, I_V_UP, I_POOL_W, I_POOL_SCALE, I_W0, I_W_UP, I_A0, I_A_UP, I_G_UP,
       I_K_K, I_K_A, I_R_K, I_GN_G, I_GN_B, I_W_OUT, I_MLP_NORM, I_W_FFN_UP, I_W_FFN_DOWN, I_PLE_NORM, I_W_PLE_GATE, I_W_PLE_PROJ, I_FINAL_NORM };

__device__ __forceinline__ void p0_transpose_item(const float* W, int N, bf16_t* WT, int ldd, int row_off, LAS float* scr, int item, int nblk, int lane, const float* gs) {
    const int kb = item / nblk, nb = item % nblk, k0 = 64 * kb, n0 = 32 * nb;
    const int c = lane & 7;
    f32x4 g0 = {1.f, 1.f, 1.f, 1.f}, g1 = {1.f, 1.f, 1.f, 1.f};
    if (gs) { g0 = *(const f32x4*)(gs + k0 + 8 * c); g1 = *(const f32x4*)(gs + k0 + 8 * c + 4); }
#pragma unroll
    for (int hb = 0; hb < 2; ++hb) {
        float wv[16];
#pragma unroll
        for (int i = 0; i < 16; ++i) { const int kk = 2 * (16 * hb + i) + (lane >> 5); wv[i] = W[(size_t)(k0 + kk) * N + n0 + (lane & 31)]; }
#pragma unroll
        for (int i = 0; i < 16; ++i) { const int kk = 2 * (16 * hb + i) + (lane >> 5); scr[kk * 33 + (lane & 31)] = wv[i]; }
    }
    asm volatile("s_waitcnt lgkmcnt(0)" ::: "memory");
#pragma unroll
    for (int j = 0; j < 4; ++j) { const int n = (lane >> 3) + 8 * j; const LAS float* s = scr + (8 * c) * 33 + n;
        v4u o; o.x = cvt_pk_bf16(s[0 * 33] * g0[0], s[1 * 33] * g0[1]); o.y = cvt_pk_bf16(s[2 * 33] * g0[2], s[3 * 33] * g0[3]); o.z = cvt_pk_bf16(s[4 * 33] * g1[0], s[5 * 33] * g1[1]); o.w = cvt_pk_bf16(s[6 * 33] * g1[2], s[7 * 33] * g1[3]);
        *(v4u*)(WT + (size_t)(row_off + n0 + n) * ldd + k0 + 8 * c) = o; }
    asm volatile("s_waitcnt lgkmcnt(0)" ::: "memory");
}
__device__ __forceinline__ void cvt_job(const float* W, int K, int N, bf16_t* WT, int ldd, int row_off, LAS float* scr, int gw, int NW, int lane, const float* gs = nullptr) {
    const int nblk = N / 32, nit = (K / 64) * nblk;
    for (int it = gw; it < nit; it += NW) p0_transpose_item(W, N, WT, ldd, row_off, scr, it, nblk, lane, gs);
}
__device__ __forceinline__ void phase_convert(ArgsP a, LAS unsigned char* lds, const int tid, const int bx) {
    const int lane = tid & 63, wave = tid >> 6, G = gridDim.x;
    const int gw = bx * 8 + wave, NW = G * 8; const size_t gt = (size_t)bx * 512 + tid, NT = (size_t)G * 512;
    LAS float* scr = (LAS float*)(lds + wave * 8448);
    unsigned char* ws = a->ws;
    for (int l = 0; l < DEPTH; ++l) {
        bf16_t* win = (bf16_t*)(ws + WS_WIN) + (size_t)l * NZ * DM;
        cvt_job(a->in[I_W_IN] + (size_t)l * DM * INW, DM, INW, win, DM, 0, scr, gw, NW, lane, a->in[I_ATTN_NORM] + (size_t)l * DM);
        if (l > 0) cvt_job(a->in[I_W_VRES_DN] + (size_t)(l - 1) * DM * 32, DM, 32, win, DM, INW, scr, gw, NW, lane, a->in[I_ATTN_NORM] + (size_t)l * DM);
        { const int r0 = (l == 0) ? INW : INW + 32; const size_t n16 = (size_t)(NZ - r0) * DM / 8; v4u* z = (v4u*)(win + (size_t)r0 * DM);
          for (size_t i = gt; i < n16; i += NT) z[i] = (v4u){0u, 0u, 0u, 0u}; }
        cvt_job(a->in[I_W_OUT] + (size_t)l * DM * DM, DM, DM, (bf16_t*)(ws + WS_WOUT) + (size_t)l * DM * DM, DM, 0, scr, gw, NW, lane);
        cvt_job(a->in[I_W_FFN_UP] + (size_t)l * DM * DFF, DM, DFF, (bf16_t*)(ws + WS_WUP) + (size_t)l * DFF * DM, DM, 0, scr, gw, NW, lane, a->in[I_MLP_NORM] + (size_t)l * DM);
        cvt_job(a->in[I_W_FFN_DOWN] + (size_t)l * DFF * DM, DFF, DM, (bf16_t*)(ws + WS_WDN) + (size_t)l * DM * DFF, DFF, 0, scr, gw, NW, lane);
        cvt_job(a->in[I_W_PLE_GATE] + (size_t)l * DM * DM, DM, DM, (bf16_t*)(ws + WS_WGATE) + (size_t)l * DM * DM, DM, 0, scr, gw, NW, lane, a->in[I_PLE_NORM] + (size_t)l * DM);
        cvt_job(a->in[I_W_PLE_PROJ] + (size_t)l * DPLE * DM, DPLE, DM, (bf16_t*)(ws + WS_WPROJ) + (size_t)l * DM * DPLE, DPLE, 0, scr, gw, NW, lane);
        for (int gi = 0; gi < 4; ++gi)
            cvt_job(a->in[I_POOL_W] + ((size_t)l * 4 + gi) * 256 * 256, 256, 256, (bf16_t*)(ws + WS_WPOOL) + (size_t)l * 1024 * 256, 256, gi * 256, scr, gw, NW, lane);
        { bf16_t* wl = (bf16_t*)(ws + WS_WLORA) + (size_t)l * 4096 * KL;
          const float* wu = a->in[I_W_UP] + (size_t)l * 64 * RW; const float* au = a->in[I_A_UP] + (size_t)l * 64 * RW; const float* gu = a->in[I_G_UP] + (size_t)l * 160 * RW;
          const float* vu = a->in[I_V_UP] + (size_t)(l > 0 ? l - 1 : 0) * 32 * RW;
          for (size_t idx = gt; idx < (size_t)4096 * KL; idx += NT) { const int n = (int)(idx / KL), k = (int)(idx % KL), t = n >> 10, col = n & 1023; float v = 0.f;
              if (t == 0) { if (k < 64) v = wu[(size_t)k * RW + col]; }
              else if (t == 1) { if (k >= 64 && k < 128) v = au[(size_t)(k - 64) * RW + col]; }
              else if (t == 2) { if (k >= 128 && k < 288) v = gu[(size_t)(k - 128) * RW + col]; }
              else { if (l > 0 && k >= 288 && k < 320) v = vu[(size_t)(k - 288) * RW + col]; }
              wl[idx] = (bf16_t)(cvt_pk_bf16(v, 0.f) & 0xffffu); } }
    }
    { u64* SS = (u64*)(ws + WS_SS); bf16_t* XP = (bf16_t*)(ws + WS_H); const float* x = a->in[I_X];
      for (size_t i = gt; i < (size_t)12 * M; i += NT) SS[M + i] = 0ull;
      for (int row = gw; row < M; row += NW) {
          const f32x4* xr = (const f32x4*)(x + (size_t)row * DM) + lane; float s = 0.f;
#pragma unroll
          for (int j = 0; j < 8; ++j) { const f32x4 v = xr[64 * j]; s += (v[0] * v[0] + v[1] * v[1]) + (v[2] * v[2] + v[3] * v[3]);
              v2u w; w.x = cvt_pk_bf16(v[0], v[1]); w.y = cvt_pk_bf16(v[2], v[3]); ((v2u*)(XP + (size_t)row * DM))[lane + 64 * j] = w; }
          s = wave_sum(s); if (lane == 0) SS[row] = (u64)(s * SS_SCALE); } }
    { const float* p = a->in[I_P]; bf16_t* pb = (bf16_t*)(ws + WS_PB); const size_t n8 = (size_t)DEPTH * M * DPLE / 8;
      for (size_t i = gt; i < n8; i += NT) { const f32x8 v = ld8f(p + i * 8); *(v4u*)(pb + i * 8) = pk8(v); } }
}

template <int WIN> __device__ __forceinline__ v4u pool_diff(const bf16_t* zp, int tpos) {
    const f32x8 u = up8(*(const v4u*)zp);
    v4u raw[WIN - 1];
#pragma unroll
    for (int q = 1; q < WIN; ++q) raw[q - 1] = *(const v4u*)(zp - (size_t)((q <= tpos) ? q : 0) * NZ);
    f32x8 s = u;
#pragma unroll
    for (int q = 1; q < WIN; ++q) { const float msk = (q <= tpos) ? 1.0f : 0.0f; s = s + up8(raw[q - 1]) * msk; }
    const int cnt = (tpos + 1 < WIN) ? tpos + 1 : WIN;
    return pk8(s * (1.0f / (float)cnt) - u);
}
__device__ __forceinline__ void phase_prepa(ArgsP a, int l, const int tid, const int bx) {
    const int G = gridDim.x;
    const bf16_t* Z = (const bf16_t*)(a->ws + WS_Z); bf16_t* DP = (bf16_t*)(a->ws + WS_DPOOL); bf16_t* AL = (bf16_t*)(a->ws + WS_ALORA);
    const float* mus = a->in[I_MU_SHIFT] + (size_t)l * SHIFTW; const float* muv = a->in[I_MU_VRES] + (size_t)(l > 0 ? l - 1 : 0) * 32;
    const int wave = __builtin_amdgcn_readfirstlane(tid >> 6), lane = tid & 63;
    const int gi = wave & 3, prow = (wave >> 2) * 2 + (lane >> 5), pcol = gi * 256 + 8 * (lane & 31);
    const int arow = tid / 48, acol = 8 * (tid % 48);
    for (int unit = bx; unit < M / 4; unit += G) {
        { const int row = unit * 4 + prow, tpos = row & (SEQ - 1);
          const bf16_t* zp = Z + (size_t)row * NZ + pcol; v4u d;
          if (gi == 0) d = pool_diff<2>(zp, tpos); else if (gi == 1) d = pool_diff<4>(zp, tpos); else if (gi == 2) d = pool_diff<8>(zp, tpos); else d = pool_diff<16>(zp, tpos);
          *(v4u*)(DP + (size_t)row * RW + pcol) = d; }
        if (tid < 192) {
            const int row = unit * 4 + arow, tpos = row & (SEQ - 1), c = acol; f32x8 o;
#pragma unroll
            for (int j = 0; j < 8; ++j) o[j] = 0.f;
            if (c < 288 || (c < 320 && l > 0)) {
                const bf16_t* zp = Z + (size_t)row * NZ + 4096 + c;
                const f32x8 zc = up8(*(const v4u*)zp); f32x8 zq;
                if (tpos > 0) zq = up8(*(const v4u*)(zp - NZ)); else {
#pragma unroll
                    for (int j = 0; j < 8; ++j) zq[j] = 0.f; }
                const f32x8 mu = (c < 288) ? ld8f(mus + 3072 + c) : ld8f(muv + (c - 288));
                const f32x8 zs = zc + (zq - zc) * mu;
                if (c < 64) {
#pragma unroll
                    for (int j = 0; j < 8; ++j) o[j] = 1.0f - 2.0f * __builtin_amdgcn_rcpf(1.0f + __expf(2.0f * zs[j])); }
                else if (c >= 128 && c < 288) {
#pragma unroll
                    for (int j = 0; j < 8; ++j) o[j] = sigm(zs[j]); }
                else o = zs;
            }
            *(v4u*)(AL + (size_t)row * KL + c) = pk8(o);
        }
    }
}

constexpr int TC = 32, STEPB = 1344, BUFB = TC * STEPB, YBB = TC * 16 * 4;
struct ScanRaw { v4u zr, zrp, zk, zkp, zv, zvp, ld, aa, vg, vf; };
__device__ __forceinline__ void scan_unit(ArgsP a, int l, int u, LAS unsigned char* lds, const int tid) {
    const int wave = __builtin_amdgcn_readfirstlane(tid >> 6), lane = tid & 63;
    const int bh = u >> 2, rg = u & 3, b = bh >> 4, h = bh & 15;
    const bool hasv = l > 0;
    constexpr int NC = SEQ / TC;
    const size_t rowbase = (size_t)b * SEQ;
    if (wave < 4) {
        const int rowl = 4 * wave + (lane >> 4), j = lane & 15;
        f32x2 s01 = {0.f, 0.f}, s23 = {0.f, 0.f};
        for (int c = 0; c < NC; ++c) {
            __syncthreads();
            const LAS unsigned char* buf = lds + (c & 1) * BUFB + 16 * j;
            const LAS unsigned char* vb = lds + (c & 1) * BUFB + 1280 + 4 * rowl;
            LAS float* yb = (LAS float*)(lds + 2 * BUFB + (c & 1) * YBB) + rowl + (15 - j) * 16;
            f32x4 R[3], W[3], K[3], A[3], B[3]; float V[3];
#define SC_LD(sl, tl) do { R[sl] = *(const LAS f32x4*)(buf + (tl) * STEPB); W[sl] = *(const LAS f32x4*)(buf + (tl) * STEPB + 256); K[sl] = *(const LAS f32x4*)(buf + (tl) * STEPB + 512); \
                A[sl] = *(const LAS f32x4*)(buf + (tl) * STEPB + 768); B[sl] = *(const LAS f32x4*)(buf + (tl) * STEPB + 1024); V[sl] = *(const LAS float*)(vb + (tl) * STEPB); } while (0)
            SC_LD(0, 0); SC_LD(1, 1);
            float yprev = 0.f, ysel = 0.f;
#pragma unroll
            for (int i = 0; i < TC; ++i) {
                const int sl = i % 3;
                if (i + 2 < TC) SC_LD((i + 2) % 3, i + 2);
                const f32x2 vv = {V[sl], V[sl]};
                f32x2 pp = s01 * (f32x2){A[sl][0], A[sl][1]}; pp = s23 * (f32x2){A[sl][2], A[sl][3]} + pp;
                float p = pp[0] + pp[1];
                f32x2 t01 = vv * (f32x2){K[sl][0], K[sl][1]}, t23 = vv * (f32x2){K[sl][2], K[sl][3]};
                t01 = s01 * (f32x2){W[sl][0], W[sl][1]} + t01; t23 = s23 * (f32x2){W[sl][2], W[sl][3]} + t23;
                if (i > 0) {
                    p += dpp1<0x128>(p); yprev += dpp1<0x128>(yprev);
                    p += dpp1<0x124>(p); yprev += dpp1<0x124>(yprev);
                    p += dpp1<0x122>(p); yprev += dpp1<0x122>(yprev);
                    p += dpp1<0x121>(p); yprev += dpp1<0x121>(yprev);
                    ysel = __builtin_bit_cast(float, __builtin_amdgcn_update_dpp(__builtin_bit_cast(int, yprev), __builtin_bit_cast(int, ysel), 0x111, 0xF, 0xF, false));
                    if ((i & 15) == 0) yb[((i >> 4) - 1) * 256] = ysel;
                } else {
                    p += dpp1<0x128>(p); p += dpp1<0x124>(p); p += dpp1<0x122>(p); p += dpp1<0x121>(p);
                }
                const f32x2 pv = {p, p};
                s01 = pv * (f32x2){B[sl][0], B[sl][1]} + t01; s23 = pv * (f32x2){B[sl][2], B[sl][3]} + t23;
                f32x2 yy = s01 * (f32x2){R[sl][0], R[sl][1]}; yy = s23 * (f32x2){R[sl][2], R[sl][3]} + yy;
                yprev = yy[0] + yy[1];
            }
            yprev += dpp1<0x128>(yprev); yprev += dpp1<0x124>(yprev); yprev += dpp1<0x122>(yprev); yprev += dpp1<0x121>(yprev);
            ysel = __builtin_bit_cast(float, __builtin_amdgcn_update_dpp(__builtin_bit_cast(int, yprev), __builtin_bit_cast(int, ysel), 0x111, 0xF, 0xF, false));
            yb[(TC / 16 - 1) * 256] = ysel;
#undef SC_LD
        }
        __syncthreads();
    } else {
        const int ltid = tid - 256, tl = ltid >> 3, cgp = ltid & 7;
        const int col0 = h * HS + 8 * cgp;
        const bf16_t* Z = (const bf16_t*)(a->ws + WS_Z); const bf16_t* PL = (const bf16_t*)(a->ws + WS_PLANES); const bf16_t* VF = (const bf16_t*)(a->ws + WS_VFIRST);
        bf16_t* Y = (bf16_t*)(a->ws + WS_DPOOL);
        const float* mus = a->in[I_MU_SHIFT] + (size_t)l * SHIFTW;
        const f32x8 mur = ld8f(mus + col0), muk = ld8f(mus + 1024 + col0), muv = ld8f(mus + 2048 + col0);
        const f32x8 kkc = ld8f(a->in[I_K_K] + (size_t)l * RW + col0), kac = ld8f(a->in[I_K_A] + (size_t)l * RW + col0);
        const bool vmine = (cgp >> 1) == rg;
#define SCAN_LOAD(R, cc) do { const int t_ = (cc) * TC + tl; const size_t row_ = rowbase + t_; const size_t rowp_ = (t_ > 0) ? row_ - 1 : row_; \
            const bf16_t* z_ = Z + row_ * NZ + col0; const bf16_t* zq_ = Z + rowp_ * NZ + col0; \
            R.zr = *(const v4u*)(z_ + 1024); R.zk = *(const v4u*)(z_ + 2048); R.zv = *(const v4u*)(z_ + 3072); \
            R.zrp = *(const v4u*)(zq_ + 1024); R.zkp = *(const v4u*)(zq_ + 2048); R.zvp = *(const v4u*)(zq_ + 3072); \
            R.ld = *(const v4u*)(PL + row_ * RW + col0); R.aa = *(const v4u*)(PL + PLANE + row_ * RW + col0); \
            if (hasv) { R.vg = *(const v4u*)(PL + 3 * PLANE + row_ * RW + col0); R.vf = *(const v4u*)(VF + row_ * RW + col0); } else { R.vg = R.ld; R.vf = R.ld; } } while (0)
#define SCAN_FLUSH(cc) do { const LAS float* yb_ = (const LAS float*)(lds + 2 * BUFB + ((cc) & 1) * YBB) + tl * 16 + 2 * cgp; \
            const unsigned w_ = cvt_pk_bf16(yb_[0], yb_[1]); *(unsigned*)(Y + (rowbase + (size_t)(cc) * TC + tl) * RW + h * HS + 16 * rg + 2 * cgp) = w_; } while (0)
        ScanRaw nx; SCAN_LOAD(nx, 0);
        for (int c = 0; c < NC; ++c) {
            const ScanRaw cu = nx;
            if (c + 1 < NC) SCAN_LOAD(nx, c + 1);
            const int t = c * TC + tl;
            const f32x8 zr = up8(cu.zr), zk = up8(cu.zk), zv = up8(cu.zv);
            f32x8 zrp = up8(cu.zrp), zkp = up8(cu.zkp), zvp = up8(cu.zvp);
            if (t == 0) {
#pragma unroll
                for (int q = 0; q < 8; ++q) { zrp[q] = 0.f; zkp[q] = 0.f; zvp[q] = 0.f; } }
            const f32x8 r = zr + (zrp - zr) * mur, k = zk + (zkp - zk) * muk; f32x8 v = zv + (zvp - zv) * muv;
            const f32x8 ld = up8(cu.ld), av = up8(cu.aa);
            if (hasv) v = v + (up8(cu.vf) - v) * up8(cu.vg);
            const f32x8 kk = k * kkc;
            float n2 = sum8(kk * kk); n2 += __shfl_xor(n2, 1); n2 += __shfl_xor(n2, 2); n2 += __shfl_xor(n2, 4);
            const float inv = 1.0f / fmaxf(sqrtf(n2), 1e-12f);
            const f32x8 kkn = kk * inv;
            const f32x8 kadj = k * (1.0f + (av - 1.0f) * kac);
            f32x8 dec;
#pragma unroll
            for (int q = 0; q < 8; ++q) dec[q] = __expf(ld[q]);
            const f32x8 avec = -kkn, bvec = kkn * av;
            LAS unsigned char* dst = lds + (c & 1) * BUFB + tl * STEPB + cgp * 32;
#define ST8(off, val) do { *(LAS f32x4*)(dst + (off)) = (f32x4){val[0], val[1], val[2], val[3]}; *(LAS f32x4*)(dst + (off) + 16) = (f32x4){val[4], val[5], val[6], val[7]}; } while (0)
            ST8(0, r); ST8(256, dec); ST8(512, kadj); ST8(768, avec); ST8(1024, bvec);
            if (vmine) { LAS unsigned char* dv = lds + (c & 1) * BUFB + tl * STEPB + 1280 + (cgp & 1) * 32;
                *(LAS f32x4*)(dv) = (f32x4){v[0], v[1], v[2], v[3]}; *(LAS f32x4*)(dv + 16) = (f32x4){v[4], v[5], v[6], v[7]}; }
#undef ST8
            if (c >= 2) SCAN_FLUSH(c - 2);
            __syncthreads();
        }
        __syncthreads();
        SCAN_FLUSH(NC - 2); SCAN_FLUSH(NC - 1);
#undef SCAN_LOAD
#undef SCAN_FLUSH
    }
    __syncthreads();
}

__device__ __forceinline__ void phase_post(ArgsP a, int l, const int tid, const int bx) {
    const int lane = tid & 63, wave = tid >> 6; const int gw = bx * 8 + wave, NW = gridDim.x * 8;
    const bf16_t* Z = (const bf16_t*)(a->ws + WS_Z); const bf16_t* PL = (const bf16_t*)(a->ws + WS_PLANES); bf16_t* VF = (bf16_t*)(a->ws + WS_VFIRST);
    const bf16_t* Y = (const bf16_t*)(a->ws + WS_DPOOL); bf16_t* MIX = (bf16_t*)(a->ws + WS_MIX);
    const float* mus = a->in[I_MU_SHIFT] + (size_t)l * SHIFTW;
    const bool hasv = l > 0;
    for (int it = gw; it < M * 2; it += NW) {
        const int row = it >> 1, h = (it & 1) * 8 + (lane >> 3), col = h * HS + 8 * (lane & 7), tpos = row & (SEQ - 1);
        const bf16_t* z = Z + (size_t)row * NZ + col; const bf16_t* zq = (tpos > 0) ? z - NZ : z;
        const f32x8 zr = up8(*(const v4u*)(z + 1024)), zk = up8(*(const v4u*)(z + 2048)), zv = up8(*(const v4u*)(z + 3072));
        f32x8 zrp = up8(*(const v4u*)(zq + 1024)), zkp = up8(*(const v4u*)(zq + 2048)), zvp = up8(*(const v4u*)(zq + 3072));
        if (tpos == 0) {
#pragma unroll
            for (int q = 0; q < 8; ++q) { zrp[q] = 0.f; zkp[q] = 0.f; zvp[q] = 0.f; } }
        const f32x8 r = zr + (zrp - zr) * ld8f(mus + col), k = zk + (zkp - zk) * ld8f(mus + 1024 + col); f32x8 v = zv + (zvp - zv) * ld8f(mus + 2048 + col);
        const size_t po = (size_t)row * RW + col;
        const f32x8 av = up8(*(const v4u*)(PL + PLANE + po)), gg = up8(*(const v4u*)(PL + 2 * PLANE + po));
        if (hasv) v = v + (up8(*(const v4u*)(VF + po)) - v) * up8(*(const v4u*)(PL + 3 * PLANE + po));
        else *(v4u*)(VF + po) = pk8(v);
        const f32x8 kadj = k * (1.0f + (av - 1.0f) * ld8f(a->in[I_K_A] + (size_t)l * RW + col));
        float bonus = sum8(r * kadj * ld8f(a->in[I_R_K] + (size_t)l * RW + col));
        bonus += __shfl_xor(bonus, 1); bonus += __shfl_xor(bonus, 2); bonus += __shfl_xor(bonus, 4);
        const f32x8 y = up8(*(const v4u*)(Y + po));
        float sm = sum8(y); sm += __shfl_xor(sm, 1); sm += __shfl_xor(sm, 2); sm += __shfl_xor(sm, 4);
        const float mean = sm * (1.0f / 64.0f);
        const f32x8 d = y - mean;
        float vs = sum8(d * d); vs += __shfl_xor(vs, 1); vs += __shfl_xor(vs, 2); vs += __shfl_xor(vs, 4);
        const float rstd = rsqrtf(vs * (1.0f / 64.0f) + GN_EPS);
        const f32x8 o = (d * rstd * ld8f(a->in[I_GN_G] + (size_t)l * RW + col) + ld8f(a->in[I_GN_B] + (size_t)l * RW + col) + bonus * v) * gg;
        *(v4u*)(MIX + (size_t)row * DM + 1024 + col) = pk8(o);
    }
}

#define XB_TMO      128
#define XB_XCNT(j)  (256  + 64 * (j))
#define XB_XSUB(j)  (1280 + 64 * (j))
#define XB_XGEN(j)  (2304 + 64 * (j))
#define XB_TOP      3328
#define XB_TOPGEN   3392
#define XCD_BAR_WORDS 3456
#define XB_SPIN_CAP (1u << 18)

__device__ __forceinline__ unsigned xb_ld(unsigned* p)              { return __hip_atomic_load(p, __ATOMIC_RELAXED, __HIP_MEMORY_SCOPE_AGENT); }
__device__ __forceinline__ unsigned xb_add(unsigned* p, unsigned v) { return __hip_atomic_fetch_add(p, v, __ATOMIC_RELAXED, __HIP_MEMORY_SCOPE_AGENT); }
__device__ __forceinline__ unsigned xb_xcc_id() { return (unsigned)__builtin_amdgcn_s_getreg((3 << 11) | 20) & 0xFu; }
#define XB_SPIN(cond, bar) do { unsigned _sp = 0; while (cond) { __builtin_amdgcn_s_sleep(1); \
    if ((++_sp & 255u) == 0u) { if (xb_ld(&(bar)[XB_TMO])) break; if (_sp > XB_SPIN_CAP) { atomicAdd(&(bar)[XB_TMO], 1u); break; } } } } while (0)

struct XcdBarrier {
    unsigned* bar; unsigned x;
    volatile LAS unsigned* st;
};

__device__ __forceinline__ XcdBarrier xcd_barrier_post(unsigned* bar, volatile LAS unsigned* st) {
    XcdBarrier b; b.bar = bar; b.x = xb_xcc_id(); b.st = st;
    if (threadIdx.x == 0) (void)xb_add(&bar[XB_XCNT(b.x)], 1u);
    return b;
}
__device__ __forceinline__ void xcd_barrier_complete(unsigned* bar, unsigned x, unsigned& nloc, unsigned& nx) {
    const unsigned G = gridDim.x * gridDim.y * gridDim.z;
    unsigned sum, cnt, mine, sp = 0u;
    for (;;) {
        sum = 0u; cnt = 0u; mine = 0u;
#pragma unroll
        for (unsigned j = 0; j < 16; ++j) { const unsigned c = xb_ld(&bar[XB_XCNT(j)]); sum += c; cnt += (c > 0u) ? 1u : 0u; mine = (j == x) ? c : mine; }
        if (sum == G) break;
        __builtin_amdgcn_s_sleep(1);
        if ((++sp & 255u) == 0u) { if (xb_ld(&bar[XB_TMO])) break; if (sp > XB_SPIN_CAP) { atomicAdd(&bar[XB_TMO], 1u); break; } }
    }
    nloc = mine > 0u ? mine : 1u; nx = cnt > 0u ? cnt : 1u;
}

__device__ __forceinline__ void xcd_barrier(const XcdBarrier& b) {
    asm volatile("s_waitcnt vmcnt(0)" ::: "memory");
    __syncthreads();
    if (threadIdx.x == 0) {
        unsigned* bar = b.bar;
        __builtin_amdgcn_s_waitcnt(0);
        unsigned nloc = b.st[0], nx = b.st[1];
        if (nloc == 0u) { xcd_barrier_complete(bar, b.x, nloc, nx); b.st[0] = nloc; b.st[1] = nx; }
        const unsigned old = xb_add(&bar[XB_XSUB(b.x)], 1u);
        const unsigned gen = old / nloc;
        if (old + 1u == (gen + 1u) * nloc) {
            __builtin_amdgcn_fence(__ATOMIC_RELEASE, "agent");
            asm volatile("s_waitcnt vmcnt(0)" ::: "memory");
            const unsigned og = xb_add(&bar[XB_TOP], 1u);
            const unsigned tg = og / nx;
            if (og + 1u == (tg + 1u) * nx) xb_add(&bar[XB_TOPGEN], 1u);
            else XB_SPIN(xb_ld(&bar[XB_TOPGEN]) == tg, bar);
            __builtin_amdgcn_fence(__ATOMIC_ACQUIRE, "agent");
            xb_add(&bar[XB_XGEN(b.x)], 1u);
            asm volatile("s_waitcnt vmcnt(0)" ::: "memory");
        } else {
            XB_SPIN(xb_ld(&bar[XB_XGEN(b.x)]) == gen, bar);
            __builtin_amdgcn_fence(__ATOMIC_ACQUIRE, "agent");
            asm volatile("s_waitcnt vmcnt(0)" ::: "memory");
        }
    }
    __syncthreads();
}


constexpr int N_PHASES = 2 + 9 * DEPTH;
__device__ __forceinline__ bool make_job(ArgsP a, int l, int s, int q, pg8::Job& J) {
    unsigned char* ws = a->ws; u64* SS = (u64*)(ws + WS_SS);
    bf16_t* XC = (bf16_t*)(ws + ((l & 1) ? WS_XQ : WS_H)); bf16_t* XN = (bf16_t*)(ws + ((l & 1) ? WS_H : WS_XQ));
    bf16_t* MIX = (bf16_t*)(ws + WS_MIX); bf16_t* PP = (bf16_t*)(ws + WS_MIX);
    J.a_pn_step = 0; J.nM = M / 256; J.O = nullptr; J.ldc = DM; J.c0 = nullptr; J.c1 = nullptr; J.c2 = nullptr; J.base = nullptr; J.out = nullptr; J.pp = nullptr; J.ss_in = nullptr; J.ss_out = nullptr;
    if (s == 0 && q == 0) { J.A = XC; J.Bt = (const bf16_t*)(ws + WS_WIN) + (size_t)l * NZ * DM; J.lda = DM; J.ldb = DM; J.K = DM; J.nN = NZ / 256; J.mode = 0; J.O = (bf16_t*)(ws + WS_Z); J.ldc = NZ; J.ss_in = SS + (size_t)(3 * l) * M; return true; }
    if (s == 2 && q == 0) { J.A = (const bf16_t*)(ws + WS_ALORA); J.Bt = (const bf16_t*)(ws + WS_WLORA) + (size_t)l * 4096 * KL; J.lda = KL; J.ldb = KL; J.K = KL; J.nN = 16; J.mode = 3; J.O = (bf16_t*)(ws + WS_PLANES); J.ldc = RW;
                            J.c0 = a->in[I_W0] + (size_t)l * RW; J.c1 = a->in[I_A0] + (size_t)l * RW; J.c2 = (l > 0) ? a->in[I_V0] + (size_t)(l - 1) * RW : nullptr; return true; }
    if (s == 2 && q == 1) { J.A = (const bf16_t*)(ws + WS_DPOOL); J.Bt = (const bf16_t*)(ws + WS_WPOOL) + (size_t)l * 1024 * 256; J.lda = RW; J.ldb = 256; J.K = 256; J.a_pn_step = 256; J.nN = 4; J.mode = 2; J.O = MIX; J.ldc = DM;
                            J.c0 = a->in[I_POOL_SCALE] + (size_t)l * 1024; return true; }
    if (s == 5 && q == 0) { J.A = MIX; J.Bt = (const bf16_t*)(ws + WS_WOUT) + (size_t)l * DM * DM; J.lda = DM; J.ldb = DM; J.K = DM; J.nN = DM / 256; J.mode = 4; J.base = XC; J.out = XC; J.ss_out = SS + (size_t)(3 * l + 1) * M; return true; }
    if (s == 6 && q == 0) { J.A = XC; J.Bt = (const bf16_t*)(ws + WS_WUP) + (size_t)l * DFF * DM; J.lda = DM; J.ldb = DM; J.K = DM; J.nN = DFF / 256; J.mode = 1; J.O = (bf16_t*)(ws + WS_U); J.ldc = DFF; J.ss_in = SS + (size_t)(3 * l + 1) * M; return true; }
    if (s == 6 && q == 1) { J.A = (const bf16_t*)(ws + WS_PB) + (size_t)l * M * DPLE; J.Bt = (const bf16_t*)(ws + WS_WPROJ) + (size_t)l * DM * DPLE; J.lda = DPLE; J.ldb = DPLE; J.K = DPLE; J.nN = DM / 256; J.mode = 0; J.O = PP; J.ldc = DM; return true; }
    if (s == 7 && q == 0) { J.A = (const bf16_t*)(ws + WS_U); J.Bt = (const bf16_t*)(ws + WS_WDN) + (size_t)l * DM * DFF; J.lda = DFF; J.ldb = DFF; J.K = DFF; J.nN = DM / 256; J.mode = 4; J.base = XC; J.out = XC; J.ss_out = SS + (size_t)(3 * l + 2) * M; return true; }
    if (s == 8 && q == 0) { J.A = XC; J.Bt = (const bf16_t*)(ws + WS_WGATE) + (size_t)l * DM * DM; J.lda = DM; J.ldb = DM; J.K = DM; J.nN = DM / 256; J.mode = 5; J.base = XC; J.out = XN; J.pp = PP; J.ss_in = SS + (size_t)(3 * l + 2) * M;
                            J.ss_out = SS + (size_t)(3 * l + 3) * M; return true; }
    return false;
}
__device__ __forceinline__ void phase_final(ArgsP a, const int tid, const int bx) {
    const int lane = tid & 63, wave = tid >> 6; const int gw = bx * 8 + wave, NW = gridDim.x * 8;
    const bf16_t* X = (const bf16_t*)(a->ws + ((DEPTH & 1) ? WS_XQ : WS_H)); const u64* SS = (const u64*)(a->ws + WS_SS) + (size_t)(3 * DEPTH) * M; const float* g = a->in[I_FINAL_NORM]; float* out = a->out;
    f32x8 gv[4];
#pragma unroll
    for (int j = 0; j < 4; ++j) gv[j] = ld8f(g + 8 * lane + 512 * j);
    for (int row = gw; row < M; row += NW) {
        const float rs = rsqrtf((float)SS[row] * SS_INV + NORM_EPS);
#pragma unroll
        for (int j = 0; j < 4; ++j) { const f32x8 o = up8(*(const v4u*)(X + (size_t)row * DM + 8 * lane + 512 * j)) * rs * gv[j]; float* op = out + (size_t)row * DM + 8 * lane + 512 * j;
            *(f32x4*)op = (f32x4){o[0], o[1], o[2], o[3]}; *(f32x4*)(op + 4) = (f32x4){o[4], o[5], o[6], o[7]}; }
    }
}
constexpr int dup_count() { int c = 0; for (int s = 0; s < 9; ++s) c += (PROBE_DUP >> s) & 1; return c; }
constexpr int SUBS = 9 + dup_count(), PRE = 1 + ((PROBE_DUP >> 9) & 1);
constexpr int N_PHASES_RUN = PRE + SUBS * DEPTH + 1;
__global__ void __launch_bounds__(512, 2) fwd_megakernel(Args a_byval) {
    ArgsP a = (ArgsP)__builtin_amdgcn_kernarg_segment_ptr();
    extern __shared__ __attribute__((aligned(16))) unsigned char lds_raw[];
    LAS unsigned char* lds = (LAS unsigned char*)lds_raw;
    cg::grid_group grid = cg::this_grid();
    const int G = gridDim.x;
    if (threadIdx.x < 16) ((LAS unsigned*)(lds + BAR_LDS_OFF))[threadIdx.x] = 0u;
    __syncthreads();
    XcdBarrier xbar = xcd_barrier_post((unsigned*)a->ws, (volatile LAS unsigned*)(lds + BAR_LDS_OFF));
    const int ph_lo = a->ph_lo, ph_hi = a->ph_hi;
    const int wave_s = __builtin_amdgcn_readfirstlane((int)threadIdx.x >> 6);
    if (ph_lo < 0) grid.sync();
    for (int ph = ph_lo; ph < ph_hi; ++ph) {
        if (ph > ph_lo) xcd_barrier(xbar);
        asm volatile("" : "+s"(a) :: "memory");
        int tid = (wave_s << 6) + (int)__builtin_amdgcn_mbcnt_hi(~0u, __builtin_amdgcn_mbcnt_lo(~0u, 0u)), bx = blockIdx.x; asm volatile("" : "+v"(tid), "+s"(bx));
        int l = 0, s;
        if (ph < PRE) s = 13;
        else if (ph == N_PHASES_RUN - 1) s = 12;
        else { l = (ph - PRE) / SUBS; const int qq = (ph - PRE) % SUBS; int c = 0; s = 0;
               for (; s < 9; ++s) { const int n = 1 + ((PROBE_DUP >> s) & 1); if (qq < c + n) break; c += n; } }
        if (s == 13) { phase_convert(a, lds, tid, bx); }
        else if (s == 12) { phase_final(a, tid, bx); }
        else if (s == 1) { phase_prepa(a, l, tid, bx); }
        else if (s == 3) { const int vcu = (G % 8 == 0) ? (bx % 8) * (G / 8) + bx / 8 : bx; for (int u = vcu; u < 256; u += G) scan_unit(a, l, u, lds, tid); }
        else if (s == 4) { phase_post(a, l, tid, bx); }
        else {
            for (int q = 0; q < 2; ++q) { pg8::Job J; if (!make_job(a, l, s, q, J)) break;
                pg8::StaticOrder S; S.init(J.nM, J.nN, G, bx); pg8::gemm_phase(lds, J, S, tid); }
        }
    }
}

extern "C" void kernel_launch(void* const* d_in, const int* in_sizes, int n_in, void* d_out, int out_size, void* d_ws, size_t ws_size, hipStream_t stream) {
    static int grid = 0;
    if (grid == 0) {
        if (n_in != 29 || in_sizes[0] != M * DM || out_size != M * DM || ws_size < WS_END) {
            fprintf(stderr, "kernel_launch: unexpected shapes: n_in %d in0 %d out %d ws %zu (need %zu); nothing launched\n", n_in, n_in > 0 ? in_sizes[0] : -1, out_size, ws_size, (size_t)WS_END); grid = -1; return; }
        int dev = 0, cus = 0, per_cu = 0;
        if (hipGetDevice(&dev) != hipSuccess || hipDeviceGetAttribute(&cus, hipDeviceAttributeMultiprocessorCount, dev) != hipSuccess) { fprintf(stderr, "kernel_launch: device query failed\n"); grid = -1; return; }
        if (hipFuncSetAttribute((const void*)fwd_megakernel, hipFuncAttributeMaxDynamicSharedMemorySize, LDS_BYTES) != hipSuccess) { fprintf(stderr, "kernel_launch: hipFuncSetAttribute failed\n"); grid = -1; return; }
        if (hipOccupancyMaxActiveBlocksPerMultiprocessor(&per_cu, (const void*)fwd_megakernel, 512, LDS_BYTES) != hipSuccess || per_cu < 1) {
            fprintf(stderr, "kernel_launch: occupancy query says %d blocks/CU; using 1\n", per_cu); per_cu = 1; }
        (void)hipGetLastError();
        grid = cus * 1;
        if (grid > 256) grid = 256;
    }
    if (grid < 0) return;
    Args a{};
    for (int i = 0; i < 29; ++i) a.in[i] = (const float*)d_in[i];
    a.out = (float*)d_out; a.ws = (unsigned char*)d_ws;
    if (hipMemsetAsync(d_ws, 0, 65536, stream) != hipSuccess) { fprintf(stderr, "kernel_launch: memset of barrier words failed\n"); return; }
#if MK_PER_PHASE_LAUNCH
    for (int ph = 0; ph < N_PHASES_RUN; ++ph) {
        a.ph_lo = ph; a.ph_hi = ph + 1;
        hipLaunchKernelGGL(fwd_megakernel, dim3(grid), dim3(512), LDS_BYTES, stream, a);
    }
#else
    a.ph_lo = 0; a.ph_hi = N_PHASES_RUN;
    void* args[] = {&a};
    hipError_t e = hipLaunchCooperativeKernel((const void*)fwd_megakernel, dim3(grid), dim3(512), args, LDS_BYTES, stream);
    if (e != hipSuccess) fprintf(stderr, "cooperative launch failed: %s (grid %d)\n", hipGetErrorString(e), grid);
#endif
}
```

```cpp
#include <hip/hip_runtime.h>
#include <hip/hip_cooperative_groups.h>
#include <cstdio>
#include <cstdint>
namespace cg = cooperative_groups;

#ifndef MK_PER_PHASE_LAUNCH
#define MK_PER_PHASE_LAUNCH 0
#endif

#ifndef PROBE_DUP
#define PROBE_DUP 0
#endif
#define LAS __attribute__((address_space(3)))
typedef unsigned short bf16_t;
typedef short bf16x8 __attribute__((ext_vector_type(8)));
typedef float f32x4 __attribute__((ext_vector_type(4)));
typedef float f32x8 __attribute__((ext_vector_type(8)));
typedef float f32x2 __attribute__((ext_vector_type(2)));
typedef unsigned v4u __attribute__((ext_vector_type(4)));
typedef unsigned v2u __attribute__((ext_vector_type(2)));

constexpr int BATCH = 4, SEQ = 4096, DM = 2048, DEPTH = 4, M = BATCH * SEQ;
constexpr int RW = 1024, HS = 64, NH = 16, DFF = 8192, DPLE = 256;
constexpr int INW = 4384, NZ = 4608, SHIFTW = 3360, KL = 384;
constexpr float NORM_EPS = 1e-6f, GN_EPS = 64e-5f;

constexpr size_t MiB = 1u << 20;
constexpr size_t WS_WIN = 1 * MiB, WS_WOUT = 73 * MiB, WS_WUP = 105 * MiB, WS_WDN = 233 * MiB, WS_WGATE = 361 * MiB, WS_WPROJ = 393 * MiB,
                 WS_WLORA = 397 * MiB, WS_WPOOL = 409 * MiB, WS_PB = 411 * MiB, WS_H = 443 * MiB, WS_MIX = 507 * MiB  ,
                 WS_DPOOL = 571 * MiB  , WS_ALORA = 603 * MiB, WS_VFIRST = 615 * MiB, WS_Z = 647 * MiB, WS_PLANES = 791 * MiB,
                 WS_U = 647 * MiB  , WS_XQ = 919 * MiB, WS_SS = 983 * MiB  , WS_END = 985 * MiB;
typedef unsigned long long u64;
constexpr float SS_SCALE = 1048576.0f, SS_INV = 1.0f / (1048576.0f * 2048.0f);
constexpr size_t PLANE = (size_t)M * RW;

constexpr int LDS_BYTES = 135168, BAR_LDS_OFF = 131072 + 256;

__device__ __forceinline__ unsigned cvt_pk_bf16(float lo, float hi) { unsigned r; asm volatile("v_cvt_pk_bf16_f32 %0, %1, %2" : "=v"(r) : "v"(lo), "v"(hi)); return r; }
__device__ __forceinline__ float bf2f(unsigned h) { return __uint_as_float(h << 16); }
__device__ __forceinline__ f32x8 up8(v4u p) {
    f32x8 r;
    r[0] = __uint_as_float(p.x << 16); r[1] = __uint_as_float(p.x & 0xffff0000u);
    r[2] = __uint_as_float(p.y << 16); r[3] = __uint_as_float(p.y & 0xffff0000u);
    r[4] = __uint_as_float(p.z << 16); r[5] = __uint_as_float(p.z & 0xffff0000u);
    r[6] = __uint_as_float(p.w << 16); r[7] = __uint_as_float(p.w & 0xffff0000u);
    return r;
}
__device__ __forceinline__ v4u pk8(f32x8 v) { v4u o; o.x = cvt_pk_bf16(v[0], v[1]); o.y = cvt_pk_bf16(v[2], v[3]); o.z = cvt_pk_bf16(v[4], v[5]); o.w = cvt_pk_bf16(v[6], v[7]); return o; }
__device__ __forceinline__ f32x8 ld8f(const float* p) { const f32x4 a = *(const f32x4*)p, b = *(const f32x4*)(p + 4); f32x8 r; r[0] = a[0]; r[1] = a[1]; r[2] = a[2]; r[3] = a[3]; r[4] = b[0]; r[5] = b[1]; r[6] = b[2]; r[7] = b[3]; return r; }
__device__ __forceinline__ float sigm(float x) { return __builtin_amdgcn_rcpf(1.0f + __expf(-x)); }
__device__ __forceinline__ float wave_sum(float v) {
#pragma unroll
    for (int o = 1; o < 64; o <<= 1) v += __shfl_xor(v, o);
    return v;
}
__device__ __forceinline__ float sum8(f32x8 v) { return ((v[0] + v[1]) + (v[2] + v[3])) + ((v[4] + v[5]) + (v[6] + v[7])); }
template <int CTRL> __device__ __forceinline__ float dpp1(float x) { const int xi = __builtin_bit_cast(int, x); return __builtin_bit_cast(float, __builtin_amdgcn_update_dpp(0, xi, CTRL, 0xF, 0xF, true)); }
template <int CTRL> __device__ __forceinline__ float dpp_mov(float x) { const int xi = __builtin_bit_cast(int, x); return __builtin_bit_cast(float, __builtin_amdgcn_update_dpp(xi, xi, CTRL, 0xF, 0xF, false)); }
__device__ __forceinline__ float allreduce16(float x) {
    x += dpp_mov<0x128>(x); x += dpp_mov<0x124>(x); x += dpp_mov<0x122>(x); x += dpp_mov<0x121>(x); return x;
}

namespace pg8 {
constexpr int BM = 256, BK = 64, HALF = 128, HTB = HALF * BK * 2, STAGE_BYTES = 8 * HTB, NXCD = 8, WGM = 8;
__host__ __device__ __forceinline__ int lds_byte(int r, int c) { const int st = (r >> 4) * 2 + (c >> 5), rr = r & 15, cc = c & 31, ob = rr * 64 + cc * 2; return st * 1024 + (ob ^ (((ob >> 9) & 1) << 5)); }
__host__ __device__ __forceinline__ void stage_rc(int b, int& R, int& C) { const int st = b / 1024, sb = b % 1024, swz = sb ^ (((sb >> 9) & 1) << 5); R = (st >> 1) * 16 + swz / 64; C = (st & 1) * 32 + (swz % 64) / 2; }
__host__ __device__ __forceinline__ int perm32(int rho) { const int n = rho >> 4, i = rho & 15; return 8 * (i >> 2) + 4 * n + (i & 3); }

struct Unit { int pm, pn; };

struct StaticOrder {
    int nM, nN, nwg, G, c;
    __device__ void init(int nM_, int nN_, int G_, int c_) { nM = nM_; nN = nN_; nwg = nM * nN; G = G_; c = c_; }
    __device__ bool next(int i, Unit& u) const {
        const long L = (long)i * G + c; if (L >= nwg) return false;
        int wgid = (int)L; { const int q = nwg / NXCD, r = nwg % NXCD, xcd = wgid % NXCD, off = wgid / NXCD; wgid = (xcd < r ? xcd * (q + 1) : r * (q + 1) + (xcd - r) * q) + off; }
        const int nig = WGM * nN, gid = wgid / nig, fm = gid * WGM, gsz = (nM - fm) < WGM ? (nM - fm) : WGM;
        u.pm = __builtin_amdgcn_readfirstlane(fm + ((wgid % nig) % gsz)); u.pn = __builtin_amdgcn_readfirstlane((wgid % nig) / gsz); return true;
    }
};

template <int MODE> struct EpiB {
    static constexpr bool PERM = true;
    bf16_t* O; int ldc; const float* c0; const float* c1; const float* c2; size_t plane; const u64* ss;
    __device__ __forceinline__ void operator()(const f32x4 (&acc)[2][2][4][2], const Unit& u, int wr, int wc, int fr, int fq, const u64 (&ssr)[2][4]) const {
        const int row0 = u.pm * BM + wr * 64 + fr; int colt = u.pn * BM; bf16_t* base = O; int t = 0;
        if (MODE == 3) { t = colt >> 10; base += (size_t)t * plane; colt &= 1023; }
        const int col0 = colt + wc * 32 + 8 * fq;
        f32x4 cv[2][2];
#pragma unroll
        for (int bj = 0; bj < 2; ++bj)
#pragma unroll
            for (int n = 0; n < 2; ++n) {
                cv[bj][n] = (f32x4){0.f, 0.f, 0.f, 0.f};
                if (MODE == 2) cv[bj][n] = *(const f32x4*)(c0 + col0 + bj * HALF + 4 * n);
                if (MODE == 3) { const float* b = (t == 0) ? c0 : (t == 1) ? c1 : (t == 3) ? c2 : nullptr; if (b) cv[bj][n] = *(const f32x4*)(b + col0 + bj * HALF + 4 * n); }
            }
        float rsv[2][4];
#pragma unroll
        for (int ai = 0; ai < 2; ++ai)
#pragma unroll
            for (int m = 0; m < 4; ++m) { rsv[ai][m] = 1.0f; if (MODE < 2) { if (ss) rsv[ai][m] = rsqrtf((float)ssr[ai][m] * SS_INV + NORM_EPS); } }
#pragma unroll
        for (int ai = 0; ai < 2; ++ai)
#pragma unroll
            for (int m = 0; m < 4; ++m) { bf16_t* rowp = base + (size_t)(row0 + ai * HALF + m * 16) * ldc + col0;
                const float rs = rsv[ai][m];
#pragma unroll
                for (int bj = 0; bj < 2; ++bj) { f32x4 v0 = acc[ai][bj][m][0], v1 = acc[ai][bj][m][1];
                    if (MODE < 2) { v0 = v0 * rs; v1 = v1 * rs; }
                    if (MODE == 1) {
#pragma unroll
                        for (int j = 0; j < 4; ++j) { const float a = fmaxf(v0[j], 0.f), b = fmaxf(v1[j], 0.f); v0[j] = a * a; v1[j] = b * b; } }
                    if (MODE == 2) { v0 = v0 * cv[bj][0]; v1 = v1 * cv[bj][1]; }
                    if (MODE == 3) { v0 = v0 + cv[bj][0]; v1 = v1 + cv[bj][1];
                        if (t == 0) {
#pragma unroll
                            for (int j = 0; j < 4; ++j) { v0[j] = -0.6065306597f * sigm(v0[j]); v1[j] = -0.6065306597f * sigm(v1[j]); } }
                        else if (t != 2) {
#pragma unroll
                            for (int j = 0; j < 4; ++j) { v0[j] = sigm(v0[j]); v1[j] = sigm(v1[j]); } }
                    }
                    v4u w; w.x = cvt_pk_bf16(v0[0], v0[1]); w.y = cvt_pk_bf16(v0[2], v0[3]); w.z = cvt_pk_bf16(v1[0], v1[1]); w.w = cvt_pk_bf16(v1[2], v1[3]);
                    *(v4u*)(rowp + bj * HALF) = w; } }
    }
};
template <bool GATE> struct EpiX {
    static constexpr int RB = GATE ? 2 : 4;
    const bf16_t* base; bf16_t* out; const bf16_t* pp; int ldc; const u64* ss_in; u64* ss_out;
    __device__ __forceinline__ void operator()(const f32x4 (&acc)[2][2][4][2], const Unit& u, int wr, int wc, int fr, int fq, const u64 (&ssr)[2][4]) const {
        const int row0 = u.pm * BM + wr * 64 + fr, col0 = u.pn * BM + wc * 32 + 8 * fq;
        float rsv[2][4];
#pragma unroll
        for (int ai = 0; ai < 2; ++ai)
#pragma unroll
            for (int m = 0; m < 4; ++m) { rsv[ai][m] = 1.0f; if (GATE) rsv[ai][m] = rsqrtf((float)ssr[ai][m] * SS_INV + NORM_EPS); }
#pragma unroll
        for (int aim = 0; aim < 8 / RB; ++aim) { const int ai = (aim * RB) >> 2, m0 = (aim * RB) & 3;
            v4u bs[RB][2], q[RB][2];
#pragma unroll
            for (int mm = 0; mm < RB; ++mm) { const size_t off = (size_t)(row0 + ai * HALF + (m0 + mm) * 16) * ldc + col0;
#pragma unroll
                for (int bj = 0; bj < 2; ++bj) { bs[mm][bj] = *(const v4u*)(base + off + bj * HALF); if (GATE) q[mm][bj] = *(const v4u*)(pp + off + bj * HALF); } }
#pragma unroll
            for (int mm = 0; mm < RB; ++mm) { const int m = m0 + mm, row = row0 + ai * HALF + m * 16; const size_t off = (size_t)row * ldc + col0; const float rs = rsv[ai][m];
                float sq = 0.f;
#pragma unroll
                for (int bj = 0; bj < 2; ++bj) { const f32x8 b = up8(bs[mm][bj]); f32x4 a0 = acc[ai][bj][m][0], a1 = acc[ai][bj][m][1];
                    if (GATE) { const f32x8 qf = up8(q[mm][bj]); a0 = a0 * rs; a1 = a1 * rs;
#pragma unroll
                        for (int j = 0; j < 4; ++j) { a0[j] = sigm(a0[j]) * qf[j]; a1[j] = sigm(a1[j]) * qf[4 + j]; } }
                    f32x8 x;
#pragma unroll
                    for (int j = 0; j < 4; ++j) { x[j] = b[j] + a0[j]; x[4 + j] = b[4 + j] + a1[j]; }
                    const v4u w = pk8(x);
                    *(v4u*)(out + off + bj * HALF) = w;
                    const f32x8 xr = up8(w); sq += sum8(xr * xr); }
                sq += __shfl_xor(sq, 16); sq += __shfl_xor(sq, 32);
                if (fq == 0) __hip_atomic_fetch_add(ss_out + row, (u64)(sq * SS_SCALE), __ATOMIC_RELAXED, __HIP_MEMORY_SCOPE_AGENT); }
            asm volatile("" ::: "memory"); }
    }
};

struct Job { const bf16_t* A; const bf16_t* Bt; int lda, ldb, K, a_pn_step, nM, nN, mode;
             bf16_t* O; int ldc; const float* c0; const float* c1; const float* c2; const bf16_t* base; bf16_t* out; const bf16_t* pp;
             const u64* ss_in; u64* ss_out; };
__device__ __forceinline__ void run_epi(const Job& J, const f32x4 (&acc)[2][2][4][2], const Unit& u, int wr, int wc, int fr, int fq, const u64 (&ssr)[2][4]) {
    switch (J.mode) {
    case 0: { EpiB<0> E{J.O, J.ldc, nullptr, nullptr, nullptr, 0, J.ss_in}; E(acc, u, wr, wc, fr, fq, ssr); } break;
    case 1: { EpiB<1> E{J.O, J.ldc, nullptr, nullptr, nullptr, 0, J.ss_in}; E(acc, u, wr, wc, fr, fq, ssr); } break;
    case 2: { EpiB<2> E{J.O, J.ldc, J.c0, nullptr, nullptr, 0, nullptr}; E(acc, u, wr, wc, fr, fq, ssr); } break;
    case 3: { EpiB<3> E{J.O, J.ldc, J.c0, J.c1, J.c2, PLANE, nullptr}; E(acc, u, wr, wc, fr, fq, ssr); } break;
    case 4: { EpiX<false> E{J.base, J.out, nullptr, J.ldc, nullptr, J.ss_out}; E(acc, u, wr, wc, fr, fq, ssr); } break;
    default: { EpiX<true> E{J.base, J.out, J.pp, J.ldc, J.ss_in, J.ss_out}; E(acc, u, wr, wc, fr, fq, ssr); } break;
    }
}
__device__ __forceinline__ void gemm_phase(LAS unsigned char* lds, const Job& J, const StaticOrder& S, const int tid) {
    const int wid = __builtin_amdgcn_readfirstlane(tid >> 6), lane = tid & 63, wr = wid >> 2, wc = wid & 3, fr = lane & 15, fq = lane >> 4;
    const int K = J.K, nt = K / BK;
    unsigned voffA[2], voffB[2];
#pragma unroll
    for (int i = 0; i < 2; ++i) { int R, C; stage_rc(tid * 16 + i * 8192, R, C); const int Rb = (R & ~31) + perm32(R & 31);
        voffA[i] = (unsigned)(R * J.lda + C) * 2u; voffB[i] = (unsigned)(Rb * J.ldb + C) * 2u; }
    const unsigned kstep = (unsigned)(BK * 2);
    const unsigned hstepA = (unsigned)HALF * J.lda * 2, hstepB = (unsigned)HALF * J.ldb * 2;
    const unsigned tstepA = 2 * hstepA, tstepB = 2 * hstepB;
    const __amdgpu_buffer_rsrc_t rsA = __builtin_amdgcn_make_buffer_rsrc((void*)J.A, 0, 0x7fffffff, 0x00020000);
    const __amdgpu_buffer_rsrc_t rsB = __builtin_amdgcn_make_buffer_rsrc((void*)J.Bt, 0, 0x7fffffff, 0x00020000);
    const unsigned ldsw = (unsigned)wid * 1024u;
    const int aoff = lds_byte(wr * 64 + fr, fq * 8), boff = lds_byte(wc * 32 + fr, fq * 8);
#define PG8_SA(b, h) (((b) * 2 + (h)) * HTB)
#define PG8_SB(b, h) ((4 + (b) * 2 + (h)) * HTB)
#define PG8_STAGE(bufoff, goff, voff) do { _Pragma("unroll") for (int _i = 0; _i < 2; ++_i) \
        __builtin_amdgcn_raw_ptr_buffer_load_lds(PG8_RS_##voff, (LAS unsigned*)(lds + (bufoff) + ldsw + _i * 8192), 16, (voff)[_i], (goff), 0, 0); } while (0)
#define PG8_RS_voffA rsA
#define PG8_RS_voffB rsB
#define PG8_LDA(dst, b, h) do { _Pragma("unroll") for (int m = 0; m < 4; ++m) _Pragma("unroll") for (int k = 0; k < 2; ++k) dst[m][k] = *(const LAS bf16x8*)(lds + PG8_SA(b, h) + aoff + m * 2048 + k * 1024); } while (0)
#define PG8_LDB(dst, b, h) do { _Pragma("unroll") for (int n = 0; n < 2; ++n) _Pragma("unroll") for (int k = 0; k < 2; ++k) dst[n][k] = *(const LAS bf16x8*)(lds + PG8_SB(b, h) + boff + n * 2048 + k * 1024); } while (0)
#define PG8_MMA(ai, bj, At, Bt) do { __builtin_amdgcn_s_setprio(1); _Pragma("unroll") for (int m = 0; m < 4; ++m) _Pragma("unroll") for (int n = 0; n < 2; ++n) _Pragma("unroll") for (int k = 0; k < 2; ++k) \
        acc[ai][bj][m][n] = __builtin_amdgcn_mfma_f32_16x16x32_bf16(Bt[n][k], At[m][k], acc[ai][bj][m][n], 0, 0, 0); __builtin_amdgcn_s_setprio(0); } while (0)
#define PG8_WAIT_V(n) asm volatile("s_waitcnt vmcnt(" #n ")" ::: "memory")
#define PG8_WAIT_L(n) asm volatile("s_waitcnt lgkmcnt(" #n ")" ::: "memory")
#define PG8_BAR __builtin_amdgcn_s_barrier()
#define PG8_SCHED __builtin_amdgcn_sched_barrier(0)
    Unit cur, nxt; int ui = 0;
    if (!S.next(0, cur)) return;
    f32x4 acc[2][2][4][2];
#pragma unroll
    for (int a = 0; a < 2; ++a)
#pragma unroll
        for (int b = 0; b < 2; ++b)
#pragma unroll
            for (int m = 0; m < 4; ++m)
#pragma unroll
                for (int n = 0; n < 2; ++n) acc[a][b][m][n] = (f32x4){0.f, 0.f, 0.f, 0.f};
    bf16x8 At[4][2], B0[2][2], B1[2][2];
    u64 ssr[2][4];
#define PG8_SSLD(U) do { if (J.ss_in) { const u64* sp_ = J.ss_in + (U).pm * BM + wr * 64 + fr; _Pragma("unroll") for (int ai_ = 0; ai_ < 2; ++ai_) _Pragma("unroll") for (int m_ = 0; m_ < 4; ++m_) ssr[ai_][m_] = sp_[ai_ * HALF + m_ * 16]; } \
        else { _Pragma("unroll") for (int ai_ = 0; ai_ < 2; ++ai_) _Pragma("unroll") for (int m_ = 0; m_ < 4; ++m_) ssr[ai_][m_] = 0ull; } } while (0)
    PG8_SSLD(cur);
    unsigned cA = (unsigned)cur.pm * tstepA + (unsigned)cur.pn * J.a_pn_step * 2; unsigned cB = (unsigned)cur.pn * tstepB;
    PG8_STAGE(PG8_SB(0, 0), cB, voffB); PG8_STAGE(PG8_SB(0, 1), cB + hstepB, voffB); PG8_STAGE(PG8_SA(0, 0), cA, voffA); PG8_STAGE(PG8_SA(0, 1), cA + hstepA, voffA);
    if (wr == 1) PG8_BAR;
    PG8_WAIT_V(2); PG8_BAR;
    PG8_STAGE(PG8_SB(1, 0), cB + kstep, voffB); PG8_STAGE(PG8_SA(1, 0), cA + kstep, voffA); PG8_STAGE(PG8_SB(1, 1), cB + hstepB + kstep, voffB);
    PG8_WAIT_V(6); PG8_BAR;
    for (;;) {
        const bool has_next = S.next(ui + 1, nxt);
        const unsigned nA = has_next ? (unsigned)nxt.pm * tstepA + (unsigned)nxt.pn * J.a_pn_step * 2 : cA; const unsigned nB = has_next ? (unsigned)nxt.pn * tstepB : cB;
        for (int t = 0; t < nt; t += 2) {
            const bool last = (t == nt - 2);
            const unsigned a1 = cA + (unsigned)(t + 1) * kstep;
            const unsigned a2 = last ? nA : cA + (unsigned)(t + 2) * kstep; const unsigned b2 = last ? nB : cB + (unsigned)(t + 2) * kstep;
            const unsigned a3 = a2 + kstep; const unsigned b3 = b2 + kstep;
            PG8_LDB(B0, 0, 0); PG8_LDB(B1, 0, 1); PG8_SCHED; PG8_LDA(At, 0, 0); PG8_STAGE(PG8_SA(1, 1), a1 + hstepA, voffA);
            PG8_WAIT_V(8); PG8_WAIT_L(0); PG8_BAR; PG8_MMA(0, 0, At, B0); PG8_MMA(0, 1, At, B1); PG8_BAR; PG8_SCHED;
            PG8_LDA(At, 0, 1); PG8_STAGE(PG8_SB(0, 0), b2, voffB); PG8_STAGE(PG8_SB(0, 1), b2 + hstepB, voffB); PG8_STAGE(PG8_SA(0, 0), a2, voffA);
            PG8_WAIT_V(8); PG8_WAIT_L(0); PG8_BAR; PG8_MMA(1, 0, At, B0); PG8_MMA(1, 1, At, B1); PG8_BAR; PG8_SCHED;
            PG8_LDB(B0, 1, 0); PG8_LDB(B1, 1, 1); PG8_SCHED; PG8_LDA(At, 1, 0); PG8_STAGE(PG8_SA(0, 1), a2 + hstepA, voffA);
            PG8_WAIT_V(8); PG8_WAIT_L(0); PG8_BAR; PG8_MMA(0, 0, At, B0); PG8_MMA(0, 1, At, B1); PG8_BAR; PG8_SCHED;
            PG8_LDA(At, 1, 1); PG8_STAGE(PG8_SB(1, 0), b3, voffB); PG8_STAGE(PG8_SB(1, 1), b3 + hstepB, voffB); PG8_STAGE(PG8_SA(1, 0), a3, voffA);
            PG8_WAIT_V(8); PG8_WAIT_L(0); PG8_BAR; PG8_MMA(1, 0, At, B0); PG8_MMA(1, 1, At, B1); PG8_BAR; PG8_SCHED;
        }
        if (wr == 0) PG8_BAR;
        run_epi(J, acc, cur, wr, wc, fr, fq, ssr);
        if (!has_next) break;
        PG8_SSLD(nxt);
#pragma unroll
        for (int a = 0; a < 2; ++a)
#pragma unroll
            for (int b = 0; b < 2; ++b)
#pragma unroll
                for (int m = 0; m < 4; ++m)
#pragma unroll
                    for (int n = 0; n < 2; ++n) acc[a][b][m][n] = (f32x4){0.f, 0.f, 0.f, 0.f};
        cur = nxt; cA = nA; cB = nB; ++ui;
        if (wr == 1) PG8_BAR;
    }
    PG8_WAIT_V(0);
    PG8_BAR;
#undef PG8_SA
#undef PG8_SB
#undef PG8_STAGE
#undef PG8_SSLD
#undef PG8_RS_voffA
#undef PG8_RS_voffB
#undef PG8_LDA
#undef PG8_LDB
#undef PG8_MMA
#undef PG8_WAIT_V
#undef PG8_WAIT_L
#undef PG8_BAR
#undef PG8_SCHED
}
}

struct Args { const float* in[29]; float* out; unsigned char* ws; int ph_lo, ph_hi; };
typedef const __attribute__((address_space(4))) Args* ArgsP;
enum { I_X = 0, I_P, I_ATTN_NORM, I_W_IN, I_MU_SHIFT, I_W_VRES_DN, I_MU_VRES, I_V0, I_V_UP, I_POOL_W, I_POOL_SCALE, I_W0, I_W_UP, I_A0, I_A_UP, I_G_UP,
       I_K_K, I_K_A, I_R_K, I_GN_G, I_GN_B, I_W_OUT, I_MLP_NORM, I_W_FFN_UP, I_W_FFN_DOWN, I_PLE_NORM, I_W_PLE_GATE, I_W_PLE_PROJ, I_FINAL_NORM };

__device__ __forceinline__ void p0_transpose_item(const float* W, int N, bf16_t* WT, int ldd, int row_off, LAS float* scr, int item, int nblk, int lane, const float* gs) {
    const int kb = item / nblk, nb = item % nblk, k0 = 64 * kb, n0 = 32 * nb;
    const int c = lane & 7;
    f32x4 g0 = {1.f, 1.f, 1.f, 1.f}, g1 = {1.f, 1.f, 1.f, 1.f};
    if (gs) { g0 = *(const f32x4*)(gs + k0 + 8 * c); g1 = *(const f32x4*)(gs + k0 + 8 * c + 4); }
#pragma unroll
    for (int hb = 0; hb < 2; ++hb) {
        float wv[16];
#pragma unroll
        for (int i = 0; i < 16; ++i) { const int kk = 2 * (16 * hb + i) + (lane >> 5); wv[i] = W[(size_t)(k0 + kk) * N + n0 + (lane & 31)]; }
#pragma unroll
        for (int i = 0; i < 16; ++i) { const int kk = 2 * (16 * hb + i) + (lane >> 5); scr[kk * 33 + (lane & 31)] = wv[i]; }
    }
    asm volatile("s_waitcnt lgkmcnt(0)" ::: "memory");
#pragma unroll
    for (int j = 0; j < 4; ++j) { const int n = (lane >> 3) + 8 * j; const LAS float* s = scr + (8 * c) * 33 + n;
        v4u o; o.x = cvt_pk_bf16(s[0 * 33] * g0[0], s[1 * 33] * g0[1]); o.y = cvt_pk_bf16(s[2 * 33] * g0[2], s[3 * 33] * g0[3]); o.z = cvt_pk_bf16(s[4 * 33] * g1[0], s[5 * 33] * g1[1]); o.w = cvt_pk_bf16(s[6 * 33] * g1[2], s[7 * 33] * g1[3]);
        *(v4u*)(WT + (size_t)(row_off + n0 + n) * ldd + k0 + 8 * c) = o; }
    asm volatile("s_waitcnt lgkmcnt(0)" ::: "memory");
}
__device__ __forceinline__ void cvt_job(const float* W, int K, int N, bf16_t* WT, int ldd, int row_off, LAS float* scr, int gw, int NW, int lane, const float* gs = nullptr) {
    const int nblk = N / 32, nit = (K / 64) * nblk;
    for (int it = gw; it < nit; it += NW) p0_transpose_item(W, N, WT, ldd, row_off, scr, it, nblk, lane, gs);
}
__device__ __forceinline__ void phase_convert(ArgsP a, LAS unsigned char* lds, const int tid, const int bx) {
    const int lane = tid & 63, wave = tid >> 6, G = gridDim.x;
    const int gw = bx * 8 + wave, NW = G * 8; const size_t gt = (size_t)bx * 512 + tid, NT = (size_t)G * 512;
    LAS float* scr = (LAS float*)(lds + wave * 8448);
    unsigned char* ws = a->ws;
    for (int l = 0; l < DEPTH; ++l) {
        bf16_t* win = (bf16_t*)(ws + WS_WIN) + (size_t)l * NZ * DM;
        cvt_job(a->in[I_W_IN] + (size_t)l * DM * INW, DM, INW, win, DM, 0, scr, gw, NW, lane, a->in[I_ATTN_NORM] + (size_t)l * DM);
        if (l > 0) cvt_job(a->in[I_W_VRES_DN] + (size_t)(l - 1) * DM * 32, DM, 32, win, DM, INW, scr, gw, NW, lane, a->in[I_ATTN_NORM] + (size_t)l * DM);
        { const int r0 = (l == 0) ? INW : INW + 32; const size_t n16 = (size_t)(NZ - r0) * DM / 8; v4u* z = (v4u*)(win + (size_t)r0 * DM);
          for (size_t i = gt; i < n16; i += NT) z[i] = (v4u){0u, 0u, 0u, 0u}; }
        cvt_job(a->in[I_W_OUT] + (size_t)l * DM * DM, DM, DM, (bf16_t*)(ws + WS_WOUT) + (size_t)l * DM * DM, DM, 0, scr, gw, NW, lane);
        cvt_job(a->in[I_W_FFN_UP] + (size_t)l * DM * DFF, DM, DFF, (bf16_t*)(ws + WS_WUP) + (size_t)l * DFF * DM, DM, 0, scr, gw, NW, lane, a->in[I_MLP_NORM] + (size_t)l * DM);
        cvt_job(a->in[I_W_FFN_DOWN] + (size_t)l * DFF * DM, DFF, DM, (bf16_t*)(ws + WS_WDN) + (size_t)l * DM * DFF, DFF, 0, scr, gw, NW, lane);
        cvt_job(a->in[I_W_PLE_GATE] + (size_t)l * DM * DM, DM, DM, (bf16_t*)(ws + WS_WGATE) + (size_t)l * DM * DM, DM, 0, scr, gw, NW, lane, a->in[I_PLE_NORM] + (size_t)l * DM);
        cvt_job(a->in[I_W_PLE_PROJ] + (size_t)l * DPLE * DM, DPLE, DM, (bf16_t*)(ws + WS_WPROJ) + (size_t)l * DM * DPLE, DPLE, 0, scr, gw, NW, lane);
        for (int gi = 0; gi < 4; ++gi)
            cvt_job(a->in[I_POOL_W] + ((size_t)l * 4 + gi) * 256 * 256, 256, 256, (bf16_t*)(ws + WS_WPOOL) + (size_t)l * 1024 * 256, 256, gi * 256, scr, gw, NW, lane);
        { bf16_t* wl = (bf16_t*)(ws + WS_WLORA) + (size_t)l * 4096 * KL;
          const float* wu = a->in[I_W_UP] + (size_t)l * 64 * RW; const float* au = a->in[I_A_UP] + (size_t)l * 64 * RW; const float* gu = a->in[I_G_UP] + (size_t)l * 160 * RW;
          const float* vu = a->in[I_V_UP] + (size_t)(l > 0 ? l - 1 : 0) * 32 * RW;
          for (size_t idx = gt; idx < (size_t)4096 * KL; idx += NT) { const int n = (int)(idx / KL), k = (int)(idx % KL), t = n >> 10, col = n & 1023; float v = 0.f;
              if (t == 0) { if (k < 64) v = wu[(size_t)k * RW + col]; }
              else if (t == 1) { if (k >= 64 && k < 128) v = au[(size_t)(k - 64) * RW + col]; }
              else if (t == 2) { if (k >= 128 && k < 288) v = gu[(size_t)(k - 128) * RW + col]; }
              else { if (l > 0 && k >= 288 && k < 320) v = vu[(size_t)(k - 288) * RW + col]; }
              wl[idx] = (bf16_t)(cvt_pk_bf16(v, 0.f) & 0xffffu); } }
    }
    { u64* SS = (u64*)(ws + WS_SS); bf16_t* XP = (bf16_t*)(ws + WS_H); const float* x = a->in[I_X];
      for (size_t i = gt; i < (size_t)12 * M; i += NT) SS[M + i] = 0ull;
      for (int row = gw; row < M; row += NW) {
          const f32x4* xr = (const f32x4*)(x + (size_t)row * DM) + lane; float s = 0.f;
#pragma unroll
          for (int j = 0; j < 8; ++j) { const f32x4 v = xr[64 * j]; s += (v[0] * v[0] + v[1] * v[1]) + (v[2] * v[2] + v[3] * v[3]);
              v2u w; w.x = cvt_pk_bf16(v[0], v[1]); w.y = cvt_pk_bf16(v[2], v[3]); ((v2u*)(XP + (size_t)row * DM))[lane + 64 * j] = w; }
          s = wave_sum(s); if (lane == 0) SS[row] = (u64)(s * SS_SCALE); } }
    { const float* p = a->in[I_P]; bf16_t* pb = (bf16_t*)(ws + WS_PB); const size_t n8 = (size_t)DEPTH * M * DPLE / 8;
      for (size_t i = gt; i < n8; i += NT) { const f32x8 v = ld8f(p + i * 8); *(v4u*)(pb + i * 8) = pk8(v); } }
}

template <int WIN> __device__ __forceinline__ v4u pool_diff(const bf16_t* zp, int tpos) {
    const f32x8 u = up8(*(const v4u*)zp);
    v4u raw[WIN - 1];
#pragma unroll
    for (int q = 1; q < WIN; ++q) raw[q - 1] = *(const v4u*)(zp - (size_t)((q <= tpos) ? q : 0) * NZ);
    f32x8 s = u;
#pragma unroll
    for (int q = 1; q < WIN; ++q) { const float msk = (q <= tpos) ? 1.0f : 0.0f; s = s + up8(raw[q - 1]) * msk; }
    const int cnt = (tpos + 1 < WIN) ? tpos + 1 : WIN;
    return pk8(s * (1.0f / (float)cnt) - u);
}
__device__ __forceinline__ void phase_prepa(ArgsP a, int l, const int tid, const int bx) {
    const int G = gridDim.x;
    const bf16_t* Z = (const bf16_t*)(a->ws + WS_Z); bf16_t* DP = (bf16_t*)(a->ws + WS_DPOOL); bf16_t* AL = (bf16_t*)(a->ws + WS_ALORA);
    const float* mus = a->in[I_MU_SHIFT] + (size_t)l * SHIFTW; const float* muv = a->in[I_MU_VRES] + (size_t)(l > 0 ? l - 1 : 0) * 32;
    const int wave = __builtin_amdgcn_readfirstlane(tid >> 6), lane = tid & 63;
    const int gi = wave & 3, prow = (wave >> 2) * 2 + (lane >> 5), pcol = gi * 256 + 8 * (lane & 31);
    const int arow = tid / 48, acol = 8 * (tid % 48);
    for (int unit = bx; unit < M / 4; unit += G) {
        { const int row = unit * 4 + prow, tpos = row & (SEQ - 1);
          const bf16_t* zp = Z + (size_t)row * NZ + pcol; v4u d;
          if (gi == 0) d = pool_diff<2>(zp, tpos); else if (gi == 1) d = pool_diff<4>(zp, tpos); else if (gi == 2) d = pool_diff<8>(zp, tpos); else d = pool_diff<16>(zp, tpos);
          *(v4u*)(DP + (size_t)row * RW + pcol) = d; }
        if (tid < 192) {
            const int row = unit * 4 + arow, tpos = row & (SEQ - 1), c = acol; f32x8 o;
#pragma unroll
            for (int j = 0; j < 8; ++j) o[j] = 0.f;
            if (c < 288 || (c < 320 && l > 0)) {
                const bf16_t* zp = Z + (size_t)row * NZ + 4096 + c;
                const f32x8 zc = up8(*(const v4u*)zp); f32x8 zq;
                if (tpos > 0) zq = up8(*(const v4u*)(zp - NZ)); else {
#pragma unroll
                    for (int j = 0; j < 8; ++j) zq[j] = 0.f; }
                const f32x8 mu = (c < 288) ? ld8f(mus + 3072 + c) : ld8f(muv + (c - 288));
                const f32x8 zs = zc + (zq - zc) * mu;
                if (c < 64) {
#pragma unroll
                    for (int j = 0; j < 8; ++j) o[j] = 1.0f - 2.0f * __builtin_amdgcn_rcpf(1.0f + __expf(2.0f * zs[j])); }
                else if (c >= 128 && c < 288) {
#pragma unroll
                    for (int j = 0; j < 8; ++j) o[j] = sigm(zs[j]); }
                else o = zs;
            }
            *(v4u*)(AL + (size_t)row * KL + c) = pk8(o);
        }
    }
}

constexpr int TC = 32, STEPB = 1344, BUFB = TC * STEPB, YBB = TC * 16 * 4;
struct ScanRaw { v4u zr, zrp, zk, zkp, zv, zvp, ld, aa, vg, vf; };
__device__ __forceinline__ void scan_unit(ArgsP a, int l, int u, LAS unsigned char* lds, const int tid) {
    const int wave = __builtin_amdgcn_readfirstlane(tid >> 6), lane = tid & 63;
    const int bh = u >> 2, rg = u & 3, b = bh >> 4, h = bh & 15;
    const bool hasv = l > 0;
    constexpr int NC = SEQ / TC;
    const size_t rowbase = (size_t)b * SEQ;
    if (wave < 4) {
        const int rowl = 4 * wave + (lane >> 4), j = lane & 15;
        f32x2 s01 = {0.f, 0.f}, s23 = {0.f, 0.f};
        for (int c = 0; c < NC; ++c) {
            __syncthreads();
            const LAS unsigned char* buf = lds + (c & 1) * BUFB + 16 * j;
            const LAS unsigned char* vb = lds + (c & 1) * BUFB + 1280 + 4 * rowl;
            LAS float* yb = (LAS float*)(lds + 2 * BUFB + (c & 1) * YBB) + rowl + (15 - j) * 16;
            f32x4 R[3], W[3], K[3], A[3], B[3]; float V[3];
#define SC_LD(sl, tl) do { R[sl] = *(const LAS f32x4*)(buf + (tl) * STEPB); W[sl] = *(const LAS f32x4*)(buf + (tl) * STEPB + 256); K[sl] = *(const LAS f32x4*)(buf + (tl) * STEPB + 512); \
                A[sl] = *(const LAS f32x4*)(buf + (tl) * STEPB + 768); B[sl] = *(const LAS f32x4*)(buf + (tl) * STEPB + 1024); V[sl] = *(const LAS float*)(vb + (tl) * STEPB); } while (0)
            SC_LD(0, 0); SC_LD(1, 1);
            float yprev = 0.f, ysel = 0.f;
#pragma unroll
            for (int i = 0; i < TC; ++i) {
                const int sl = i % 3;
                if (i + 2 < TC) SC_LD((i + 2) % 3, i + 2);
                const f32x2 vv = {V[sl], V[sl]};
                f32x2 pp = s01 * (f32x2){A[sl][0], A[sl][1]}; pp = s23 * (f32x2){A[sl][2], A[sl][3]} + pp;
                float p = pp[0] + pp[1];
                f32x2 t01 = vv * (f32x2){K[sl][0], K[sl][1]}, t23 = vv * (f32x2){K[sl][2], K[sl][3]};
                t01 = s01 * (f32x2){W[sl][0], W[sl][1]} + t01; t23 = s23 * (f32x2){W[sl][2], W[sl][3]} + t23;
                if (i > 0) {
                    p += dpp1<0x128>(p); yprev += dpp1<0x128>(yprev);
                    p += dpp1<0x124>(p); yprev += dpp1<0x124>(yprev);
                    p += dpp1<0x122>(p); yprev += dpp1<0x122>(yprev);
                    p += dpp1<0x121>(p); yprev += dpp1<0x121>(yprev);
                    ysel = __builtin_bit_cast(float, __builtin_amdgcn_update_dpp(__builtin_bit_cast(int, yprev), __builtin_bit_cast(int, ysel), 0x111, 0xF, 0xF, false));
                    if ((i & 15) == 0) yb[((i >> 4) - 1) * 256] = ysel;
                } else {
                    p += dpp1<0x128>(p); p += dpp1<0x124>(p); p += dpp1<0x122>(p); p += dpp1<0x121>(p);
                }
                const f32x2 pv = {p, p};
                s01 = pv * (f32x2){B[sl][0], B[sl][1]} + t01; s23 = pv * (f32x2){B[sl][2], B[sl][3]} + t23;
                f32x2 yy = s01 * (f32x2){R[sl][0], R[sl][1]}; yy = s23 * (f32x2){R[sl][2], R[sl][3]} + yy;
                yprev = yy[0] + yy[1];
            }
            yprev += dpp1<0x128>(yprev); yprev += dpp1<0x124>(yprev); yprev += dpp1<0x122>(yprev); yprev += dpp1<0x121>(yprev);
            ysel = __builtin_bit_cast(float, __builtin_amdgcn_update_dpp(__builtin_bit_cast(int, yprev), __builtin_bit_cast(int, ysel), 0x111, 0xF, 0xF, false));
            yb[(TC / 16 - 1) * 256] = ysel;
#undef SC_LD
        }
        __syncthreads();
    } else {
        const int ltid = tid - 256, tl = ltid >> 3, cgp = ltid & 7;
        const int col0 = h * HS + 8 * cgp;
        const bf16_t* Z = (const bf16_t*)(a->ws + WS_Z); const bf16_t* PL = (const bf16_t*)(a->ws + WS_PLANES); const bf16_t* VF = (const bf16_t*)(a->ws + WS_VFIRST);
        bf16_t* Y = (bf16_t*)(a->ws + WS_DPOOL);
        const float* mus = a->in[I_MU_SHIFT] + (size_t)l * SHIFTW;
        const f32x8 mur = ld8f(mus + col0), muk = ld8f(mus + 1024 + col0), muv = ld8f(mus + 2048 + col0);
        const f32x8 kkc = ld8f(a->in[I_K_K] + (size_t)l * RW + col0), kac = ld8f(a->in[I_K_A] + (size_t)l * RW + col0);
        const bool vmine = (cgp >> 1) == rg;
#define SCAN_LOAD(R, cc) do { const int t_ = (cc) * TC + tl; const size_t row_ = rowbase + t_; const size_t rowp_ = (t_ > 0) ? row_ - 1 : row_; \
            const bf16_t* z_ = Z + row_ * NZ + col0; const bf16_t* zq_ = Z + rowp_ * NZ + col0; \
            R.zr = *(const v4u*)(z_ + 1024); R.zk = *(const v4u*)(z_ + 2048); R.zv = *(const v4u*)(z_ + 3072); \
            R.zrp = *(const v4u*)(zq_ + 1024); R.zkp = *(const v4u*)(zq_ + 2048); R.zvp = *(const v4u*)(zq_ + 3072); \
            R.ld = *(const v4u*)(PL + row_ * RW + col0); R.aa = *(const v4u*)(PL + PLANE + row_ * RW + col0); \
            if (hasv) { R.vg = *(const v4u*)(PL + 3 * PLANE + row_ * RW + col0); R.vf = *(const v4u*)(VF + row_ * RW + col0); } else { R.vg = R.ld; R.vf = R.ld; } } while (0)
#define SCAN_FLUSH(cc) do { const LAS float* yb_ = (const LAS float*)(lds + 2 * BUFB + ((cc) & 1) * YBB) + tl * 16 + 2 * cgp; \
            const unsigned w_ = cvt_pk_bf16(yb_[0], yb_[1]); *(unsigned*)(Y + (rowbase + (size_t)(cc) * TC + tl) * RW + h * HS + 16 * rg + 2 * cgp) = w_; } while (0)
        ScanRaw nx; SCAN_LOAD(nx, 0);
        for (int c = 0; c < NC; ++c) {
            const ScanRaw cu = nx;
            if (c + 1 < NC) SCAN_LOAD(nx, c + 1);
            const int t = c * TC + tl;
            const f32x8 zr = up8(cu.zr), zk = up8(cu.zk), zv = up8(cu.zv);
            f32x8 zrp = up8(cu.zrp), zkp = up8(cu.zkp), zvp = up8(cu.zvp);
            if (t == 0) {
#pragma unroll
                for (int q = 0; q < 8; ++q) { zrp[q] = 0.f; zkp[q] = 0.f; zvp[q] = 0.f; } }
            const f32x8 r = zr + (zrp - zr) * mur, k = zk + (zkp - zk) * muk; f32x8 v = zv + (zvp - zv) * muv;
            const f32x8 ld = up8(cu.ld), av = up8(cu.aa);
            if (hasv) v = v + (up8(cu.vf) - v) * up8(cu.vg);
            const f32x8 kk = k * kkc;
            float n2 = sum8(kk * kk); n2 += __shfl_xor(n2, 1); n2 += __shfl_xor(n2, 2); n2 += __shfl_xor(n2, 4);
            const float inv = 1.0f / fmaxf(sqrtf(n2), 1e-12f);
            const f32x8 kkn = kk * inv;
            const f32x8 kadj = k * (1.0f + (av - 1.0f) * kac);
            f32x8 dec;
#pragma unroll
            for (int q = 0; q < 8; ++q) dec[q] = __expf(ld[q]);
            const f32x8 avec = -kkn, bvec = kkn * av;
            LAS unsigned char* dst = lds + (c & 1) * BUFB + tl * STEPB + cgp * 32;
#define ST8(off, val) do { *(LAS f32x4*)(dst + (off)) = (f32x4){val[0], val[1], val[2], val[3]}; *(LAS f32x4*)(dst + (off) + 16) = (f32x4){val[4], val[5], val[6], val[7]}; } while (0)
            ST8(0, r); ST8(256, dec); ST8(512, kadj); ST8(768, avec); ST8(1024, bvec);
            if (vmine) { LAS unsigned char* dv = lds + (c & 1) * BUFB + tl * STEPB + 1280 + (cgp & 1) * 32;
                *(LAS f32x4*)(dv) = (f32x4){v[0], v[1], v[2], v[3]}; *(LAS f32x4*)(dv + 16) = (f32x4){v[4], v[5], v[6], v[7]}; }
#undef ST8
            if (c >= 2) SCAN_FLUSH(c - 2);
            __syncthreads();
        }
        __syncthreads();
        SCAN_FLUSH(NC - 2); SCAN_FLUSH(NC - 1);
#undef SCAN_LOAD
#undef SCAN_FLUSH
    }
    __syncthreads();
}

__device__ __forceinline__ void phase_post(ArgsP a, int l, const int tid, const int bx) {
    const int lane = tid & 63, wave = tid >> 6; const int gw = bx * 8 + wave, NW = gridDim.x * 8;
    const bf16_t* Z = (const bf16_t*)(a->ws + WS_Z); const bf16_t* PL = (const bf16_t*)(a->ws + WS_PLANES); bf16_t* VF = (bf16_t*)(a->ws + WS_VFIRST);
    const bf16_t* Y = (const bf16_t*)(a->ws + WS_DPOOL); bf16_t* MIX = (bf16_t*)(a->ws + WS_MIX);
    const float* mus = a->in[I_MU_SHIFT] + (size_t)l * SHIFTW;
    const bool hasv = l > 0;
    for (int it = gw; it < M * 2; it += NW) {
        const int row = it >> 1, h = (it & 1) * 8 + (lane >> 3), col = h * HS + 8 * (lane & 7), tpos = row & (SEQ - 1);
        const bf16_t* z = Z + (size_t)row * NZ + col; const bf16_t* zq = (tpos > 0) ? z - NZ : z;
        const f32x8 zr = up8(*(const v4u*)(z + 1024)), zk = up8(*(const v4u*)(z + 2048)), zv = up8(*(const v4u*)(z + 3072));
        f32x8 zrp = up8(*(const v4u*)(zq + 1024)), zkp = up8(*(const v4u*)(zq + 2048)), zvp = up8(*(const v4u*)(zq + 3072));
        if (tpos == 0) {
#pragma unroll
            for (int q = 0; q < 8; ++q) { zrp[q] = 0.f; zkp[q] = 0.f; zvp[q] = 0.f; } }
        const f32x8 r = zr + (zrp - zr) * ld8f(mus + col), k = zk + (zkp - zk) * ld8f(mus + 1024 + col); f32x8 v = zv + (zvp - zv) * ld8f(mus + 2048 + col);
        const size_t po = (size_t)row * RW + col;
        const f32x8 av = up8(*(const v4u*)(PL + PLANE + po)), gg = up8(*(const v4u*)(PL + 2 * PLANE + po));
        if (hasv) v = v + (up8(*(const v4u*)(VF + po)) - v) * up8(*(const v4u*)(PL + 3 * PLANE + po));
        else *(v4u*)(VF + po) = pk8(v);
        const f32x8 kadj = k * (1.0f + (av - 1.0f) * ld8f(a->in[I_K_A] + (size_t)l * RW + col));
        float bonus = sum8(r * kadj * ld8f(a->in[I_R_K] + (size_t)l * RW + col));
        bonus += __shfl_xor(bonus, 1); bonus += __shfl_xor(bonus, 2); bonus += __shfl_xor(bonus, 4);
        const f32x8 y = up8(*(const v4u*)(Y + po));
        float sm = sum8(y); sm += __shfl_xor(sm, 1); sm += __shfl_xor(sm, 2); sm += __shfl_xor(sm, 4);
        const float mean = sm * (1.0f / 64.0f);
        const f32x8 d = y - mean;
        float vs = sum8(d * d); vs += __shfl_xor(vs, 1); vs += __shfl_xor(vs, 2); vs += __shfl_xor(vs, 4);
        const float rstd = rsqrtf(vs * (1.0f / 64.0f) + GN_EPS);
        const f32x8 o = (d * rstd * ld8f(a->in[I_GN_G] + (size_t)l * RW + col) + ld8f(a->in[I_GN_B] + (size_t)l * RW + col) + bonus * v) * gg;
        *(v4u*)(MIX + (size_t)row * DM + 1024 + col) = pk8(o);
    }
}

#define XB_TMO      128
#define XB_XCNT(j)  (256  + 64 * (j))
#define XB_XSUB(j)  (1280 + 64 * (j))
#define XB_XGEN(j)  (2304 + 64 * (j))
#define XB_TOP      3328
#define XB_TOPGEN   3392
#define XCD_BAR_WORDS 3456
#define XB_SPIN_CAP (1u << 18)

__device__ __forceinline__ unsigned xb_ld(unsigned* p)              { return __hip_atomic_load(p, __ATOMIC_RELAXED, __HIP_MEMORY_SCOPE_AGENT); }
__device__ __forceinline__ unsigned xb_add(unsigned* p, unsigned v) { return __hip_atomic_fetch_add(p, v, __ATOMIC_RELAXED, __HIP_MEMORY_SCOPE_AGENT); }
__device__ __forceinline__ unsigned xb_xcc_id() { return (unsigned)__builtin_amdgcn_s_getreg((3 << 11) | 20) & 0xFu; }
#define XB_SPIN(cond, bar) do { unsigned _sp = 0; while (cond) { __builtin_amdgcn_s_sleep(1); \
    if ((++_sp & 255u) == 0u) { if (xb_ld(&(bar)[XB_TMO])) break; if (_sp > XB_SPIN_CAP) { atomicAdd(&(bar)[XB_TMO], 1u); break; } } } } while (0)

struct XcdBarrier {
    unsigned* bar; unsigned x;
    volatile LAS unsigned* st;
};

__device__ __forceinline__ XcdBarrier xcd_barrier_post(unsigned* bar, volatile LAS unsigned* st) {
    XcdBarrier b; b.bar = bar; b.x = xb_xcc_id(); b.st = st;
    if (threadIdx.x == 0) (void)xb_add(&bar[XB_XCNT(b.x)], 1u);
    return b;
}
__device__ __forceinline__ void xcd_barrier_complete(unsigned* bar, unsigned x, unsigned& nloc, unsigned& nx) {
    const unsigned G = gridDim.x * gridDim.y * gridDim.z;
    unsigned sum, cnt, mine, sp = 0u;
    for (;;) {
        sum = 0u; cnt = 0u; mine = 0u;
#pragma unroll
        for (unsigned j = 0; j < 16; ++j) { const unsigned c = xb_ld(&bar[XB_XCNT(j)]); sum += c; cnt += (c > 0u) ? 1u : 0u; mine = (j == x) ? c : mine; }
        if (sum == G) break;
        __builtin_amdgcn_s_sleep(1);
        if ((++sp & 255u) == 0u) { if (xb_ld(&bar[XB_TMO])) break; if (sp > XB_SPIN_CAP) { atomicAdd(&bar[XB_TMO], 1u); break; } }
    }
    nloc = mine > 0u ? mine : 1u; nx = cnt > 0u ? cnt : 1u;
}

__device__ __forceinline__ void xcd_barrier(const XcdBarrier& b) {
    asm volatile("s_waitcnt vmcnt(0)" ::: "memory");
    __syncthreads();
    if (threadIdx.x == 0) {
        unsigned* bar = b.bar;
        __builtin_amdgcn_s_waitcnt(0);
        unsigned nloc = b.st[0], nx = b.st[1];
        if (nloc == 0u) { xcd_barrier_complete(bar, b.x, nloc, nx); b.st[0] = nloc; b.st[1] = nx; }
        const unsigned old = xb_add(&bar[XB_XSUB(b.x)], 1u);
        const unsigned gen = old / nloc;
        if (old + 1u == (gen + 1u) * nloc) {
            __builtin_amdgcn_fence(__ATOMIC_RELEASE, "agent");
            asm volatile("s_waitcnt vmcnt(0)" ::: "memory");
            const unsigned og = xb_add(&bar[XB_TOP], 1u);
            const unsigned tg = og / nx;
            if (og + 1u == (tg + 1u) * nx) xb_add(&bar[XB_TOPGEN], 1u);
            else XB_SPIN(xb_ld(&bar[XB_TOPGEN]) == tg, bar);
            __builtin_amdgcn_fence(__ATOMIC_ACQUIRE, "agent");
            xb_add(&bar[XB_XGEN(b.x)], 1u);
            asm volatile("s_waitcnt vmcnt(0)" ::: "memory");
        } else {
            XB_SPIN(xb_ld(&bar[XB_XGEN(b.x)]) == gen, bar);
            __builtin_amdgcn_fence(__ATOMIC_ACQUIRE, "agent");
            asm volatile("s_waitcnt vmcnt(0)" ::: "memory");
        }
    }
    __syncthreads();
}


constexpr int N_PHASES = 2 + 9 * DEPTH;
__device__ __forceinline__ bool make_job(ArgsP a, int l, int s, int q, pg8::Job& J) {
    unsigned char* ws = a->ws; u64* SS = (u64*)(ws + WS_SS);
    bf16_t* XC = (bf16_t*)(ws + ((l & 1) ? WS_XQ : WS_H)); bf16_t* XN = (bf16_t*)(ws + ((l & 1) ? WS_H : WS_XQ));
    bf16_t* MIX = (bf16_t*)(ws + WS_MIX); bf16_t* PP = (bf16_t*)(ws + WS_MIX);
    J.a_pn_step = 0; J.nM = M / 256; J.O = nullptr; J.ldc = DM; J.c0 = nullptr; J.c1 = nullptr; J.c2 = nullptr; J.base = nullptr; J.out = nullptr; J.pp = nullptr; J.ss_in = nullptr; J.ss_out = nullptr;
    if (s == 0 && q == 0) { J.A = XC; J.Bt = (const bf16_t*)(ws + WS_WIN) + (size_t)l * NZ * DM; J.lda = DM; J.ldb = DM; J.K = DM; J.nN = NZ / 256; J.mode = 0; J.O = (bf16_t*)(ws + WS_Z); J.ldc = NZ; J.ss_in = SS + (size_t)(3 * l) * M; return true; }
    if (s == 2 && q == 0) { J.A = (const bf16_t*)(ws + WS_ALORA); J.Bt = (const bf16_t*)(ws + WS_WLORA) + (size_t)l * 4096 * KL; J.lda = KL; J.ldb = KL; J.K = KL; J.nN = 16; J.mode = 3; J.O = (bf16_t*)(ws + WS_PLANES); J.ldc = RW;
                            J.c0 = a->in[I_W0] + (size_t)l * RW; J.c1 = a->in[I_A0] + (size_t)l * RW; J.c2 = (l > 0) ? a->in[I_V0] + (size_t)(l - 1) * RW : nullptr; return true; }
    if (s == 2 && q == 1) { J.A = (const bf16_t*)(ws + WS_DPOOL); J.Bt = (const bf16_t*)(ws + WS_WPOOL) + (size_t)l * 1024 * 256; J.lda = RW; J.ldb = 256; J.K = 256; J.a_pn_step = 256; J.nN = 4; J.mode = 2; J.O = MIX; J.ldc = DM;
                            J.c0 = a->in[I_POOL_SCALE] + (size_t)l * 1024; return true; }
    if (s == 5 && q == 0) { J.A = MIX; J.Bt = (const bf16_t*)(ws + WS_WOUT) + (size_t)l * DM * DM; J.lda = DM; J.ldb = DM; J.K = DM; J.nN = DM / 256; J.mode = 4; J.base = XC; J.out = XC; J.ss_out = SS + (size_t)(3 * l + 1) * M; return true; }
    if (s == 6 && q == 0) { J.A = XC; J.Bt = (const bf16_t*)(ws + WS_WUP) + (size_t)l * DFF * DM; J.lda = DM; J.ldb = DM; J.K = DM; J.nN = DFF / 256; J.mode = 1; J.O = (bf16_t*)(ws + WS_U); J.ldc = DFF; J.ss_in = SS + (size_t)(3 * l + 1) * M; return true; }
    if (s == 6 && q == 1) { J.A = (const bf16_t*)(ws + WS_PB) + (size_t)l * M * DPLE; J.Bt = (const bf16_t*)(ws + WS_WPROJ) + (size_t)l * DM * DPLE; J.lda = DPLE; J.ldb = DPLE; J.K = DPLE; J.nN = DM / 256; J.mode = 0; J.O = PP; J.ldc = DM; return true; }
    if (s == 7 && q == 0) { J.A = (const bf16_t*)(ws + WS_U); J.Bt = (const bf16_t*)(ws + WS_WDN) + (size_t)l * DM * DFF; J.lda = DFF; J.ldb = DFF; J.K = DFF; J.nN = DM / 256; J.mode = 4; J.base = XC; J.out = XC; J.ss_out = SS + (size_t)(3 * l + 2) * M; return true; }
    if (s == 8 && q == 0) { J.A = XC; J.Bt = (const bf16_t*)(ws + WS_WGATE) + (size_t)l * DM * DM; J.lda = DM; J.ldb = DM; J.K = DM; J.nN = DM / 256; J.mode = 5; J.base = XC; J.out = XN; J.pp = PP; J.ss_in = SS + (size_t)(3 * l + 2) * M;
                            J.ss_out = SS + (size_t)(3 * l + 3) * M; return true; }
    return false;
}
__device__ __forceinline__ void phase_final(ArgsP a, const int tid, const int bx) {
    const int lane = tid & 63, wave = tid >> 6; const int gw = bx * 8 + wave, NW = gridDim.x * 8;
    const bf16_t* X = (const bf16_t*)(a->ws + ((DEPTH & 1) ? WS_XQ : WS_H)); const u64* SS = (const u64*)(a->ws + WS_SS) + (size_t)(3 * DEPTH) * M; const float* g = a->in[I_FINAL_NORM]; float* out = a->out;
    f32x8 gv[4];
#pragma unroll
    for (int j = 0; j < 4; ++j) gv[j] = ld8f(g + 8 * lane + 512 * j);
    for (int row = gw; row < M; row += NW) {
        const float rs = rsqrtf((float)SS[row] * SS_INV + NORM_EPS);
#pragma unroll
        for (int j = 0; j < 4; ++j) { const f32x8 o = up8(*(const v4u*)(X + (size_t)row * DM + 8 * lane + 512 * j)) * rs * gv[j]; float* op = out + (size_t)row * DM + 8 * lane + 512 * j;
            *(f32x4*)op = (f32x4){o[0], o[1], o[2], o[3]}; *(f32x4*)(op + 4) = (f32x4){o[4], o[5], o[6], o[7]}; }
    }
}
constexpr int dup_count() { int c = 0; for (int s = 0; s < 9; ++s) c += (PROBE_DUP >> s) & 1; return c; }
constexpr int SUBS = 9 + dup_count(), PRE = 1 + ((PROBE_DUP >> 9) & 1);
constexpr int N_PHASES_RUN = PRE + SUBS * DEPTH + 1;
__global__ void __launch_bounds__(512, 2) fwd_megakernel(Args a_byval) {
    ArgsP a = (ArgsP)__builtin_amdgcn_kernarg_segment_ptr();
    extern __shared__ __attribute__((aligned(16))) unsigned char lds_raw[];
    LAS unsigned char* lds = (LAS unsigned char*)lds_raw;
    cg::grid_group grid = cg::this_grid();
    const int G = gridDim.x;
    if (threadIdx.x < 16) ((LAS unsigned*)(lds + BAR_LDS_OFF))[threadIdx.x] = 0u;
    __syncthreads();
    XcdBarrier xbar = xcd_barrier_post((unsigned*)a->ws, (volatile LAS unsigned*)(lds + BAR_LDS_OFF));
    const int ph_lo = a->ph_lo, ph_hi = a->ph_hi;
    const int wave_s = __builtin_amdgcn_readfirstlane((int)threadIdx.x >> 6);
    if (ph_lo < 0) grid.sync();
    for (int ph = ph_lo; ph < ph_hi; ++ph) {
        if (ph > ph_lo) xcd_barrier(xbar);
        asm volatile("" : "+s"(a) :: "memory");
        int tid = (wave_s << 6) + (int)__builtin_amdgcn_mbcnt_hi(~0u, __builtin_amdgcn_mbcnt_lo(~0u, 0u)), bx = blockIdx.x; asm volatile("" : "+v"(tid), "+s"(bx));
        int l = 0, s;
        if (ph < PRE) s = 13;
        else if (ph == N_PHASES_RUN - 1) s = 12;
        else { l = (ph - PRE) / SUBS; const int qq = (ph - PRE) % SUBS; int c = 0; s = 0;
               for (; s < 9; ++s) { const int n = 1 + ((PROBE_DUP >> s) & 1); if (qq < c + n) break; c += n; } }
        if (s == 13) { phase_convert(a, lds, tid, bx); }
        else if (s == 12) { phase_final(a, tid, bx); }
        else if (s == 1) { phase_prepa(a, l, tid, bx); }
        else if (s == 3) { const int vcu = (G % 8 == 0) ? (bx % 8) * (G / 8) + bx / 8 : bx; for (int u = vcu; u < 256; u += G) scan_unit(a, l, u, lds, tid); }
        else if (s == 4) { phase_post(a, l, tid, bx); }
        else {
            for (int q = 0; q < 2; ++q) { pg8::Job J; if (!make_job(a, l, s, q, J)) break;
                pg8::StaticOrder S; S.init(J.nM, J.nN, G, bx); pg8::gemm_phase(lds, J, S, tid); }
        }
    }
}

extern "C" void kernel_launch(void* const* d_in, const int* in_sizes, int n_in, void* d_out, int out_size, void* d_ws, size_t ws_size, hipStream_t stream) {
    static int grid = 0;
    if (grid == 0) {
        if (n_in != 29 || in_sizes[0] != M * DM || out_size != M * DM || ws_size < WS_END) {
            fprintf(stderr, "kernel_launch: unexpected shapes: n_in %d in0 %d out %d ws %zu (need %zu); nothing launched\n", n_in, n_in > 0 ? in_sizes[0] : -1, out_size, ws_size, (size_t)WS_END); grid = -1; return; }
        int dev = 0, cus = 0, per_cu = 0;
        if (hipGetDevice(&dev) != hipSuccess || hipDeviceGetAttribute(&cus, hipDeviceAttributeMultiprocessorCount, dev) != hipSuccess) { fprintf(stderr, "kernel_launch: device query failed\n"); grid = -1; return; }
        if (hipFuncSetAttribute((const void*)fwd_megakernel, hipFuncAttributeMaxDynamicSharedMemorySize, LDS_BYTES) != hipSuccess) { fprintf(stderr, "kernel_launch: hipFuncSetAttribute failed\n"); grid = -1; return; }
        if (hipOccupancyMaxActiveBlocksPerMultiprocessor(&per_cu, (const void*)fwd_megakernel, 512, LDS_BYTES) != hipSuccess || per_cu < 1) {
            fprintf(stderr, "kernel_launch: occupancy query says %d blocks/CU; using 1\n", per_cu); per_cu = 1; }
        (void)hipGetLastError();
        grid = cus * 1;
        if (grid > 256) grid = 256;
    }
    if (grid < 0) return;
    Args a{};
    for (int i = 0; i < 29; ++i) a.in[i] = (const float*)d_in[i];
    a.out = (float*)d_out; a.ws = (unsigned char*)d_ws;
    if (hipMemsetAsync(d_ws, 0, 65536, stream) != hipSuccess) { fprintf(stderr, "kernel_launch: memset of barrier words failed\n"); return; }
#if MK_PER_PHASE_LAUNCH
    for (int ph = 0; ph < N_PHASES_RUN; ++ph) {
        a.ph_lo = ph; a.ph_hi = ph + 1;
        hipLaunchKernelGGL(fwd_megakernel, dim3(grid), dim3(512), LDS_BYTES, stream, a);
    }
#else
    a.ph_lo = 0; a.ph_hi = N_PHASES_RUN;
    void* args[] = {&a};
    hipError_t e = hipLaunchCooperativeKernel((const void*)fwd_megakernel, dim3(grid), dim3(512), args, LDS_BYTES, stream);
    if (e != hipSuccess) fprintf(stderr, "cooperative launch failed: %s (grid %d)\n", hipGetErrorString(e), grid);
#endif
}
```

```cpp
#include <hip/hip_runtime.h>
#include <hip/hip_cooperative_groups.h>
#include <cstdio>
#include <cstdint>
namespace cg = cooperative_groups;

#ifndef MK_PER_PHASE_LAUNCH
#define MK_PER_PHASE_LAUNCH 0
#endif

#ifndef PROBE_DUP
#define PROBE_DUP 0
#endif
#define LAS __attribute__((address_space(3)))
typedef unsigned short bf16_t;
typedef short bf16x8 __attribute__((ext_vector_type(8)));
typedef float f32x4 __attribute__((ext_vector_type(4)));
typedef float f32x8 __attribute__((ext_vector_type(8)));
typedef float f32x2 __attribute__((ext_vector_type(2)));
typedef unsigned v4u __attribute__((ext_vector_type(4)));
typedef unsigned v2u __attribute__((ext_vector_type(2)));

constexpr int BATCH = 4, SEQ = 4096, DM = 2048, DEPTH = 4, M = BATCH * SEQ;
constexpr int RW = 1024, HS = 64, NH = 16, DFF = 8192, DPLE = 256;
constexpr int INW = 4384, NZ = 4608, SHIFTW = 3360, KL = 384;
constexpr float NORM_EPS = 1e-6f, GN_EPS = 64e-5f;

constexpr size_t MiB = 1u << 20;
constexpr size_t WS_WIN = 1 * MiB, WS_WOUT = 73 * MiB, WS_WUP = 105 * MiB, WS_WDN = 233 * MiB, WS_WGATE = 361 * MiB, WS_WPROJ = 393 * MiB,
                 WS_WLORA = 397 * MiB, WS_WPOOL = 409 * MiB, WS_PB = 411 * MiB, WS_H = 443 * MiB, WS_MIX = 507 * MiB  ,
                 WS_DPOOL = 571 * MiB  , WS_ALORA = 603 * MiB, WS_VFIRST = 615 * MiB, WS_Z = 647 * MiB, WS_PLANES = 791 * MiB,
                 WS_U = 647 * MiB  , WS_XQ = 919 * MiB, WS_SS = 983 * MiB  , WS_END = 985 * MiB;
typedef unsigned long long u64;
constexpr float SS_SCALE = 1048576.0f, SS_INV = 1.0f / (1048576.0f * 2048.0f);
constexpr size_t PLANE = (size_t)M * RW;

constexpr int LDS_BYTES = 135168, BAR_LDS_OFF = 131072 + 256;

__device__ __forceinline__ unsigned cvt_pk_bf16(float lo, float hi) { unsigned r; asm volatile("v_cvt_pk_bf16_f32 %0, %1, %2" : "=v"(r) : "v"(lo), "v"(hi)); return r; }
__device__ __forceinline__ float bf2f(unsigned h) { return __uint_as_float(h << 16); }
__device__ __forceinline__ f32x8 up8(v4u p) {
    f32x8 r;
    r[0] = __uint_as_float(p.x << 16); r[1] = __uint_as_float(p.x & 0xffff0000u);
    r[2] = __uint_as_float(p.y << 16); r[3] = __uint_as_float(p.y & 0xffff0000u);
    r[4] = __uint_as_float(p.z << 16); r[5] = __uint_as_float(p.z & 0xffff0000u);
    r[6] = __uint_as_float(p.w << 16); r[7] = __uint_as_float(p.w & 0xffff0000u);
    return r;
}
__device__ __forceinline__ v4u pk8(f32x8 v) { v4u o; o.x = cvt_pk_bf16(v[0], v[1]); o.y = cvt_pk_bf16(v[2], v[3]); o.z = cvt_pk_bf16(v[4], v[5]); o.w = cvt_pk_bf16(v[6], v[7]); return o; }
__device__ __forceinline__ f32x8 ld8f(const float* p) { const f32x4 a = *(const f32x4*)p, b = *(const f32x4*)(p + 4); f32x8 r; r[0] = a[0]; r[1] = a[1]; r[2] = a[2]; r[3] = a[3]; r[4] = b[0]; r[5] = b[1]; r[6] = b[2]; r[7] = b[3]; return r; }
__device__ __forceinline__ float sigm(float x) { return __builtin_amdgcn_rcpf(1.0f + __expf(-x)); }
__device__ __forceinline__ float wave_sum(float v) {
#pragma unroll
    for (int o = 1; o < 64; o <<= 1) v += __shfl_xor(v, o);
    return v;
}
__device__ __forceinline__ float sum8(f32x8 v) { return ((v[0] + v[1]) + (v[2] + v[3])) + ((v[4] + v[5]) + (v[6] + v[7])); }
template <int CTRL> __device__ __forceinline__ float dpp1(float x) { const int xi = __builtin_bit_cast(int, x); return __builtin_bit_cast(float, __builtin_amdgcn_update_dpp(0, xi, CTRL, 0xF, 0xF, true)); }
template <int CTRL> __device__ __forceinline__ float dpp_mov(float x) { const int xi = __builtin_bit_cast(int, x); return __builtin_bit_cast(float, __builtin_amdgcn_update_dpp(xi, xi, CTRL, 0xF, 0xF, false)); }
__device__ __forceinline__ float allreduce16(float x) {
    x += dpp_mov<0x128>(x); x += dpp_mov<0x124>(x); x += dpp_mov<0x122>(x); x += dpp_mov<0x121>(x); return x;
}

namespace pg8 {
constexpr int BM = 256, BK = 64, HALF = 128, HTB = HALF * BK * 2, STAGE_BYTES = 8 * HTB, NXCD = 8, WGM = 4;
__host__ __device__ __forceinline__ int lds_byte(int r, int c) { const int st = (r >> 4) * 2 + (c >> 5), rr = r & 15, cc = c & 31, ob = rr * 64 + cc * 2; return st * 1024 + (ob ^ (((ob >> 9) & 1) << 5)); }
__host__ __device__ __forceinline__ void stage_rc(int b, int& R, int& C) { const int st = b / 1024, sb = b % 1024, swz = sb ^ (((sb >> 9) & 1) << 5); R = (st >> 1) * 16 + swz / 64; C = (st & 1) * 32 + (swz % 64) / 2; }
__host__ __device__ __forceinline__ int perm32(int rho) { const int n = rho >> 4, i = rho & 15; return 8 * (i >> 2) + 4 * n + (i & 3); }

struct Unit { int pm, pn; };

struct StaticOrder {
    int nM, nN, nwg, G, c;
    __device__ void init(int nM_, int nN_, int G_, int c_) { nM = nM_; nN = nN_; nwg = nM * nN; G = G_; c = c_; }
    __device__ bool next(int i, Unit& u) const {
        const long L = (long)i * G + c; if (L >= nwg) return false;
        int wgid = (int)L; { const int q = nwg / NXCD, r = nwg % NXCD, xcd = wgid % NXCD, off = wgid / NXCD; wgid = (xcd < r ? xcd * (q + 1) : r * (q + 1) + (xcd - r) * q) + off; }
        const int nig = WGM * nN, gid = wgid / nig, fm = gid * WGM, gsz = (nM - fm) < WGM ? (nM - fm) : WGM;
        u.pm = __builtin_amdgcn_readfirstlane(fm + ((wgid % nig) % gsz)); u.pn = __builtin_amdgcn_readfirstlane((wgid % nig) / gsz); return true;
    }
};

template <int MODE> struct EpiB {
    static constexpr bool PERM = true;
    bf16_t* O; int ldc; const float* c0; const float* c1; const float* c2; size_t plane; const u64* ss;
    __device__ __forceinline__ void operator()(const f32x4 (&acc)[2][2][4][2], const Unit& u, int wr, int wc, int fr, int fq, const u64 (&ssr)[2][4]) const {
        const int row0 = u.pm * BM + wr * 64 + fr; int colt = u.pn * BM; bf16_t* base = O; int t = 0;
        if (MODE == 3) { t = colt >> 10; base += (size_t)t * plane; colt &= 1023; }
        const int col0 = colt + wc * 32 + 8 * fq;
        f32x4 cv[2][2];
#pragma unroll
        for (int bj = 0; bj < 2; ++bj)
#pragma unroll
            for (int n = 0; n < 2; ++n) {
                cv[bj][n] = (f32x4){0.f, 0.f, 0.f, 0.f};
                if (MODE == 2) cv[bj][n] = *(const f32x4*)(c0 + col0 + bj * HALF + 4 * n);
                if (MODE == 3) { const float* b = (t == 0) ? c0 : (t == 1) ? c1 : (t == 3) ? c2 : nullptr; if (b) cv[bj][n] = *(const f32x4*)(b + col0 + bj * HALF + 4 * n); }
            }
        float rsv[2][4];
#pragma unroll
        for (int ai = 0; ai < 2; ++ai)
#pragma unroll
            for (int m = 0; m < 4; ++m) { rsv[ai][m] = 1.0f; if (MODE < 2) { if (ss) rsv[ai][m] = rsqrtf((float)ssr[ai][m] * SS_INV + NORM_EPS); } }
#pragma unroll
        for (int ai = 0; ai < 2; ++ai)
#pragma unroll
            for (int m = 0; m < 4; ++m) { bf16_t* rowp = base + (size_t)(row0 + ai * HALF + m * 16) * ldc + col0;
                const float rs = rsv[ai][m];
#pragma unroll
                for (int bj = 0; bj < 2; ++bj) { f32x4 v0 = acc[ai][bj][m][0], v1 = acc[ai][bj][m][1];
                    if (MODE < 2) { v0 = v0 * rs; v1 = v1 * rs; }
                    if (MODE == 1) {
#pragma unroll
                        for (int j = 0; j < 4; ++j) { const float a = fmaxf(v0[j], 0.f), b = fmaxf(v1[j], 0.f); v0[j] = a * a; v1[j] = b * b; } }
                    if (MODE == 2) { v0 = v0 * cv[bj][0]; v1 = v1 * cv[bj][1]; }
                    if (MODE == 3) { v0 = v0 + cv[bj][0]; v1 = v1 + cv[bj][1];
                        if (t == 0) {
#pragma unroll
                            for (int j = 0; j < 4; ++j) { v0[j] = -0.6065306597f * sigm(v0[j]); v1[j] = -0.6065306597f * sigm(v1[j]); } }
                        else if (t != 2) {
#pragma unroll
                            for (int j = 0; j < 4; ++j) { v0[j] = sigm(v0[j]); v1[j] = sigm(v1[j]); } }
                    }
                    v4u w; w.x = cvt_pk_bf16(v0[0], v0[1]); w.y = cvt_pk_bf16(v0[2], v0[3]); w.z = cvt_pk_bf16(v1[0], v1[1]); w.w = cvt_pk_bf16(v1[2], v1[3]);
                    *(v4u*)(rowp + bj * HALF) = w; } }
    }
};
template <bool GATE> struct EpiX {
    static constexpr int RB = GATE ? 2 : 4;
    const bf16_t* base; bf16_t* out; const bf16_t* pp; int ldc; const u64* ss_in; u64* ss_out;
    __device__ __forceinline__ void operator()(const f32x4 (&acc)[2][2][4][2], const Unit& u, int wr, int wc, int fr, int fq, const u64 (&ssr)[2][4]) const {
        const int row0 = u.pm * BM + wr * 64 + fr, col0 = u.pn * BM + wc * 32 + 8 * fq;
        float rsv[2][4];
#pragma unroll
        for (int ai = 0; ai < 2; ++ai)
#pragma unroll
            for (int m = 0; m < 4; ++m) { rsv[ai][m] = 1.0f; if (GATE) rsv[ai][m] = rsqrtf((float)ssr[ai][m] * SS_INV + NORM_EPS); }
#pragma unroll
        for (int aim = 0; aim < 8 / RB; ++aim) { const int ai = (aim * RB) >> 2, m0 = (aim * RB) & 3;
            v4u bs[RB][2], q[RB][2];
#pragma unroll
            for (int mm = 0; mm < RB; ++mm) { const size_t off = (size_t)(row0 + ai * HALF + (m0 + mm) * 16) * ldc + col0;
#pragma unroll
                for (int bj = 0; bj < 2; ++bj) { bs[mm][bj] = *(const v4u*)(base + off + bj * HALF); if (GATE) q[mm][bj] = *(const v4u*)(pp + off + bj * HALF); } }
#pragma unroll
            for (int mm = 0; mm < RB; ++mm) { const int m = m0 + mm, row = row0 + ai * HALF + m * 16; const size_t off = (size_t)row * ldc + col0; const float rs = rsv[ai][m];
                float sq = 0.f;
#pragma unroll
                for (int bj = 0; bj < 2; ++bj) { const f32x8 b = up8(bs[mm][bj]); f32x4 a0 = acc[ai][bj][m][0], a1 = acc[ai][bj][m][1];
                    if (GATE) { const f32x8 qf = up8(q[mm][bj]); a0 = a0 * rs; a1 = a1 * rs;
#pragma unroll
                        for (int j = 0; j < 4; ++j) { a0[j] = sigm(a0[j]) * qf[j]; a1[j] = sigm(a1[j]) * qf[4 + j]; } }
                    f32x8 x;
#pragma unroll
                    for (int j = 0; j < 4; ++j) { x[j] = b[j] + a0[j]; x[4 + j] = b[4 + j] + a1[j]; }
                    const v4u w = pk8(x);
                    *(v4u*)(out + off + bj * HALF) = w;
                    const f32x8 xr = up8(w); sq += sum8(xr * xr); }
                sq += __shfl_xor(sq, 16); sq += __shfl_xor(sq, 32);
                if (fq == 0) __hip_atomic_fetch_add(ss_out + row, (u64)(sq * SS_SCALE), __ATOMIC_RELAXED, __HIP_MEMORY_SCOPE_AGENT); }
            asm volatile("" ::: "memory"); }
    }
};

struct Job { const bf16_t* A; const bf16_t* Bt; int lda, ldb, K, a_pn_step, nM, nN, mode;
             bf16_t* O; int ldc; const float* c0; const float* c1; const float* c2; const bf16_t* base; bf16_t* out; const bf16_t* pp;
             const u64* ss_in; u64* ss_out; };
__device__ __forceinline__ void run_epi(const Job& J, const f32x4 (&acc)[2][2][4][2], const Unit& u, int wr, int wc, int fr, int fq, const u64 (&ssr)[2][4]) {
    switch (J.mode) {
    case 0: { EpiB<0> E{J.O, J.ldc, nullptr, nullptr, nullptr, 0, J.ss_in}; E(acc, u, wr, wc, fr, fq, ssr); } break;
    case 1: { EpiB<1> E{J.O, J.ldc, nullptr, nullptr, nullptr, 0, J.ss_in}; E(acc, u, wr, wc, fr, fq, ssr); } break;
    case 2: { EpiB<2> E{J.O, J.ldc, J.c0, nullptr, nullptr, 0, nullptr}; E(acc, u, wr, wc, fr, fq, ssr); } break;
    case 3: { EpiB<3> E{J.O, J.ldc, J.c0, J.c1, J.c2, PLANE, nullptr}; E(acc, u, wr, wc, fr, fq, ssr); } break;
    case 4: { EpiX<false> E{J.base, J.out, nullptr, J.ldc, nullptr, J.ss_out}; E(acc, u, wr, wc, fr, fq, ssr); } break;
    default: { EpiX<true> E{J.base, J.out, J.pp, J.ldc, J.ss_in, J.ss_out}; E(acc, u, wr, wc, fr, fq, ssr); } break;
    }
}
__device__ __forceinline__ void gemm_phase(LAS unsigned char* lds, const Job& J, const StaticOrder& S, const int tid) {
    const int wid = __builtin_amdgcn_readfirstlane(tid >> 6), lane = tid & 63, wr = wid >> 2, wc = wid & 3, fr = lane & 15, fq = lane >> 4;
    const int K = J.K, nt = K / BK;
    unsigned voffA[2], voffB[2];
#pragma unroll
    for (int i = 0; i < 2; ++i) { int R, C; stage_rc(tid * 16 + i * 8192, R, C); const int Rb = (R & ~31) + perm32(R & 31);
        voffA[i] = (unsigned)(R * J.lda + C) * 2u; voffB[i] = (unsigned)(Rb * J.ldb + C) * 2u; }
    const unsigned kstep = (unsigned)(BK * 2);
    const unsigned hstepA = (unsigned)HALF * J.lda * 2, hstepB = (unsigned)HALF * J.ldb * 2;
    const unsigned tstepA = 2 * hstepA, tstepB = 2 * hstepB;
    const __amdgpu_buffer_rsrc_t rsA = __builtin_amdgcn_make_buffer_rsrc((void*)J.A, 0, 0x7fffffff, 0x00020000);
    const __amdgpu_buffer_rsrc_t rsB = __builtin_amdgcn_make_buffer_rsrc((void*)J.Bt, 0, 0x7fffffff, 0x00020000);
    const unsigned ldsw = (unsigned)wid * 1024u;
    const int aoff = lds_byte(wr * 64 + fr, fq * 8), boff = lds_byte(wc * 32 + fr, fq * 8);
#define PG8_SA(b, h) (((b) * 2 + (h)) * HTB)
#define PG8_SB(b, h) ((4 + (b) * 2 + (h)) * HTB)
#define PG8_STAGE(bufoff, goff, voff) do { _Pragma("unroll") for (int _i = 0; _i < 2; ++_i) \
        __builtin_amdgcn_raw_ptr_buffer_load_lds(PG8_RS_##voff, (LAS unsigned*)(lds + (bufoff) + ldsw + _i * 8192), 16, (voff)[_i], (goff), 0, 0); } while (0)
#define PG8_RS_voffA rsA
#define PG8_RS_voffB rsB
#define PG8_LDA(dst, b, h) do { _Pragma("unroll") for (int m = 0; m < 4; ++m) _Pragma("unroll") for (int k = 0; k < 2; ++k) dst[m][k] = *(const LAS bf16x8*)(lds + PG8_SA(b, h) + aoff + m * 2048 + k * 1024); } while (0)
#define PG8_LDB(dst, b, h) do { _Pragma("unroll") for (int n = 0; n < 2; ++n) _Pragma("unroll") for (int k = 0; k < 2; ++k) dst[n][k] = *(const LAS bf16x8*)(lds + PG8_SB(b, h) + boff + n * 2048 + k * 1024); } while (0)
#define PG8_MMA(ai, bj, At, Bt) do { __builtin_amdgcn_s_setprio(1); _Pragma("unroll") for (int m = 0; m < 4; ++m) _Pragma("unroll") for (int n = 0; n < 2; ++n) _Pragma("unroll") for (int k = 0; k < 2; ++k) \
        acc[ai][bj][m][n] = __builtin_amdgcn_mfma_f32_16x16x32_bf16(Bt[n][k], At[m][k], acc[ai][bj][m][n], 0, 0, 0); __builtin_amdgcn_s_setprio(0); } while (0)
#define PG8_WAIT_V(n) asm volatile("s_waitcnt vmcnt(" #n ")" ::: "memory")
#define PG8_WAIT_L(n) asm volatile("s_waitcnt lgkmcnt(" #n ")" ::: "memory")
#define PG8_BAR __builtin_amdgcn_s_barrier()
#define PG8_SCHED __builtin_amdgcn_sched_barrier(0)
    Unit cur, nxt; int ui = 0;
    if (!S.next(0, cur)) return;
    f32x4 acc[2][2][4][2];
#pragma unroll
    for (int a = 0; a < 2; ++a)
#pragma unroll
        for (int b = 0; b < 2; ++b)
#pragma unroll
            for (int m = 0; m < 4; ++m)
#pragma unroll
                for (int n = 0; n < 2; ++n) acc[a][b][m][n] = (f32x4){0.f, 0.f, 0.f, 0.f};
    bf16x8 At[4][2], B0[2][2], B1[2][2];
    u64 ssr[2][4];
#define PG8_SSLD(U) do { if (J.ss_in) { const u64* sp_ = J.ss_in + (U).pm * BM + wr * 64 + fr; _Pragma("unroll") for (int ai_ = 0; ai_ < 2; ++ai_) _Pragma("unroll") for (int m_ = 0; m_ < 4; ++m_) ssr[ai_][m_] = sp_[ai_ * HALF + m_ * 16]; } \
        else { _Pragma("unroll") for (int ai_ = 0; ai_ < 2; ++ai_) _Pragma("unroll") for (int m_ = 0; m_ < 4; ++m_) ssr[ai_][m_] = 0ull; } } while (0)
    PG8_SSLD(cur);
    unsigned cA = (unsigned)cur.pm * tstepA + (unsigned)cur.pn * J.a_pn_step * 2; unsigned cB = (unsigned)cur.pn * tstepB;
    PG8_STAGE(PG8_SB(0, 0), cB, voffB); PG8_STAGE(PG8_SB(0, 1), cB + hstepB, voffB); PG8_STAGE(PG8_SA(0, 0), cA, voffA); PG8_STAGE(PG8_SA(0, 1), cA + hstepA, voffA);
    if (wr == 1) PG8_BAR;
    PG8_WAIT_V(2); PG8_BAR;
    PG8_STAGE(PG8_SB(1, 0), cB + kstep, voffB); PG8_STAGE(PG8_SA(1, 0), cA + kstep, voffA); PG8_STAGE(PG8_SB(1, 1), cB + hstepB + kstep, voffB);
    PG8_WAIT_V(6); PG8_BAR;
    for (;;) {
        const bool has_next = S.next(ui + 1, nxt);
        const unsigned nA = has_next ? (unsigned)nxt.pm * tstepA + (unsigned)nxt.pn * J.a_pn_step * 2 : cA; const unsigned nB = has_next ? (unsigned)nxt.pn * tstepB : cB;
        for (int t = 0; t < nt; t += 2) {
            const bool last = (t == nt - 2);
            const unsigned a1 = cA + (unsigned)(t + 1) * kstep;
            const unsigned a2 = last ? nA : cA + (unsigned)(t + 2) * kstep; const unsigned b2 = last ? nB : cB + (unsigned)(t + 2) * kstep;
            const unsigned a3 = a2 + kstep; const unsigned b3 = b2 + kstep;
            PG8_LDB(B0, 0, 0); PG8_LDB(B1, 0, 1); PG8_SCHED; PG8_LDA(At, 0, 0); PG8_STAGE(PG8_SA(1, 1), a1 + hstepA, voffA);
            PG8_WAIT_V(8); PG8_WAIT_L(0); PG8_BAR; PG8_MMA(0, 0, At, B0); PG8_MMA(0, 1, At, B1); PG8_BAR; PG8_SCHED;
            PG8_LDA(At, 0, 1); PG8_STAGE(PG8_SB(0, 0), b2, voffB); PG8_STAGE(PG8_SB(0, 1), b2 + hstepB, voffB); PG8_STAGE(PG8_SA(0, 0), a2, voffA);
            PG8_WAIT_V(8); PG8_WAIT_L(0); PG8_BAR; PG8_MMA(1, 0, At, B0); PG8_MMA(1, 1, At, B1); PG8_BAR; PG8_SCHED;
            PG8_LDB(B0, 1, 0); PG8_LDB(B1, 1, 1); PG8_SCHED; PG8_LDA(At, 1, 0); PG8_STAGE(PG8_SA(0, 1), a2 + hstepA, voffA);
            PG8_WAIT_V(8); PG8_WAIT_L(0); PG8_BAR; PG8_MMA(0, 0, At, B0); PG8_MMA(0, 1, At, B1); PG8_BAR; PG8_SCHED;
            PG8_LDA(At, 1, 1); PG8_STAGE(PG8_SB(1, 0), b3, voffB); PG8_STAGE(PG8_SB(1, 1), b3 + hstepB, voffB); PG8_STAGE(PG8_SA(1, 0), a3, voffA);
            PG8_WAIT_V(8); PG8_WAIT_L(0); PG8_BAR; PG8_MMA(1, 0, At, B0); PG8_MMA(1, 1, At, B1); PG8_BAR; PG8_SCHED;
        }
        if (wr == 0) PG8_BAR;
        run_epi(J, acc, cur, wr, wc, fr, fq, ssr);
        if (!has_next) break;
        PG8_SSLD(nxt);
#pragma unroll
        for (int a = 0; a < 2; ++a)
#pragma unroll
            for (int b = 0; b < 2; ++b)
#pragma unroll
                for (int m = 0; m < 4; ++m)
#pragma unroll
                    for (int n = 0; n < 2; ++n) acc[a][b][m][n] = (f32x4){0.f, 0.f, 0.f, 0.f};
        cur = nxt; cA = nA; cB = nB; ++ui;
        if (wr == 1) PG8_BAR;
    }
    PG8_WAIT_V(0);
    PG8_BAR;
#undef PG8_SA
#undef PG8_SB
#undef PG8_STAGE
#undef PG8_SSLD
#undef PG8_RS_voffA
#undef PG8_RS_voffB
#undef PG8_LDA
#undef PG8_LDB
#undef PG8_MMA
#undef PG8_WAIT_V
#undef PG8_WAIT_L
#undef PG8_BAR
#undef PG8_SCHED
}
}

struct Args { const float* in[29]; float* out; unsigned char* ws; int ph_lo, ph_hi; };
typedef const __attribute__((address_space(4))) Args* ArgsP;
enum { I_X = 0, I_P, I_ATTN_NORM, I_W_IN, I_MU_SHIFT, I_W_VRES_DN, I_MU_VRES, I_V0, I_V_UP, I_POOL_W, I_POOL_SCALE, I_W0, I_W_UP, I_A0, I_A_UP, I_G_UP,
       I_K_K, I_K_A, I_R_K, I_GN_G, I_GN_B, I_W_OUT, I_MLP_NORM, I_W_FFN_UP, I_W_FFN_DOWN, I_PLE_NORM, I_W_PLE_GATE, I_W_PLE_PROJ, I_FINAL_NORM };

__device__ __forceinline__ void p0_transpose_item(const float* W, int N, bf16_t* WT, int ldd, int row_off, LAS float* scr, int item, int nblk, int lane, const float* gs) {
    const int kb = item / nblk, nb = item % nblk, k0 = 64 * kb, n0 = 32 * nb;
    const int c = lane & 7;
    f32x4 g0 = {1.f, 1.f, 1.f, 1.f}, g1 = {1.f, 1.f, 1.f, 1.f};
    if (gs) { g0 = *(const f32x4*)(gs + k0 + 8 * c); g1 = *(const f32x4*)(gs + k0 + 8 * c + 4); }
#pragma unroll
    for (int hb = 0; hb < 2; ++hb) {
        float wv[16];
#pragma unroll
        for (int i = 0; i < 16; ++i) { const int kk = 2 * (16 * hb + i) + (lane >> 5); wv[i] = W[(size_t)(k0 + kk) * N + n0 + (lane & 31)]; }
#pragma unroll
        for (int i = 0; i < 16; ++i) { const int kk = 2 * (16 * hb + i) + (lane >> 5); scr[kk * 33 + (lane & 31)] = wv[i]; }
    }
    asm volatile("s_waitcnt lgkmcnt(0)" ::: "memory");
#pragma unroll
    for (int j = 0; j < 4; ++j) { const int n = (lane >> 3) + 8 * j; const LAS float* s = scr + (8 * c) * 33 + n;
        v4u o; o.x = cvt_pk_bf16(s[0 * 33] * g0[0], s[1 * 33] * g0[1]); o.y = cvt_pk_bf16(s[2 * 33] * g0[2], s[3 * 33] * g0[3]); o.z = cvt_pk_bf16(s[4 * 33] * g1[0], s[5 * 33] * g1[1]); o.w = cvt_pk_bf16(s[6 * 33] * g1[2], s[7 * 33] * g1[3]);
        *(v4u*)(WT + (size_t)(row_off + n0 + n) * ldd + k0 + 8 * c) = o; }
    asm volatile("s_waitcnt lgkmcnt(0)" ::: "memory");
}
__device__ __forceinline__ void cvt_job(const float* W, int K, int N, bf16_t* WT, int ldd, int row_off, LAS float* scr, int gw, int NW, int lane, const float* gs = nullptr) {
    const int nblk = N / 32, nit = (K / 64) * nblk;
    for (int it = gw; it < nit; it += NW) p0_transpose_item(W, N, WT, ldd, row_off, scr, it, nblk, lane, gs);
}
__device__ __forceinline__ void phase_convert(ArgsP a, LAS unsigned char* lds, const int tid, const int bx) {
    const int lane = tid & 63, wave = tid >> 6, G = gridDim.x;
    const int gw = bx * 8 + wave, NW = G * 8; const size_t gt = (size_t)bx * 512 + tid, NT = (size_t)G * 512;
    LAS float* scr = (LAS float*)(lds + wave * 8448);
    unsigned char* ws = a->ws;
    for (int l = 0; l < DEPTH; ++l) {
        bf16_t* win = (bf16_t*)(ws + WS_WIN) + (size_t)l * NZ * DM;
        cvt_job(a->in[I_W_IN] + (size_t)l * DM * INW, DM, INW, win, DM, 0, scr, gw, NW, lane, a->in[I_ATTN_NORM] + (size_t)l * DM);
        if (l > 0) cvt_job(a->in[I_W_VRES_DN] + (size_t)(l - 1) * DM * 32, DM, 32, win, DM, INW, scr, gw, NW, lane, a->in[I_ATTN_NORM] + (size_t)l * DM);
        { const int r0 = (l == 0) ? INW : INW + 32; const size_t n16 = (size_t)(NZ - r0) * DM / 8; v4u* z = (v4u*)(win + (size_t)r0 * DM);
          for (size_t i = gt; i < n16; i += NT) z[i] = (v4u){0u, 0u, 0u, 0u}; }
        cvt_job(a->in[I_W_OUT] + (size_t)l * DM * DM, DM, DM, (bf16_t*)(ws + WS_WOUT) + (size_t)l * DM * DM, DM, 0, scr, gw, NW, lane);
        cvt_job(a->in[I_W_FFN_UP] + (size_t)l * DM * DFF, DM, DFF, (bf16_t*)(ws + WS_WUP) + (size_t)l * DFF * DM, DM, 0, scr, gw, NW, lane, a->in[I_MLP_NORM] + (size_t)l * DM);
        cvt_job(a->in[I_W_FFN_DOWN] + (size_t)l * DFF * DM, DFF, DM, (bf16_t*)(ws + WS_WDN) + (size_t)l * DM * DFF, DFF, 0, scr, gw, NW, lane);
        cvt_job(a->in[I_W_PLE_GATE] + (size_t)l * DM * DM, DM, DM, (bf16_t*)(ws + WS_WGATE) + (size_t)l * DM * DM, DM, 0, scr, gw, NW, lane, a->in[I_PLE_NORM] + (size_t)l * DM);
        cvt_job(a->in[I_W_PLE_PROJ] + (size_t)l * DPLE * DM, DPLE, DM, (bf16_t*)(ws + WS_WPROJ) + (size_t)l * DM * DPLE, DPLE, 0, scr, gw, NW, lane);
        for (int gi = 0; gi < 4; ++gi)
            cvt_job(a->in[I_POOL_W] + ((size_t)l * 4 + gi) * 256 * 256, 256, 256, (bf16_t*)(ws + WS_WPOOL) + (size_t)l * 1024 * 256, 256, gi * 256, scr, gw, NW, lane);
        { bf16_t* wl = (bf16_t*)(ws + WS_WLORA) + (size_t)l * 4096 * KL;
          const float* wu = a->in[I_W_UP] + (size_t)l * 64 * RW; const float* au = a->in[I_A_UP] + (size_t)l * 64 * RW; const float* gu = a->in[I_G_UP] + (size_t)l * 160 * RW;
          const float* vu = a->in[I_V_UP] + (size_t)(l > 0 ? l - 1 : 0) * 32 * RW;
          for (size_t idx = gt; idx < (size_t)4096 * KL; idx += NT) { const int n = (int)(idx / KL), k = (int)(idx % KL), t = n >> 10, col = n & 1023; float v = 0.f;
              if (t == 0) { if (k < 64) v = wu[(size_t)k * RW + col]; }
              else if (t == 1) { if (k >= 64 && k < 128) v = au[(size_t)(k - 64) * RW + col]; }
              else if (t == 2) { if (k >= 128 && k < 288) v = gu[(size_t)(k - 128) * RW + col]; }
              else { if (l > 0 && k >= 288 && k < 320) v = vu[(size_t)(k - 288) * RW + col]; }
              wl[idx] = (bf16_t)(cvt_pk_bf16(v, 0.f) & 0xffffu); } }
    }
    { u64* SS = (u64*)(ws + WS_SS); bf16_t* XP = (bf16_t*)(ws + WS_H); const float* x = a->in[I_X];
      for (size_t i = gt; i < (size_t)12 * M; i += NT) SS[M + i] = 0ull;
      for (int row = gw; row < M; row += NW) {
          const f32x4* xr = (const f32x4*)(x + (size_t)row * DM) + lane; float s = 0.f;
#pragma unroll
          for (int j = 0; j < 8; ++j) { const f32x4 v = xr[64 * j]; s += (v[0] * v[0] + v[1] * v[1]) + (v[2] * v[2] + v[3] * v[3]);
              v2u w; w.x = cvt_pk_bf16(v[0], v[1]); w.y = cvt_pk_bf16(v[2], v[3]); ((v2u*)(XP + (size_t)row * DM))[lane + 64 * j] = w; }
          s = wave_sum(s); if (lane == 0) SS[row] = (u64)(s * SS_SCALE); } }
    { const float* p = a->in[I_P]; bf16_t* pb = (bf16_t*)(ws + WS_PB); const size_t n8 = (size_t)DEPTH * M * DPLE / 8;
      for (size_t i = gt; i < n8; i += NT) { const f32x8 v = ld8f(p + i * 8); *(v4u*)(pb + i * 8) = pk8(v); } }
}

template <int WIN> __device__ __forceinline__ v4u pool_diff(const bf16_t* zp, int tpos) {
    const f32x8 u = up8(*(const v4u*)zp);
    v4u raw[WIN - 1];
#pragma unroll
    for (int q = 1; q < WIN; ++q) raw[q - 1] = *(const v4u*)(zp - (size_t)((q <= tpos) ? q : 0) * NZ);
    f32x8 s = u;
#pragma unroll
    for (int q = 1; q < WIN; ++q) { const float msk = (q <= tpos) ? 1.0f : 0.0f; s = s + up8(raw[q - 1]) * msk; }
    const int cnt = (tpos + 1 < WIN) ? tpos + 1 : WIN;
    return pk8(s * (1.0f / (float)cnt) - u);
}
__device__ __forceinline__ void phase_prepa(ArgsP a, int l, const int tid, const int bx) {
    const int G = gridDim.x;
    const bf16_t* Z = (const bf16_t*)(a->ws + WS_Z); bf16_t* DP = (bf16_t*)(a->ws + WS_DPOOL); bf16_t* AL = (bf16_t*)(a->ws + WS_ALORA);
    const float* mus = a->in[I_MU_SHIFT] + (size_t)l * SHIFTW; const float* muv = a->in[I_MU_VRES] + (size_t)(l > 0 ? l - 1 : 0) * 32;
    const int wave = __builtin_amdgcn_readfirstlane(tid >> 6), lane = tid & 63;
    const int gi = wave & 3, prow = (wave >> 2) * 2 + (lane >> 5), pcol = gi * 256 + 8 * (lane & 31);
    const int arow = tid / 48, acol = 8 * (tid % 48);
    for (int unit = bx; unit < M / 4; unit += G) {
        { const int row = unit * 4 + prow, tpos = row & (SEQ - 1);
          const bf16_t* zp = Z + (size_t)row * NZ + pcol; v4u d;
          if (gi == 0) d = pool_diff<2>(zp, tpos); else if (gi == 1) d = pool_diff<4>(zp, tpos); else if (gi == 2) d = pool_diff<8>(zp, tpos); else d = pool_diff<16>(zp, tpos);
          *(v4u*)(DP + (size_t)row * RW + pcol) = d; }
        if (tid < 192) {
            const int row = unit * 4 + arow, tpos = row & (SEQ - 1), c = acol; f32x8 o;
#pragma unroll
            for (int j = 0; j < 8; ++j) o[j] = 0.f;
            if (c < 288 || (c < 320 && l > 0)) {
                const bf16_t* zp = Z + (size_t)row * NZ + 4096 + c;
                const f32x8 zc = up8(*(const v4u*)zp); f32x8 zq;
                if (tpos > 0) zq = up8(*(const v4u*)(zp - NZ)); else {
#pragma unroll
                    for (int j = 0; j < 8; ++j) zq[j] = 0.f; }
                const f32x8 mu = (c < 288) ? ld8f(mus + 3072 + c) : ld8f(muv + (c - 288));
                const f32x8 zs = zc + (zq - zc) * mu;
                if (c < 64) {
#pragma unroll
                    for (int j = 0; j < 8; ++j) o[j] = 1.0f - 2.0f * __builtin_amdgcn_rcpf(1.0f + __expf(2.0f * zs[j])); }
                else if (c >= 128 && c < 288) {
#pragma unroll
                    for (int j = 0; j < 8; ++j) o[j] = sigm(zs[j]); }
                else o = zs;
            }
            *(v4u*)(AL + (size_t)row * KL + c) = pk8(o);
        }
    }
}

constexpr int TC = 32, STEPB = 1344, BUFB = TC * STEPB, YBB = TC * 16 * 4;
struct ScanRaw { v4u zr, zrp, zk, zkp, zv, zvp, ld, aa, vg, vf; };
__device__ __forceinline__ void scan_unit(ArgsP a, int l, int u, LAS unsigned char* lds, const int tid) {
    const int wave = __builtin_amdgcn_readfirstlane(tid >> 6), lane = tid & 63;
    const int bh = u >> 2, rg = u & 3, b = bh >> 4, h = bh & 15;
    const bool hasv = l > 0;
    constexpr int NC = SEQ / TC;
    const size_t rowbase = (size_t)b * SEQ;
    if (wave < 4) {
        const int rowl = 4 * wave + (lane >> 4), j = lane & 15;
        f32x2 s01 = {0.f, 0.f}, s23 = {0.f, 0.f};
        for (int c = 0; c < NC; ++c) {
            __syncthreads();
            const LAS unsigned char* buf = lds + (c & 1) * BUFB + 16 * j;
            const LAS unsigned char* vb = lds + (c & 1) * BUFB + 1280 + 4 * rowl;
            LAS float* yb = (LAS float*)(lds + 2 * BUFB + (c & 1) * YBB) + rowl + (15 - j) * 16;
            f32x4 R[3], W[3], K[3], A[3], B[3]; float V[3];
#define SC_LD(sl, tl) do { R[sl] = *(const LAS f32x4*)(buf + (tl) * STEPB); W[sl] = *(const LAS f32x4*)(buf + (tl) * STEPB + 256); K[sl] = *(const LAS f32x4*)(buf + (tl) * STEPB + 512); \
                A[sl] = *(const LAS f32x4*)(buf + (tl) * STEPB + 768); B[sl] = *(const LAS f32x4*)(buf + (tl) * STEPB + 1024); V[sl] = *(const LAS float*)(vb + (tl) * STEPB); } while (0)
            SC_LD(0, 0); SC_LD(1, 1);
            float yprev = 0.f, ysel = 0.f;
#pragma unroll
            for (int i = 0; i < TC; ++i) {
                const int sl = i % 3;
                if (i + 2 < TC) SC_LD((i + 2) % 3, i + 2);
                const f32x2 vv = {V[sl], V[sl]};
                f32x2 pp = s01 * (f32x2){A[sl][0], A[sl][1]}; pp = s23 * (f32x2){A[sl][2], A[sl][3]} + pp;
                float p = pp[0] + pp[1];
                f32x2 t01 = vv * (f32x2){K[sl][0], K[sl][1]}, t23 = vv * (f32x2){K[sl][2], K[sl][3]};
                t01 = s01 * (f32x2){W[sl][0], W[sl][1]} + t01; t23 = s23 * (f32x2){W[sl][2], W[sl][3]} + t23;
                if (i > 0) {
                    p += dpp1<0x128>(p); yprev += dpp1<0x128>(yprev);
                    p += dpp1<0x124>(p); yprev += dpp1<0x124>(yprev);
                    p += dpp1<0x122>(p); yprev += dpp1<0x122>(yprev);
                    p += dpp1<0x121>(p); yprev += dpp1<0x121>(yprev);
                    ysel = __builtin_bit_cast(float, __builtin_amdgcn_update_dpp(__builtin_bit_cast(int, yprev), __builtin_bit_cast(int, ysel), 0x111, 0xF, 0xF, false));
                    if ((i & 15) == 0) yb[((i >> 4) - 1) * 256] = ysel;
                } else {
                    p += dpp1<0x128>(p); p += dpp1<0x124>(p); p += dpp1<0x122>(p); p += dpp1<0x121>(p);
                }
                const f32x2 pv = {p, p};
                s01 = pv * (f32x2){B[sl][0], B[sl][1]} + t01; s23 = pv * (f32x2){B[sl][2], B[sl][3]} + t23;
                f32x2 yy = s01 * (f32x2){R[sl][0], R[sl][1]}; yy = s23 * (f32x2){R[sl][2], R[sl][3]} + yy;
                yprev = yy[0] + yy[1];
            }
            yprev += dpp1<0x128>(yprev); yprev += dpp1<0x124>(yprev); yprev += dpp1<0x122>(yprev); yprev += dpp1<0x121>(yprev);
            ysel = __builtin_bit_cast(float, __builtin_amdgcn_update_dpp(__builtin_bit_cast(int, yprev), __builtin_bit_cast(int, ysel), 0x111, 0xF, 0xF, false));
            yb[(TC / 16 - 1) * 256] = ysel;
#undef SC_LD
        }
        __syncthreads();
    } else {
        const int ltid = tid - 256, tl = ltid >> 3, cgp = ltid & 7;
        const int col0 = h * HS + 8 * cgp;
        const bf16_t* Z = (const bf16_t*)(a->ws + WS_Z); const bf16_t* PL = (const bf16_t*)(a->ws + WS_PLANES); const bf16_t* VF = (const bf16_t*)(a->ws + WS_VFIRST);
        bf16_t* Y = (bf16_t*)(a->ws + WS_DPOOL);
        const float* mus = a->in[I_MU_SHIFT] + (size_t)l * SHIFTW;
        const f32x8 mur = ld8f(mus + col0), muk = ld8f(mus + 1024 + col0), muv = ld8f(mus + 2048 + col0);
        const f32x8 kkc = ld8f(a->in[I_K_K] + (size_t)l * RW + col0), kac = ld8f(a->in[I_K_A] + (size_t)l * RW + col0);
        const bool vmine = (cgp >> 1) == rg;
#define SCAN_LOAD(R, cc) do { const int t_ = (cc) * TC + tl; const size_t row_ = rowbase + t_; const size_t rowp_ = (t_ > 0) ? row_ - 1 : row_; \
            const bf16_t* z_ = Z + row_ * NZ + col0; const bf16_t* zq_ = Z + rowp_ * NZ + col0; \
            R.zr = *(const v4u*)(z_ + 1024); R.zk = *(const v4u*)(z_ + 2048); R.zv = *(const v4u*)(z_ + 3072); \
            R.zrp = *(const v4u*)(zq_ + 1024); R.zkp = *(const v4u*)(zq_ + 2048); R.zvp = *(const v4u*)(zq_ + 3072); \
            R.ld = *(const v4u*)(PL + row_ * RW + col0); R.aa = *(const v4u*)(PL + PLANE + row_ * RW + col0); \
            if (hasv) { R.vg = *(const v4u*)(PL + 3 * PLANE + row_ * RW + col0); R.vf = *(const v4u*)(VF + row_ * RW + col0); } else { R.vg = R.ld; R.vf = R.ld; } } while (0)
#define SCAN_FLUSH(cc) do { const LAS float* yb_ = (const LAS float*)(lds + 2 * BUFB + ((cc) & 1) * YBB) + tl * 16 + 2 * cgp; \
            const unsigned w_ = cvt_pk_bf16(yb_[0], yb_[1]); *(unsigned*)(Y + (rowbase + (size_t)(cc) * TC + tl) * RW + h * HS + 16 * rg + 2 * cgp) = w_; } while (0)
        ScanRaw nx; SCAN_LOAD(nx, 0);
        for (int c = 0; c < NC; ++c) {
            const ScanRaw cu = nx;
            if (c + 1 < NC) SCAN_LOAD(nx, c + 1);
            const int t = c * TC + tl;
            const f32x8 zr = up8(cu.zr), zk = up8(cu.zk), zv = up8(cu.zv);
            f32x8 zrp = up8(cu.zrp), zkp = up8(cu.zkp), zvp = up8(cu.zvp);
            if (t == 0) {
#pragma unroll
                for (int q = 0; q < 8; ++q) { zrp[q] = 0.f; zkp[q] = 0.f; zvp[q] = 0.f; } }
            const f32x8 r = zr + (zrp - zr) * mur, k = zk + (zkp - zk) * muk; f32x8 v = zv + (zvp - zv) * muv;
            const f32x8 ld = up8(cu.ld), av = up8(cu.aa);
            if (hasv) v = v + (up8(cu.vf) - v) * up8(cu.vg);
            const f32x8 kk = k * kkc;
            float n2 = sum8(kk * kk); n2 += __shfl_xor(n2, 1); n2 += __shfl_xor(n2, 2); n2 += __shfl_xor(n2, 4);
            const float inv = 1.0f / fmaxf(sqrtf(n2), 1e-12f);
            const f32x8 kkn = kk * inv;
            const f32x8 kadj = k * (1.0f + (av - 1.0f) * kac);
            f32x8 dec;
#pragma unroll
            for (int q = 0; q < 8; ++q) dec[q] = __expf(ld[q]);
            const f32x8 avec = -kkn, bvec = kkn * av;
            LAS unsigned char* dst = lds + (c & 1) * BUFB + tl * STEPB + cgp * 32;
#define ST8(off, val) do { *(LAS f32x4*)(dst + (off)) = (f32x4){val[0], val[1], val[2], val[3]}; *(LAS f32x4*)(dst + (off) + 16) = (f32x4){val[4], val[5], val[6], val[7]}; } while (0)
            ST8(0, r); ST8(256, dec); ST8(512, kadj); ST8(768, avec); ST8(1024, bvec);
            if (vmine) { LAS unsigned char* dv = lds + (c & 1) * BUFB + tl * STEPB + 1280 + (cgp & 1) * 32;
                *(LAS f32x4*)(dv) = (f32x4){v[0], v[1], v[2], v[3]}; *(LAS f32x4*)(dv + 16) = (f32x4){v[4], v[5], v[6], v[7]}; }
#undef ST8
            if (c >= 2) SCAN_FLUSH(c - 2);
            __syncthreads();
        }
        __syncthreads();
        SCAN_FLUSH(NC - 2); SCAN_FLUSH(NC - 1);
#undef SCAN_LOAD
#undef SCAN_FLUSH
    }
    __syncthreads();
}

__device__ __forceinline__ void phase_post(ArgsP a, int l, const int tid, const int bx) {
    const int lane = tid & 63, wave = tid >> 6; const int gw = bx * 8 + wave, NW = gridDim.x * 8;
    const bf16_t* Z = (const bf16_t*)(a->ws + WS_Z); const bf16_t* PL = (const bf16_t*)(a->ws + WS_PLANES); bf16_t* VF = (bf16_t*)(a->ws + WS_VFIRST);
    const bf16_t* Y = (const bf16_t*)(a->ws + WS_DPOOL); bf16_t* MIX = (bf16_t*)(a->ws + WS_MIX);
    const float* mus = a->in[I_MU_SHIFT] + (size_t)l * SHIFTW;
    const bool hasv = l > 0;
    for (int it = gw; it < M * 2; it += NW) {
        const int row = it >> 1, h = (it & 1) * 8 + (lane >> 3), col = h * HS + 8 * (lane & 7), tpos = row & (SEQ - 1);
        const bf16_t* z = Z + (size_t)row * NZ + col; const bf16_t* zq = (tpos > 0) ? z - NZ : z;
        const f32x8 zr = up8(*(const v4u*)(z + 1024)), zk = up8(*(const v4u*)(z + 2048)), zv = up8(*(const v4u*)(z + 3072));
        f32x8 zrp = up8(*(const v4u*)(zq + 1024)), zkp = up8(*(const v4u*)(zq + 2048)), zvp = up8(*(const v4u*)(zq + 3072));
        if (tpos == 0) {
#pragma unroll
            for (int q = 0; q < 8; ++q) { zrp[q] = 0.f; zkp[q] = 0.f; zvp[q] = 0.f; } }
        const f32x8 r = zr + (zrp - zr) * ld8f(mus + col), k = zk + (zkp - zk) * ld8f(mus + 1024 + col); f32x8 v = zv + (zvp - zv) * ld8f(mus + 2048 + col);
        const size_t po = (size_t)row * RW + col;
        const f32x8 av = up8(*(const v4u*)(PL + PLANE + po)), gg = up8(*(const v4u*)(PL + 2 * PLANE + po));
        if (hasv) v = v + (up8(*(const v4u*)(VF + po)) - v) * up8(*(const v4u*)(PL + 3 * PLANE + po));
        else *(v4u*)(VF + po) = pk8(v);
        const f32x8 kadj = k * (1.0f + (av - 1.0f) * ld8f(a->in[I_K_A] + (size_t)l * RW + col));
        float bonus = sum8(r * kadj * ld8f(a->in[I_R_K] + (size_t)l * RW + col));
        bonus += __shfl_xor(bonus, 1); bonus += __shfl_xor(bonus, 2); bonus += __shfl_xor(bonus, 4);
        const f32x8 y = up8(*(const v4u*)(Y + po));
        float sm = sum8(y); sm += __shfl_xor(sm, 1); sm += __shfl_xor(sm, 2); sm += __shfl_xor(sm, 4);
        const float mean = sm * (1.0f / 64.0f);
        const f32x8 d = y - mean;
        float vs = sum8(d * d); vs += __shfl_xor(vs, 1); vs += __shfl_xor(vs, 2); vs += __shfl_xor(vs, 4);
        const float rstd = rsqrtf(vs * (1.0f / 64.0f) + GN_EPS);
        const f32x8 o = (d * rstd * ld8f(a->in[I_GN_G] + (size_t)l * RW + col) + ld8f(a->in[I_GN_B] + (size_t)l * RW + col) + bonus * v) * gg;
        *(v4u*)(MIX + (size_t)row * DM + 1024 + col) = pk8(o);
    }
}

#define XB_TMO      128
#define XB_XCNT(j)  (256  + 64 * (j))
#define XB_XSUB(j)  (1280 + 64 * (j))
#define XB_XGEN(j)  (2304 + 64 * (j))
#define XB_TOP      3328
#define XB_TOPGEN   3392
#define XCD_BAR_WORDS 3456
#define XB_SPIN_CAP (1u << 18)

__device__ __forceinline__ unsigned xb_ld(unsigned* p)              { return __hip_atomic_load(p, __ATOMIC_RELAXED, __HIP_MEMORY_SCOPE_AGENT); }
__device__ __forceinline__ unsigned xb_add(unsigned* p, unsigned v) { return __hip_atomic_fetch_add(p, v, __ATOMIC_RELAXED, __HIP_MEMORY_SCOPE_AGENT); }
__device__ __forceinline__ unsigned xb_xcc_id() { return (unsigned)__builtin_amdgcn_s_getreg((3 << 11) | 20) & 0xFu; }
#define XB_SPIN(cond, bar) do { unsigned _sp = 0; while (cond) { __builtin_amdgcn_s_sleep(1); \
    if ((++_sp & 255u) == 0u) { if (xb_ld(&(bar)[XB_TMO])) break; if (_sp > XB_SPIN_CAP) { atomicAdd(&(bar)[XB_TMO], 1u); break; } } } } while (0)

struct XcdBarrier {
    unsigned* bar; unsigned x;
    volatile LAS unsigned* st;
};

__device__ __forceinline__ XcdBarrier xcd_barrier_post(unsigned* bar, volatile LAS unsigned* st) {
    XcdBarrier b; b.bar = bar; b.x = xb_xcc_id(); b.st = st;
    if (threadIdx.x == 0) (void)xb_add(&bar[XB_XCNT(b.x)], 1u);
    return b;
}
__device__ __forceinline__ void xcd_barrier_complete(unsigned* bar, unsigned x, unsigned& nloc, unsigned& nx) {
    const unsigned G = gridDim.x * gridDim.y * gridDim.z;
    unsigned sum, cnt, mine, sp = 0u;
    for (;;) {
        sum = 0u; cnt = 0u; mine = 0u;
#pragma unroll
        for (unsigned j = 0; j < 16; ++j) { const unsigned c = xb_ld(&bar[XB_XCNT(j)]); sum += c; cnt += (c > 0u) ? 1u : 0u; mine = (j == x) ? c : mine; }
        if (sum == G) break;
        __builtin_amdgcn_s_sleep(1);
        if ((++sp & 255u) == 0u) { if (xb_ld(&bar[XB_TMO])) break; if (sp > XB_SPIN_CAP) { atomicAdd(&bar[XB_TMO], 1u); break; } }
    }
    nloc = mine > 0u ? mine : 1u; nx = cnt > 0u ? cnt : 1u;
}

__device__ __forceinline__ void xcd_barrier(const XcdBarrier& b) {
    asm volatile("s_waitcnt vmcnt(0)" ::: "memory");
    __syncthreads();
    if (threadIdx.x == 0) {
        unsigned* bar = b.bar;
        __builtin_amdgcn_s_waitcnt(0);
        unsigned nloc = b.st[0], nx = b.st[1];
        if (nloc == 0u) { xcd_barrier_complete(bar, b.x, nloc, nx); b.st[0] = nloc; b.st[1] = nx; }
        const unsigned old = xb_add(&bar[XB_XSUB(b.x)], 1u);
        const unsigned gen = old / nloc;
        if (old + 1u == (gen + 1u) * nloc) {
            __builtin_amdgcn_fence(__ATOMIC_RELEASE, "agent");
            asm volatile("s_waitcnt vmcnt(0)" ::: "memory");
            const unsigned og = xb_add(&bar[XB_TOP], 1u);
            const unsigned tg = og / nx;
            if (og + 1u == (tg + 1u) * nx) xb_add(&bar[XB_TOPGEN], 1u);
            else XB_SPIN(xb_ld(&bar[XB_TOPGEN]) == tg, bar);
            __builtin_amdgcn_fence(__ATOMIC_ACQUIRE, "agent");
            xb_add(&bar[XB_XGEN(b.x)], 1u);
            asm volatile("s_waitcnt vmcnt(0)" ::: "memory");
        } else {
            XB_SPIN(xb_ld(&bar[XB_XGEN(b.x)]) == gen, bar);
            __builtin_amdgcn_fence(__ATOMIC_ACQUIRE, "agent");
            asm volatile("s_waitcnt vmcnt(0)" ::: "memory");
        }
    }
    __syncthreads();
}


constexpr int N_PHASES = 2 + 9 * DEPTH;
__device__ __forceinline__ bool make_job(ArgsP a, int l, int s, int q, pg8::Job& J) {
    unsigned char* ws = a->ws; u64* SS = (u64*)(ws + WS_SS);
    bf16_t* XC = (bf16_t*)(ws + ((l & 1) ? WS_XQ : WS_H)); bf16_t* XN = (bf16_t*)(ws + ((l & 1) ? WS_H : WS_XQ));
    bf16_t* MIX = (bf16_t*)(ws + WS_MIX); bf16_t* PP = (bf16_t*)(ws + WS_MIX);
    J.a_pn_step = 0; J.nM = M / 256; J.O = nullptr; J.ldc = DM; J.c0 = nullptr; J.c1 = nullptr; J.c2 = nullptr; J.base = nullptr; J.out = nullptr; J.pp = nullptr; J.ss_in = nullptr; J.ss_out = nullptr;
    if (s == 0 && q == 0) { J.A = XC; J.Bt = (const bf16_t*)(ws + WS_WIN) + (size_t)l * NZ * DM; J.lda = DM; J.ldb = DM; J.K = DM; J.nN = NZ / 256; J.mode = 0; J.O = (bf16_t*)(ws + WS_Z); J.ldc = NZ; J.ss_in = SS + (size_t)(3 * l) * M; return true; }
    if (s == 2 && q == 0) { J.A = (const bf16_t*)(ws + WS_ALORA); J.Bt = (const bf16_t*)(ws + WS_WLORA) + (size_t)l * 4096 * KL; J.lda = KL; J.ldb = KL; J.K = KL; J.nN = 16; J.mode = 3; J.O = (bf16_t*)(ws + WS_PLANES); J.ldc = RW;
                            J.c0 = a->in[I_W0] + (size_t)l * RW; J.c1 = a->in[I_A0] + (size_t)l * RW; J.c2 = (l > 0) ? a->in[I_V0] + (size_t)(l - 1) * RW : nullptr; return true; }
    if (s == 2 && q == 1) { J.A = (const bf16_t*)(ws + WS_DPOOL); J.Bt = (const bf16_t*)(ws + WS_WPOOL) + (size_t)l * 1024 * 256; J.lda = RW; J.ldb = 256; J.K = 256; J.a_pn_step = 256; J.nN = 4; J.mode = 2; J.O = MIX; J.ldc = DM;
                            J.c0 = a->in[I_POOL_SCALE] + (size_t)l * 1024; return true; }
    if (s == 5 && q == 0) { J.A = MIX; J.Bt = (const bf16_t*)(ws + WS_WOUT) + (size_t)l * DM * DM; J.lda = DM; J.ldb = DM; J.K = DM; J.nN = DM / 256; J.mode = 4; J.base = XC; J.out = XC; J.ss_out = SS + (size_t)(3 * l + 1) * M; return true; }
    if (s == 6 && q == 0) { J.A = XC; J.Bt = (const bf16_t*)(ws + WS_WUP) + (size_t)l * DFF * DM; J.lda = DM; J.ldb = DM; J.K = DM; J.nN = DFF / 256; J.mode = 1; J.O = (bf16_t*)(ws + WS_U); J.ldc = DFF; J.ss_in = SS + (size_t)(3 * l + 1) * M; return true; }
    if (s == 6 && q == 1) { J.A = (const bf16_t*)(ws + WS_PB) + (size_t)l * M * DPLE; J.Bt = (const bf16_t*)(ws + WS_WPROJ) + (size_t)l * DM * DPLE; J.lda = DPLE; J.ldb = DPLE; J.K = DPLE; J.nN = DM / 256; J.mode = 0; J.O = PP; J.ldc = DM; return true; }
    if (s == 7 && q == 0) { J.A = (const bf16_t*)(ws + WS_U); J.Bt = (const bf16_t*)(ws + WS_WDN) + (size_t)l * DM * DFF; J.lda = DFF; J.ldb = DFF; J.K = DFF; J.nN = DM / 256; J.mode = 4; J.base = XC; J.out = XC; J.ss_out = SS + (size_t)(3 * l + 2) * M; return true; }
    if (s == 8 && q == 0) { J.A = XC; J.Bt = (const bf16_t*)(ws + WS_WGATE) + (size_t)l * DM * DM; J.lda = DM; J.ldb = DM; J.K = DM; J.nN = DM / 256; J.mode = 5; J.base = XC; J.out = XN; J.pp = PP; J.ss_in = SS + (size_t)(3 * l + 2) * M;
                            J.ss_out = SS + (size_t)(3 * l + 3) * M; return true; }
    return false;
}
__device__ __forceinline__ void phase_final(ArgsP a, const int tid, const int bx) {
    const int lane = tid & 63, wave = tid >> 6; const int gw = bx * 8 + wave, NW = gridDim.x * 8;
    const bf16_t* X = (const bf16_t*)(a->ws + ((DEPTH & 1) ? WS_XQ : WS_H)); const u64* SS = (const u64*)(a->ws + WS_SS) + (size_t)(3 * DEPTH) * M; const float* g = a->in[I_FINAL_NORM]; float* out = a->out;
    f32x8 gv[4];
#pragma unroll
    for (int j = 0; j < 4; ++j) gv[j] = ld8f(g + 8 * lane + 512 * j);
    for (int row = gw; row < M; row += NW) {
        const float rs = rsqrtf((float)SS[row] * SS_INV + NORM_EPS);
#pragma unroll
        for (int j = 0; j < 4; ++j) { const f32x8 o = up8(*(const v4u*)(X + (size_t)row * DM + 8 * lane + 512 * j)) * rs * gv[j]; float* op = out + (size_t)row * DM + 8 * lane + 512 * j;
            *(f32x4*)op = (f32x4){o[0], o[1], o[2], o[3]}; *(f32x4*)(op + 4) = (f32x4){o[4], o[5], o[6], o[7]}; }
    }
}
constexpr int dup_count() { int c = 0; for (int s = 0; s < 9; ++s) c += (PROBE_DUP >> s) & 1; return c; }
constexpr int SUBS = 9 + dup_count(), PRE = 1 + ((PROBE_DUP >> 9) & 1);
constexpr int N_PHASES_RUN = PRE + SUBS * DEPTH + 1;
__global__ void __launch_bounds__(512, 2) fwd_megakernel(Args a_byval) {
    ArgsP a = (ArgsP)__builtin_amdgcn_kernarg_segment_ptr();
    extern __shared__ __attribute__((aligned(16))) unsigned char lds_raw[];
    LAS unsigned char* lds = (LAS unsigned char*)lds_raw;
    cg::grid_group grid = cg::this_grid();
    const int G = gridDim.x;
    if (threadIdx.x < 16) ((LAS unsigned*)(lds + BAR_LDS_OFF))[threadIdx.x] = 0u;
    __syncthreads();
    XcdBarrier xbar = xcd_barrier_post((unsigned*)a->ws, (volatile LAS unsigned*)(lds + BAR_LDS_OFF));
    const int ph_lo = a->ph_lo, ph_hi = a->ph_hi;
    const int wave_s = __builtin_amdgcn_readfirstlane((int)threadIdx.x >> 6);
    if (ph_lo < 0) grid.sync();
    for (int ph = ph_lo; ph < ph_hi; ++ph) {
        if (ph > ph_lo) xcd_barrier(xbar);
        asm volatile("" : "+s"(a) :: "memory");
        int tid = (wave_s << 6) + (int)__builtin_amdgcn_mbcnt_hi(~0u, __builtin_amdgcn_mbcnt_lo(~0u, 0u)), bx = blockIdx.x; asm volatile("" : "+v"(tid), "+s"(bx));
        int l = 0, s;
        if (ph < PRE) s = 13;
        else if (ph == N_PHASES_RUN - 1) s = 12;
        else { l = (ph - PRE) / SUBS; const int qq = (ph - PRE) % SUBS; int c = 0; s = 0;
               for (; s < 9; ++s) { const int n = 1 + ((PROBE_DUP >> s) & 1); if (qq < c + n) break; c += n; } }
        if (s == 13) { phase_convert(a, lds, tid, bx); }
        else if (s == 12) { phase_final(a, tid, bx); }
        else if (s == 1) { phase_prepa(a, l, tid, bx); }
        else if (s == 3) { const int vcu = (G % 8 == 0) ? (bx % 8) * (G / 8) + bx / 8 : bx; for (int u = vcu; u < 256; u += G) scan_unit(a, l, u, lds, tid); }
        else if (s == 4) { phase_post(a, l, tid, bx); }
        else {
            for (int q = 0; q < 2; ++q) { pg8::Job J; if (!make_job(a, l, s, q, J)) break;
                pg8::StaticOrder S; S.init(J.nM, J.nN, G, bx); pg8::gemm_phase(lds, J, S, tid); }
        }
    }
}

extern "C" void kernel_launch(void* const* d_in, const int* in_sizes, int n_in, void* d_out, int out_size, void* d_ws, size_t ws_size, hipStream_t stream) {
    static int grid = 0;
    if (grid == 0) {
        if (n_in != 29 || in_sizes[0] != M * DM || out_size != M * DM || ws_size < WS_END) {
            fprintf(stderr, "kernel_launch: unexpected shapes: n_in %d in0 %d out %d ws %zu (need %zu); nothing launched\n", n_in, n_in > 0 ? in_sizes[0] : -1, out_size, ws_size, (size_t)WS_END); grid = -1; return; }
        int dev = 0, cus = 0, per_cu = 0;
        if (hipGetDevice(&dev) != hipSuccess || hipDeviceGetAttribute(&cus, hipDeviceAttributeMultiprocessorCount, dev) != hipSuccess) { fprintf(stderr, "kernel_launch: device query failed\n"); grid = -1; return; }
        if (hipFuncSetAttribute((const void*)fwd_megakernel, hipFuncAttributeMaxDynamicSharedMemorySize, LDS_BYTES) != hipSuccess) { fprintf(stderr, "kernel_launch: hipFuncSetAttribute failed\n"); grid = -1; return; }
        if (hipOccupancyMaxActiveBlocksPerMultiprocessor(&per_cu, (const void*)fwd_megakernel, 512, LDS_BYTES) != hipSuccess || per_cu < 1) {
            fprintf(stderr, "kernel_launch: occupancy query says %d blocks/CU; using 1\n", per_cu); per_cu = 1; }
        (void)hipGetLastError();
        grid = cus * 1;
        if (grid > 256) grid = 256;
    }
    if (grid < 0) return;
    Args a{};
    for (int i = 0; i < 29; ++i) a.in[i] = (const float*)d_in[i];
    a.out = (float*)d_out; a.ws = (unsigned char*)d_ws;
    if (hipMemsetAsync(d_ws, 0, 65536, stream) != hipSuccess) { fprintf(stderr, "kernel_launch: memset of barrier words failed\n"); return; }
#if MK_PER_PHASE_LAUNCH
    for (int ph = 0; ph < N_PHASES_RUN; ++ph) {
        a.ph_lo = ph; a.ph_hi = ph + 1;
        hipLaunchKernelGGL(fwd_megakernel, dim3(grid), dim3(512), LDS_BYTES, stream, a);
    }
#else
    a.ph_lo = 0; a.ph_hi = N_PHASES_RUN;
    void* args[] = {&a};
    hipError_t e = hipLaunchCooperativeKernel((const void*)fwd_megakernel, dim3(grid), dim3(512), args, LDS_BYTES, stream);
    if (e != hipSuccess) fprintf(stderr, "cooperative launch failed: %s (grid %d)\n", hipGetErrorString(e), grid);
#endif
}
```

```cpp
#include <hip/hip_runtime.h>
#include <hip/hip_cooperative_groups.h>
#include <cstdio>
#include <cstdint>
namespace cg = cooperative_groups;

#ifndef MK_PER_PHASE_LAUNCH
#define MK_PER_PHASE_LAUNCH 0
#endif

#ifndef PROBE_DUP
#define PROBE_DUP 0
#endif
#define LAS __attribute__((address_space(3)))
typedef unsigned short bf16_t;
typedef short bf16x8 __attribute__((ext_vector_type(8)));
typedef float f32x4 __attribute__((ext_vector_type(4)));
typedef float f32x8 __attribute__((ext_vector_type(8)));
typedef float f32x2 __attribute__((ext_vector_type(2)));
typedef unsigned v4u __attribute__((ext_vector_type(4)));
typedef unsigned v2u __attribute__((ext_vector_type(2)));

constexpr int BATCH = 4, SEQ = 4096, DM = 2048, DEPTH = 4, M = BATCH * SEQ;
constexpr int RW = 1024, HS = 64, NH = 16, DFF = 8192, DPLE = 256;
constexpr int INW = 4384, NZ = 4608, SHIFTW = 3360, KL = 384;
constexpr float NORM_EPS = 1e-6f, GN_EPS = 64e-5f;

constexpr size_t MiB = 1u << 20;
constexpr size_t WS_WIN = 1 * MiB, WS_WOUT = 73 * MiB, WS_WUP = 105 * MiB, WS_WDN = 233 * MiB, WS_WGATE = 361 * MiB, WS_WPROJ = 393 * MiB,
                 WS_WLORA = 397 * MiB, WS_WPOOL = 409 * MiB, WS_PB = 411 * MiB, WS_H = 443 * MiB, WS_MIX = 507 * MiB  ,
                 WS_DPOOL = 571 * MiB  , WS_ALORA = 603 * MiB, WS_VFIRST = 615 * MiB, WS_Z = 647 * MiB, WS_PLANES = 791 * MiB,
                 WS_U = 647 * MiB  , WS_XQ = 919 * MiB, WS_SS = 983 * MiB  , WS_END = 985 * MiB;
typedef unsigned long long u64;
constexpr float SS_SCALE = 1048576.0f, SS_INV = 1.0f / (1048576.0f * 2048.0f);
constexpr size_t PLANE = (size_t)M * RW;

constexpr int LDS_BYTES = 135168, BAR_LDS_OFF = 131072 + 256;

__device__ __forceinline__ unsigned cvt_pk_bf16(float lo, float hi) { unsigned r; asm volatile("v_cvt_pk_bf16_f32 %0, %1, %2" : "=v"(r) : "v"(lo), "v"(hi)); return r; }
__device__ __forceinline__ float bf2f(unsigned h) { return __uint_as_float(h << 16); }
__device__ __forceinline__ f32x8 up8(v4u p) {
    f32x8 r;
    r[0] = __uint_as_float(p.x << 16); r[1] = __uint_as_float(p.x & 0xffff0000u);
    r[2] = __uint_as_float(p.y << 16); r[3] = __uint_as_float(p.y & 0xffff0000u);
    r[4] = __uint_as_float(p.z << 16); r[5] = __uint_as_float(p.z & 0xffff0000u);
    r[6] = __uint_as_float(p.w << 16); r[7] = __uint_as_float(p.w & 0xffff0000u);
    return r;
}
__device__ __forceinline__ v4u pk8(f32x8 v) { v4u o; o.x = cvt_pk_bf16(v[0], v[1]); o.y = cvt_pk_bf16(v[2], v[3]); o.z = cvt_pk_bf16(v[4], v[5]); o.w = cvt_pk_bf16(v[6], v[7]); return o; }
__device__ __forceinline__ f32x8 ld8f(const float* p) { const f32x4 a = *(const f32x4*)p, b = *(const f32x4*)(p + 4); f32x8 r; r[0] = a[0]; r[1] = a[1]; r[2] = a[2]; r[3] = a[3]; r[4] = b[0]; r[5] = b[1]; r[6] = b[2]; r[7] = b[3]; return r; }
__device__ __forceinline__ float sigm(float x) { return __builtin_amdgcn_rcpf(1.0f + __expf(-x)); }
__device__ __forceinline__ float wave_sum(float v) {
#pragma unroll
    for (int o = 1; o < 64; o <<= 1) v += __shfl_xor(v, o);
    return v;
}
__device__ __forceinline__ float sum8(f32x8 v) { return ((v[0] + v[1]) + (v[2] + v[3])) + ((v[4] + v[5]) + (v[6] + v[7])); }
template <int CTRL> __device__ __forceinline__ float dpp1(float x) { const int xi = __builtin_bit_cast(int, x); return __builtin_bit_cast(float, __builtin_amdgcn_update_dpp(0, xi, CTRL, 0xF, 0xF, true)); }
template <int CTRL> __device__ __forceinline__ float dpp_mov(float x) { const int xi = __builtin_bit_cast(int, x); return __builtin_bit_cast(float, __builtin_amdgcn_update_dpp(xi, xi, CTRL, 0xF, 0xF, false)); }
__device__ __forceinline__ float allreduce16(float x) {
    x += dpp_mov<0x128>(x); x += dpp_mov<0x124>(x); x += dpp_mov<0x122>(x); x += dpp_mov<0x121>(x); return x;
}

namespace pg8 {
constexpr int BM = 256, BK = 64, HALF = 128, HTB = HALF * BK * 2, STAGE_BYTES = 8 * HTB, NXCD = 8, WGM = 4;
__host__ __device__ __forceinline__ int lds_byte(int r, int c) { const int st = (r >> 4) * 2 + (c >> 5), rr = r & 15, cc = c & 31, ob = rr * 64 + cc * 2; return st * 1024 + (ob ^ (((ob >> 9) & 1) << 5)); }
__host__ __device__ __forceinline__ void stage_rc(int b, int& R, int& C) { const int st = b / 1024, sb = b % 1024, swz = sb ^ (((sb >> 9) & 1) << 5); R = (st >> 1) * 16 + swz / 64; C = (st & 1) * 32 + (swz % 64) / 2; }
__host__ __device__ __forceinline__ int perm32(int rho) { const int n = rho >> 4, i = rho & 15; return 8 * (i >> 2) + 4 * n + (i & 3); }

struct Unit { int pm, pn; };

struct StaticOrder {
    int nM, nN, nwg, G, c;
    __device__ void init(int nM_, int nN_, int G_, int c_) { nM = nM_; nN = nN_; nwg = nM * nN; G = G_; c = c_; }
    __device__ bool next(int i, Unit& u) const {
        const long L = (long)i * G + c; if (L >= nwg) return false;
        int wgid = (int)L; { const int q = nwg / NXCD, r = nwg % NXCD, xcd = wgid % NXCD, off = wgid / NXCD; wgid = (xcd < r ? xcd * (q + 1) : r * (q + 1) + (xcd - r) * q) + off; }
        const int nig = WGM * nN, gid = wgid / nig, fm = gid * WGM, gsz = (nM - fm) < WGM ? (nM - fm) : WGM;
        u.pm = __builtin_amdgcn_readfirstlane(fm + ((wgid % nig) % gsz)); u.pn = __builtin_amdgcn_readfirstlane((wgid % nig) / gsz); return true;
    }
};

template <int MODE> struct EpiB {
    static constexpr bool PERM = true;
    bf16_t* O; int ldc; const float* c0; const float* c1; const float* c2; size_t plane; const u64* ss;
    __device__ __forceinline__ void operator()(const f32x4 (&acc)[2][2][4][2], const Unit& u, int wr, int wc, int fr, int fq, const u64 (&ssr)[2][4]) const {
        const int row0 = u.pm * BM + wr * 64 + fr; int colt = u.pn * BM; bf16_t* base = O; int t = 0;
        if (MODE == 3) { t = colt >> 10; base += (size_t)t * plane; colt &= 1023; }
        const int col0 = colt + wc * 32 + 8 * fq;
        f32x4 cv[2][2];
#pragma unroll
        for (int bj = 0; bj < 2; ++bj)
#pragma unroll
            for (int n = 0; n < 2; ++n) {
                cv[bj][n] = (f32x4){0.f, 0.f, 0.f, 0.f};
                if (MODE == 2) cv[bj][n] = *(const f32x4*)(c0 + col0 + bj * HALF + 4 * n);
                if (MODE == 3) { const float* b = (t == 0) ? c0 : (t == 1) ? c1 : (t == 3) ? c2 : nullptr; if (b) cv[bj][n] = *(const f32x4*)(b + col0 + bj * HALF + 4 * n); }
            }
        float rsv[2][4];
#pragma unroll
        for (int ai = 0; ai < 2; ++ai)
#pragma unroll
            for (int m = 0; m < 4; ++m) { rsv[ai][m] = 1.0f; if (MODE < 2) { if (ss) rsv[ai][m] = rsqrtf((float)ssr[ai][m] * SS_INV + NORM_EPS); } }
#pragma unroll
        for (int ai = 0; ai < 2; ++ai)
#pragma unroll
            for (int m = 0; m < 4; ++m) { bf16_t* rowp = base + (size_t)(row0 + ai * HALF + m * 16) * ldc + col0;
                const float rs = rsv[ai][m];
#pragma unroll
                for (int bj = 0; bj < 2; ++bj) { f32x4 v0 = acc[ai][bj][m][0], v1 = acc[ai][bj][m][1];
                    if (MODE < 2) { v0 = v0 * rs; v1 = v1 * rs; }
                    if (MODE == 1) {
#pragma unroll
                        for (int j = 0; j < 4; ++j) { const float a = fmaxf(v0[j], 0.f), b = fmaxf(v1[j], 0.f); v0[j] = a * a; v1[j] = b * b; } }
                    if (MODE == 2) { v0 = v0 * cv[bj][0]; v1 = v1 * cv[bj][1]; }
                    if (MODE == 3) { v0 = v0 + cv[bj][0]; v1 = v1 + cv[bj][1];
                        if (t == 0) {
#pragma unroll
                            for (int j = 0; j < 4; ++j) { v0[j] = -0.6065306597f * sigm(v0[j]); v1[j] = -0.6065306597f * sigm(v1[j]); } }
                        else if (t != 2) {
#pragma unroll
                            for (int j = 0; j < 4; ++j) { v0[j] = sigm(v0[j]); v1[j] = sigm(v1[j]); } }
                    }
                    v4u w; w.x = cvt_pk_bf16(v0[0], v0[1]); w.y = cvt_pk_bf16(v0[2], v0[3]); w.z = cvt_pk_bf16(v1[0], v1[1]); w.w = cvt_pk_bf16(v1[2], v1[3]);
                    *(v4u*)(rowp + bj * HALF) = w; } }
    }
};
template <bool GATE> struct EpiX {
    static constexpr int RB = GATE ? 2 : 4;
    const bf16_t* base; bf16_t* out; const bf16_t* pp; int ldc; const u64* ss_in; u64* ss_out;
    __device__ __forceinline__ void operator()(const f32x4 (&acc)[2][2][4][2], const Unit& u, int wr, int wc, int fr, int fq, const u64 (&ssr)[2][4]) const {
        const int row0 = u.pm * BM + wr * 64 + fr, col0 = u.pn * BM + wc * 32 + 8 * fq;
        float rsv[2][4];
#pragma unroll
        for (int ai = 0; ai < 2; ++ai)
#pragma unroll
            for (int m = 0; m < 4; ++m) { rsv[ai][m] = 1.0f; if (GATE) rsv[ai][m] = rsqrtf((float)ssr[ai][m] * SS_INV + NORM_EPS); }
#pragma unroll
        for (int aim = 0; aim < 8 / RB; ++aim) { const int ai = (aim * RB) >> 2, m0 = (aim * RB) & 3;
            v4u bs[RB][2], q[RB][2];
#pragma unroll
            for (int mm = 0; mm < RB; ++mm) { const size_t off = (size_t)(row0 + ai * HALF + (m0 + mm) * 16) * ldc + col0;
#pragma unroll
                for (int bj = 0; bj < 2; ++bj) { bs[mm][bj] = *(const v4u*)(base + off + bj * HALF); if (GATE) q[mm][bj] = *(const v4u*)(pp + off + bj * HALF); } }
#pragma unroll
            for (int mm = 0; mm < RB; ++mm) { const int m = m0 + mm, row = row0 + ai * HALF + m * 16; const size_t off = (size_t)row * ldc + col0; const float rs = rsv[ai][m];
                float sq = 0.f;
#pragma unroll
                for (int bj = 0; bj < 2; ++bj) { const f32x8 b = up8(bs[mm][bj]); f32x4 a0 = acc[ai][bj][m][0], a1 = acc[ai][bj][m][1];
                    if (GATE) { const f32x8 qf = up8(q[mm][bj]); a0 = a0 * rs; a1 = a1 * rs;
#pragma unroll
                        for (int j = 0; j < 4; ++j) { a0[j] = sigm(a0[j]) * qf[j]; a1[j] = sigm(a1[j]) * qf[4 + j]; } }
                    f32x8 x;
#pragma unroll
                    for (int j = 0; j < 4; ++j) { x[j] = b[j] + a0[j]; x[4 + j] = b[4 + j] + a1[j]; }
                    const v4u w = pk8(x);
                    *(v4u*)(out + off + bj * HALF) = w;
                    const f32x8 xr = up8(w); sq += sum8(xr * xr); }
                sq += __shfl_xor(sq, 16); sq += __shfl_xor(sq, 32);
                if (fq == 0) __hip_atomic_fetch_add(ss_out + row, (u64)(sq * SS_SCALE), __ATOMIC_RELAXED, __HIP_MEMORY_SCOPE_AGENT); }
            asm volatile("" ::: "memory"); }
    }
};

struct Job { const bf16_t* A; const bf16_t* Bt; int lda, ldb, K, a_pn_step, nM, nN, mode;
             bf16_t* O; int ldc; const float* c0; const float* c1; const float* c2; const bf16_t* base; bf16_t* out; const bf16_t* pp;
             const u64* ss_in; u64* ss_out; };
__device__ __forceinline__ void run_epi(const Job& J, const f32x4 (&acc)[2][2][4][2], const Unit& u, int wr, int wc, int fr, int fq, const u64 (&ssr)[2][4]) {
    switch (J.mode) {
    case 0: { EpiB<0> E{J.O, J.ldc, nullptr, nullptr, nullptr, 0, J.ss_in}; E(acc, u, wr, wc, fr, fq, ssr); } break;
    case 1: { EpiB<1> E{J.O, J.ldc, nullptr, nullptr, nullptr, 0, J.ss_in}; E(acc, u, wr, wc, fr, fq, ssr); } break;
    case 2: { EpiB<2> E{J.O, J.ldc, J.c0, nullptr, nullptr, 0, nullptr}; E(acc, u, wr, wc, fr, fq, ssr); } break;
    case 3: { EpiB<3> E{J.O, J.ldc, J.c0, J.c1, J.c2, PLANE, nullptr}; E(acc, u, wr, wc, fr, fq, ssr); } break;
    case 4: { EpiX<false> E{J.base, J.out, nullptr, J.ldc, nullptr, J.ss_out}; E(acc, u, wr, wc, fr, fq, ssr); } break;
    default: { EpiX<true> E{J.base, J.out, J.pp, J.ldc, J.ss_in, J.ss_out}; E(acc, u, wr, wc, fr, fq, ssr); } break;
    }
}
__device__ __forceinline__ void gemm_phase(LAS unsigned char* lds, const Job& J, const StaticOrder& S, const int tid) {
    const int wid = __builtin_amdgcn_readfirstlane(tid >> 6), lane = tid & 63, wr = wid >> 2, wc = wid & 3, fr = lane & 15, fq = lane >> 4;
    const int K = J.K, nt = K / BK;
    unsigned voffA[2], voffB[2];
#pragma unroll
    for (int i = 0; i < 2; ++i) { int R, C; stage_rc(tid * 16 + i * 8192, R, C); const int Rb = (R & ~31) + perm32(R & 31);
        voffA[i] = (unsigned)(R * J.lda + C) * 2u; voffB[i] = (unsigned)(Rb * J.ldb + C) * 2u; }
    const unsigned kstep = (unsigned)(BK * 2);
    const unsigned hstepA = (unsigned)HALF * J.lda * 2, hstepB = (unsigned)HALF * J.ldb * 2;
    const unsigned tstepA = 2 * hstepA, tstepB = 2 * hstepB;
    const __amdgpu_buffer_rsrc_t rsA = __builtin_amdgcn_make_buffer_rsrc((void*)J.A, 0, 0x7fffffff, 0x00020000);
    const __amdgpu_buffer_rsrc_t rsB = __builtin_amdgcn_make_buffer_rsrc((void*)J.Bt, 0, 0x7fffffff, 0x00020000);
    const unsigned ldsw = (unsigned)wid * 1024u;
    const int aoff = lds_byte(wr * 64 + fr, fq * 8), boff = lds_byte(wc * 32 + fr, fq * 8);
#define PG8_SA(b, h) (((b) * 2 + (h)) * HTB)
#define PG8_SB(b, h) ((4 + (b) * 2 + (h)) * HTB)
#define PG8_STAGE(bufoff, goff, voff) do { _Pragma("unroll") for (int _i = 0; _i < 2; ++_i) \
        __builtin_amdgcn_raw_ptr_buffer_load_lds(PG8_RS_##voff, (LAS unsigned*)(lds + (bufoff) + ldsw + _i * 8192), 16, (voff)[_i], (goff), 0, 0); } while (0)
#define PG8_RS_voffA rsA
#define PG8_RS_voffB rsB
#define PG8_LDA(dst, b, h) do { _Pragma("unroll") for (int m = 0; m < 4; ++m) _Pragma("unroll") for (int k = 0; k < 2; ++k) dst[m][k] = *(const LAS bf16x8*)(lds + PG8_SA(b, h) + aoff + m * 2048 + k * 1024); } while (0)
#define PG8_LDB(dst, b, h) do { _Pragma("unroll") for (int n = 0; n < 2; ++n) _Pragma("unroll") for (int k = 0; k < 2; ++k) dst[n][k] = *(const LAS bf16x8*)(lds + PG8_SB(b, h) + boff + n * 2048 + k * 1024); } while (0)
#define PG8_MMA(ai, bj, At, Bt) do { __builtin_amdgcn_s_setprio(1); _Pragma("unroll") for (int m = 0; m < 4; ++m) _Pragma("unroll") for (int n = 0; n < 2; ++n) _Pragma("unroll") for (int k = 0; k < 2; ++k) \
        acc[ai][bj][m][n] = __builtin_amdgcn_mfma_f32_16x16x32_bf16(Bt[n][k], At[m][k], acc[ai][bj][m][n], 0, 0, 0); __builtin_amdgcn_s_setprio(0); } while (0)
#define PG8_WAIT_V(n) asm volatile("s_waitcnt vmcnt(" #n ")" ::: "memory")
#define PG8_WAIT_L(n) asm volatile("s_waitcnt lgkmcnt(" #n ")" ::: "memory")
#define PG8_BAR __builtin_amdgcn_s_barrier()
#define PG8_SCHED __builtin_amdgcn_sched_barrier(0)
    Unit cur, nxt; int ui = 0;
    if (!S.next(0, cur)) return;
    f32x4 acc[2][2][4][2];
#pragma unroll
    for (int a = 0; a < 2; ++a)
#pragma unroll
        for (int b = 0; b < 2; ++b)
#pragma unroll
            for (int m = 0; m < 4; ++m)
#pragma unroll
                for (int n = 0; n < 2; ++n) acc[a][b][m][n] = (f32x4){0.f, 0.f, 0.f, 0.f};
    bf16x8 At[4][2], B0[2][2], B1[2][2];
    u64 ssr[2][4];
#define PG8_SSLD(U) do { if (J.ss_in) { const u64* sp_ = J.ss_in + (U).pm * BM + wr * 64 + fr; _Pragma("unroll") for (int ai_ = 0; ai_ < 2; ++ai_) _Pragma("unroll") for (int m_ = 0; m_ < 4; ++m_) ssr[ai_][m_] = sp_[ai_ * HALF + m_ * 16]; } \
        else { _Pragma("unroll") for (int ai_ = 0; ai_ < 2; ++ai_) _Pragma("unroll") for (int m_ = 0; m_ < 4; ++m_) ssr[ai_][m_] = 0ull; } } while (0)
    PG8_SSLD(cur);
    unsigned cA = (unsigned)cur.pm * tstepA + (unsigned)cur.pn * J.a_pn_step * 2; unsigned cB = (unsigned)cur.pn * tstepB;
    PG8_STAGE(PG8_SB(0, 0), cB, voffB); PG8_STAGE(PG8_SB(0, 1), cB + hstepB, voffB); PG8_STAGE(PG8_SA(0, 0), cA, voffA); PG8_STAGE(PG8_SA(0, 1), cA + hstepA, voffA);
    if (wr == 1) PG8_BAR;
    PG8_WAIT_V(2); PG8_BAR;
    PG8_STAGE(PG8_SB(1, 0), cB + kstep, voffB); PG8_STAGE(PG8_SA(1, 0), cA + kstep, voffA); PG8_STAGE(PG8_SB(1, 1), cB + hstepB + kstep, voffB);
    PG8_WAIT_V(6); PG8_BAR;
    for (;;) {
        const bool has_next = S.next(ui + 1, nxt);
        const unsigned nA = has_next ? (unsigned)nxt.pm * tstepA + (unsigned)nxt.pn * J.a_pn_step * 2 : cA; const unsigned nB = has_next ? (unsigned)nxt.pn * tstepB : cB;
        for (int t = 0; t < nt; t += 2) {
            const bool last = (t == nt - 2);
            const unsigned a1 = cA + (unsigned)(t + 1) * kstep;
            const unsigned a2 = last ? nA : cA + (unsigned)(t + 2) * kstep; const unsigned b2 = last ? nB : cB + (unsigned)(t + 2) * kstep;
            const unsigned a3 = a2 + kstep; const unsigned b3 = b2 + kstep;
            PG8_LDB(B0, 0, 0); PG8_LDB(B1, 0, 1); PG8_SCHED; PG8_LDA(At, 0, 0); PG8_STAGE(PG8_SA(1, 1), a1 + hstepA, voffA);
            PG8_WAIT_V(8); PG8_WAIT_L(0); PG8_BAR; PG8_MMA(0, 0, At, B0); PG8_MMA(0, 1, At, B1); PG8_BAR; PG8_SCHED;
            PG8_LDA(At, 0, 1); PG8_STAGE(PG8_SB(0, 0), b2, voffB); PG8_STAGE(PG8_SB(0, 1), b2 + hstepB, voffB); PG8_STAGE(PG8_SA(0, 0), a2, voffA);
            PG8_WAIT_V(8); PG8_WAIT_L(0); PG8_BAR; PG8_MMA(1, 0, At, B0); PG8_MMA(1, 1, At, B1); PG8_BAR; PG8_SCHED;
            PG8_LDB(B0, 1, 0); PG8_LDB(B1, 1, 1); PG8_SCHED; PG8_LDA(At, 1, 0); PG8_STAGE(PG8_SA(0, 1), a2 + hstepA, voffA);
            PG8_WAIT_V(8); PG8_WAIT_L(0); PG8_BAR; PG8_MMA(0, 0, At, B0); PG8_MMA(0, 1, At, B1); PG8_BAR; PG8_SCHED;
            PG8_LDA(At, 1, 1); PG8_STAGE(PG8_SB(1, 0), b3, voffB); PG8_STAGE(PG8_SB(1, 1), b3 + hstepB, voffB); PG8_STAGE(PG8_SA(1, 0), a3, voffA);
            PG8_WAIT_V(8); PG8_WAIT_L(0); PG8_BAR; PG8_MMA(1, 0, At, B0); PG8_MMA(1, 1, At, B1); PG8_BAR; PG8_SCHED;
        }
        if (wr == 0) PG8_BAR;
        run_epi(J, acc, cur, wr, wc, fr, fq, ssr);
        if (!has_next) break;
        PG8_SSLD(nxt);
#pragma unroll
        for (int a = 0; a < 2; ++a)
#pragma unroll
            for (int b = 0; b < 2; ++b)
#pragma unroll
                for (int m = 0; m < 4; ++m)
#pragma unroll
                    for (int n = 0; n < 2; ++n) acc[a][b][m][n] = (f32x4){0.f, 0.f, 0.f, 0.f};
        cur = nxt; cA = nA; cB = nB; ++ui;
        if (wr == 1) PG8_BAR;
    }
    PG8_WAIT_V(0);
    PG8_BAR;
#undef PG8_SA
#undef PG8_SB
#undef PG8_STAGE
#undef PG8_SSLD
#undef PG8_RS_voffA
#undef PG8_RS_voffB
#undef PG8_LDA
#undef PG8_LDB
#undef PG8_MMA
#undef PG8_WAIT_V
#undef PG8_WAIT_L
#undef PG8_BAR
#undef PG8_SCHED
}
}

struct Args { const float* in[29]; float* out; unsigned char* ws; int ph_lo, ph_hi; };
typedef const __attribute__((address_space(4))) Args* ArgsP;
enum { I_X = 0, I_P, I_ATTN_NORM, I_W_IN, I_MU_SHIFT, I_W_VRES_DN, I_MU_VRES, I_V0, I_V_UP, I_POOL_W, I_POOL_SCALE, I_W0, I_W_UP, I_A0, I_A_UP, I_G_UP,
       I_K_K, I_K_A, I_R_K, I_GN_G, I_GN_B, I_W_OUT, I_MLP_NORM, I_W_FFN_UP, I_W_FFN_DOWN, I_PLE_NORM, I_W_PLE_GATE, I_W_PLE_PROJ, I_FINAL_NORM };

__device__ __forceinline__ void p0_transpose_item(const float* W, int N, bf16_t* WT, int ldd, int row_off, LAS float* scr, int item, int nblk, int lane, const float* gs) {
    const int kb = item / nblk, nb = item % nblk, k0 = 64 * kb, n0 = 32 * nb;
    const int c = lane & 7;
    f32x4 g0 = {1.f, 1.f, 1.f, 1.f}, g1 = {1.f, 1.f, 1.f, 1.f};
    if (gs) { g0 = *(const f32x4*)(gs + k0 + 8 * c); g1 = *(const f32x4*)(gs + k0 + 8 * c + 4); }
#pragma unroll
    for (int hb = 0; hb < 2; ++hb) {
        float wv[16];
#pragma unroll
        for (int i = 0; i < 16; ++i) { const int kk = 2 * (16 * hb + i) + (lane >> 5); wv[i] = W[(size_t)(k0 + kk) * N + n0 + (lane & 31)]; }
#pragma unroll
        for (int i = 0; i < 16; ++i) { const int kk = 2 * (16 * hb + i) + (lane >> 5); scr[kk * 33 + (lane & 31)] = wv[i]; }
    }
    asm volatile("s_waitcnt lgkmcnt(0)" ::: "memory");
#pragma unroll
    for (int j = 0; j < 4; ++j) { const int n = (lane >> 3) + 8 * j; const LAS float* s = scr + (8 * c) * 33 + n;
        v4u o; o.x = cvt_pk_bf16(s[0 * 33] * g0[0], s[1 * 33] * g0[1]); o.y = cvt_pk_bf16(s[2 * 33] * g0[2], s[3 * 33] * g0[3]); o.z = cvt_pk_bf16(s[4 * 33] * g1[0], s[5 * 33] * g1[1]); o.w = cvt_pk_bf16(s[6 * 33] * g1[2], s[7 * 33] * g1[3]);
        *(v4u*)(WT + (size_t)(row_off + n0 + n) * ldd + k0 + 8 * c) = o; }
    asm volatile("s_waitcnt lgkmcnt(0)" ::: "memory");
}
__device__ __forceinline__ void cvt_job(const float* W, int K, int N, bf16_t* WT, int ldd, int row_off, LAS float* scr, int gw, int NW, int lane, const float* gs = nullptr) {
    const int nblk = N / 32, nit = (K / 64) * nblk;
    for (int it = gw; it < nit; it += NW) p0_transpose_item(W, N, WT, ldd, row_off, scr, it, nblk, lane, gs);
}
__device__ __forceinline__ void phase_convert(ArgsP a, LAS unsigned char* lds, const int tid, const int bx) {
    const int lane = tid & 63, wave = tid >> 6, G = gridDim.x;
    const int gw = bx * 8 + wave, NW = G * 8; const size_t gt = (size_t)bx * 512 + tid, NT = (size_t)G * 512;
    LAS float* scr = (LAS float*)(lds + wave * 8448);
    unsigned char* ws = a->ws;
    for (int l = 0; l < DEPTH; ++l) {
        bf16_t* win = (bf16_t*)(ws + WS_WIN) + (size_t)l * NZ * DM;
        cvt_job(a->in[I_W_IN] + (size_t)l * DM * INW, DM, INW, win, DM, 0, scr, gw, NW, lane, a->in[I_ATTN_NORM] + (size_t)l * DM);
        if (l > 0) cvt_job(a->in[I_W_VRES_DN] + (size_t)(l - 1) * DM * 32, DM, 32, win, DM, INW, scr, gw, NW, lane, a->in[I_ATTN_NORM] + (size_t)l * DM);
        { const int r0 = (l == 0) ? INW : INW + 32; const size_t n16 = (size_t)(NZ - r0) * DM / 8; v4u* z = (v4u*)(win + (size_t)r0 * DM);
          for (size_t i = gt; i < n16; i += NT) z[i] = (v4u){0u, 0u, 0u, 0u}; }
        cvt_job(a->in[I_W_OUT] + (size_t)l * DM * DM, DM, DM, (bf16_t*)(ws + WS_WOUT) + (size_t)l * DM * DM, DM, 0, scr, gw, NW, lane);
        cvt_job(a->in[I_W_FFN_UP] + (size_t)l * DM * DFF, DM, DFF, (bf16_t*)(ws + WS_WUP) + (size_t)l * DFF * DM, DM, 0, scr, gw, NW, lane, a->in[I_MLP_NORM] + (size_t)l * DM);
        cvt_job(a->in[I_W_FFN_DOWN] + (size_t)l * DFF * DM, DFF, DM, (bf16_t*)(ws + WS_WDN) + (size_t)l * DM * DFF, DFF, 0, scr, gw, NW, lane);
        cvt_job(a->in[I_W_PLE_GATE] + (size_t)l * DM * DM, DM, DM, (bf16_t*)(ws + WS_WGATE) + (size_t)l * DM * DM, DM, 0, scr, gw, NW, lane, a->in[I_PLE_NORM] + (size_t)l * DM);
        cvt_job(a->in[I_W_PLE_PROJ] + (size_t)l * DPLE * DM, DPLE, DM, (bf16_t*)(ws + WS_WPROJ) + (size_t)l * DM * DPLE, DPLE, 0, scr, gw, NW, lane);
        for (int gi = 0; gi < 4; ++gi)
            cvt_job(a->in[I_POOL_W] + ((size_t)l * 4 + gi) * 256 * 256, 256, 256, (bf16_t*)(ws + WS_WPOOL) + (size_t)l * 1024 * 256, 256, gi * 256, scr, gw, NW, lane);
        { bf16_t* wl = (bf16_t*)(ws + WS_WLORA) + (size_t)l * 4096 * KL;
          const float* wu = a->in[I_W_UP] + (size_t)l * 64 * RW; const float* au = a->in[I_A_UP] + (size_t)l * 64 * RW; const float* gu = a->in[I_G_UP] + (size_t)l * 160 * RW;
          const float* vu = a->in[I_V_UP] + (size_t)(l > 0 ? l - 1 : 0) * 32 * RW;
          for (size_t idx = gt; idx < (size_t)4096 * KL; idx += NT) { const int n = (int)(idx / KL), k = (int)(idx % KL), t = n >> 10, col = n & 1023; float v = 0.f;
              if (t == 0) { if (k < 64) v = wu[(size_t)k * RW + col]; }
              else if (t == 1) { if (k >= 64 && k < 128) v = au[(size_t)(k - 64) * RW + col]; }
              else if (t == 2) { if (k >= 128 && k < 288) v = gu[(size_t)(k - 128) * RW + col]; }
              else { if (l > 0 && k >= 288 && k < 320) v = vu[(size_t)(k - 288) * RW + col]; }
              wl[idx] = (bf16_t)(cvt_pk_bf16(v, 0.f) & 0xffffu); } }
    }
    { u64* SS = (u64*)(ws + WS_SS); bf16_t* XP = (bf16_t*)(ws + WS_H); const float* x = a->in[I_X];
      for (size_t i = gt; i < (size_t)12 * M; i += NT) SS[M + i] = 0ull;
      for (int row = gw; row < M; row += NW) {
          const f32x4* xr = (const f32x4*)(x + (size_t)row * DM) + lane; float s = 0.f;
#pragma unroll
          for (int j = 0; j < 8; ++j) { const f32x4 v = xr[64 * j]; s += (v[0] * v[0] + v[1] * v[1]) + (v[2] * v[2] + v[3] * v[3]);
              v2u w; w.x = cvt_pk_bf16(v[0], v[1]); w.y = cvt_pk_bf16(v[2], v[3]); ((v2u*)(XP + (size_t)row * DM))[lane + 64 * j] = w; }
          s = wave_sum(s); if (lane == 0) SS[row] = (u64)(s * SS_SCALE); } }
    { const float* p = a->in[I_P]; bf16_t* pb = (bf16_t*)(ws + WS_PB); const size_t n8 = (size_t)DEPTH * M * DPLE / 8;
      for (size_t i = gt; i < n8; i += NT) { const f32x8 v = ld8f(p + i * 8); *(v4u*)(pb + i * 8) = pk8(v); } }
}

template <int WIN> __device__ __forceinline__ v4u pool_diff(const bf16_t* zp, int tpos) {
    const f32x8 u = up8(*(const v4u*)zp);
    v4u raw[WIN - 1];
#pragma unroll
    for (int q = 1; q < WIN; ++q) raw[q - 1] = *(const v4u*)(zp - (size_t)((q <= tpos) ? q : 0) * NZ);
    f32x8 s = u;
#pragma unroll
    for (int q = 1; q < WIN; ++q) { const float msk = (q <= tpos) ? 1.0f : 0.0f; s = s + up8(raw[q - 1]) * msk; }
    const int cnt = (tpos + 1 < WIN) ? tpos + 1 : WIN;
    return pk8(s * (1.0f / (float)cnt) - u);
}
__device__ __forceinline__ void phase_prepa(ArgsP a, int l, const int tid, const int bx) {
    const int G = gridDim.x;
    const bf16_t* Z = (const bf16_t*)(a->ws + WS_Z); bf16_t* DP = (bf16_t*)(a->ws + WS_DPOOL); bf16_t* AL = (bf16_t*)(a->ws + WS_ALORA);
    const float* mus = a->in[I_MU_SHIFT] + (size_t)l * SHIFTW; const float* muv = a->in[I_MU_VRES] + (size_t)(l > 0 ? l - 1 : 0) * 32;
    const int wave = __builtin_amdgcn_readfirstlane(tid >> 6), lane = tid & 63;
    const int gi = wave & 3, prow = (wave >> 2) * 2 + (lane >> 5), pcol = gi * 256 + 8 * (lane & 31);
    const int arow = tid / 48, acol = 8 * (tid % 48);
    for (int unit = bx; unit < M / 4; unit += G) {
        { const int row = unit * 4 + prow, tpos = row & (SEQ - 1);
          const bf16_t* zp = Z + (size_t)row * NZ + pcol; v4u d;
          if (gi == 0) d = pool_diff<2>(zp, tpos); else if (gi == 1) d = pool_diff<4>(zp, tpos); else if (gi == 2) d = pool_diff<8>(zp, tpos); else d = pool_diff<16>(zp, tpos);
          *(v4u*)(DP + (size_t)row * RW + pcol) = d; }
        if (tid < 192) {
            const int row = unit * 4 + arow, tpos = row & (SEQ - 1), c = acol; f32x8 o;
#pragma unroll
            for (int j = 0; j < 8; ++j) o[j] = 0.f;
            if (c < 288 || (c < 320 && l > 0)) {
                const bf16_t* zp = Z + (size_t)row * NZ + 4096 + c;
                const f32x8 zc = up8(*(const v4u*)zp); f32x8 zq;
                if (tpos > 0) zq = up8(*(const v4u*)(zp - NZ)); else {
#pragma unroll
                    for (int j = 0; j < 8; ++j) zq[j] = 0.f; }
                const f32x8 mu = (c < 288) ? ld8f(mus + 3072 + c) : ld8f(muv + (c - 288));
                const f32x8 zs = zc + (zq - zc) * mu;
                if (c < 64) {
#pragma unroll
                    for (int j = 0; j < 8; ++j) o[j] = 1.0f - 2.0f * __builtin_amdgcn_rcpf(1.0f + __expf(2.0f * zs[j])); }
                else if (c >= 128 && c < 288) {
#pragma unroll
                    for (int j = 0; j < 8; ++j) o[j] = sigm(zs[j]); }
                else o = zs;
            }
            *(v4u*)(AL + (size_t)row * KL + c) = pk8(o);
        }
    }
}

constexpr int TC = 32, STEPB = 1344, BUFB = TC * STEPB, YBB = TC * 16 * 4;
struct ScanRaw { v4u zr, zrp, zk, zkp, zv, zvp, ld, aa, vg, vf; };
__device__ __forceinline__ void scan_unit(ArgsP a, int l, int u, LAS unsigned char* lds, const int tid) {
    const int wave = __builtin_amdgcn_readfirstlane(tid >> 6), lane = tid & 63;
    const int bh = u >> 2, rg = u & 3, b = bh >> 4, h = bh & 15;
    const bool hasv = l > 0;
    constexpr int NC = SEQ / TC;
    const size_t rowbase = (size_t)b * SEQ;
    if (wave < 4) {
        const int rowl = 4 * wave + (lane >> 4), j = lane & 15;
        f32x2 s01 = {0.f, 0.f}, s23 = {0.f, 0.f};
        for (int c = 0; c < NC; ++c) {
            __syncthreads();
            const LAS unsigned char* buf = lds + (c & 1) * BUFB + 16 * j;
            const LAS unsigned char* vb = lds + (c & 1) * BUFB + 1280 + 4 * rowl;
            LAS float* yb = (LAS float*)(lds + 2 * BUFB + (c & 1) * YBB) + rowl + (15 - j) * 16;
            f32x4 R[3], W[3], K[3], A[3], B[3]; float V[3];
#define SC_LD(sl, tl) do { R[sl] = *(const LAS f32x4*)(buf + (tl) * STEPB); W[sl] = *(const LAS f32x4*)(buf + (tl) * STEPB + 256); K[sl] = *(const LAS f32x4*)(buf + (tl) * STEPB + 512); \
                A[sl] = *(const LAS f32x4*)(buf + (tl) * STEPB + 768); B[sl] = *(const LAS f32x4*)(buf + (tl) * STEPB + 1024); V[sl] = *(const LAS float*)(vb + (tl) * STEPB); } while (0)
            SC_LD(0, 0); SC_LD(1, 1);
            float yprev = 0.f, ysel = 0.f;
#pragma unroll
            for (int i = 0; i < TC; ++i) {
                const int sl = i % 3;
                if (i + 2 < TC) SC_LD((i + 2) % 3, i + 2);
                const f32x2 vv = {V[sl], V[sl]};
                f32x2 pp = s01 * (f32x2){A[sl][0], A[sl][1]}; pp = s23 * (f32x2){A[sl][2], A[sl][3]} + pp;
                float p = pp[0] + pp[1];
                f32x2 t01 = vv * (f32x2){K[sl][0], K[sl][1]}, t23 = vv * (f32x2){K[sl][2], K[sl][3]};
                t01 = s01 * (f32x2){W[sl][0], W[sl][1]} + t01; t23 = s23 * (f32x2){W[sl][2], W[sl][3]} + t23;
                if (i > 0) {
                    p += dpp1<0x128>(p); yprev += dpp1<0x128>(yprev);
                    p += dpp1<0x124>(p); yprev += dpp1<0x124>(yprev);
                    p += dpp1<0x122>(p); yprev += dpp1<0x122>(yprev);
                    p += dpp1<0x121>(p); yprev += dpp1<0x121>(yprev);
                    ysel = __builtin_bit_cast(float, __builtin_amdgcn_update_dpp(__builtin_bit_cast(int, yprev), __builtin_bit_cast(int, ysel), 0x111, 0xF, 0xF, false));
                    if ((i & 15) == 0) yb[((i >> 4) - 1) * 256] = ysel;
                } else {
                    p += dpp1<0x128>(p); p += dpp1<0x124>(p); p += dpp1<0x122>(p); p += dpp1<0x121>(p);
                }
                const f32x2 pv = {p, p};
                s01 = pv * (f32x2){B[sl][0], B[sl][1]} + t01; s23 = pv * (f32x2){B[sl][2], B[sl][3]} + t23;
                f32x2 yy = s01 * (f32x2){R[sl][0], R[sl][1]}; yy = s23 * (f32x2){R[sl][2], R[sl][3]} + yy;
                yprev = yy[0] + yy[1];
            }
            yprev += dpp1<0x128>(yprev); yprev += dpp1<0x124>(yprev); yprev += dpp1<0x122>(yprev); yprev += dpp1<0x121>(yprev);
            ysel = __builtin_bit_cast(float, __builtin_amdgcn_update_dpp(__builtin_bit_cast(int, yprev), __builtin_bit_cast(int, ysel), 0x111, 0xF, 0xF, false));
            yb[(TC / 16 - 1) * 256] = ysel;
#undef SC_LD
        }
        __syncthreads();
    } else {
        const int ltid = tid - 256, tl = ltid >> 3, cgp = ltid & 7;
        const int col0 = h * HS + 8 * cgp;
        const bf16_t* Z = (const bf16_t*)(a->ws + WS_Z); const bf16_t* PL = (const bf16_t*)(a->ws + WS_PLANES); const bf16_t* VF = (const bf16_t*)(a->ws + WS_VFIRST);
        bf16_t* Y = (bf16_t*)(a->ws + WS_DPOOL);
        const float* mus = a->in[I_MU_SHIFT] + (size_t)l * SHIFTW;
        const f32x8 mur = ld8f(mus + col0), muk = ld8f(mus + 1024 + col0), muv = ld8f(mus + 2048 + col0);
        const f32x8 kkc = ld8f(a->in[I_K_K] + (size_t)l * RW + col0), kac = ld8f(a->in[I_K_A] + (size_t)l * RW + col0);
        const bool vmine = (cgp >> 1) == rg;
#define SCAN_LOAD(R, cc) do { const int t_ = (cc) * TC + tl; const size_t row_ = rowbase + t_; const size_t rowp_ = (t_ > 0) ? row_ - 1 : row_; \
            const bf16_t* z_ = Z + row_ * NZ + col0; const bf16_t* zq_ = Z + rowp_ * NZ + col0; \
            R.zr = *(const v4u*)(z_ + 1024); R.zk = *(const v4u*)(z_ + 2048); R.zv = *(const v4u*)(z_ + 3072); \
            R.zrp = *(const v4u*)(zq_ + 1024); R.zkp = *(const v4u*)(zq_ + 2048); R.zvp = *(const v4u*)(zq_ + 3072); \
            R.ld = *(const v4u*)(PL + row_ * RW + col0); R.aa = *(const v4u*)(PL + PLANE + row_ * RW + col0); \
            if (hasv) { R.vg = *(const v4u*)(PL + 3 * PLANE + row_ * RW + col0); R.vf = *(const v4u*)(VF + row_ * RW + col0); } else { R.vg = R.ld; R.vf = R.ld; } } while (0)
#define SCAN_FLUSH(cc) do { const LAS float* yb_ = (const LAS float*)(lds + 2 * BUFB + ((cc) & 1) * YBB) + tl * 16 + 2 * cgp; \
            const unsigned w_ = cvt_pk_bf16(yb_[0], yb_[1]); *(unsigned*)(Y + (rowbase + (size_t)(cc) * TC + tl) * RW + h * HS + 16 * rg + 2 * cgp) = w_; } while (0)
        ScanRaw nx; SCAN_LOAD(nx, 0);
        for (int c = 0; c < NC; ++c) {
            const ScanRaw cu = nx;
            if (c + 1 < NC) SCAN_LOAD(nx, c + 1);
            const int t = c * TC + tl;
            const f32x8 zr = up8(cu.zr), zk = up8(cu.zk), zv = up8(cu.zv);
            f32x8 zrp = up8(cu.zrp), zkp = up8(cu.zkp), zvp = up8(cu.zvp);
            if (t == 0) {
#pragma unroll
                for (int q = 0; q < 8; ++q) { zrp[q] = 0.f; zkp[q] = 0.f; zvp[q] = 0.f; } }
            const f32x8 r = zr + (zrp - zr) * mur, k = zk + (zkp - zk) * muk; f32x8 v = zv + (zvp - zv) * muv;
            const f32x8 ld = up8(cu.ld), av = up8(cu.aa);
            if (hasv) v = v + (up8(cu.vf) - v) * up8(cu.vg);
            const f32x8 kk = k * kkc;
            float n2 = sum8(kk * kk); n2 += __shfl_xor(n2, 1); n2 += __shfl_xor(n2, 2); n2 += __shfl_xor(n2, 4);
            const float inv = 1.0f / fmaxf(sqrtf(n2), 1e-12f);
            const f32x8 kkn = kk * inv;
            const f32x8 kadj = k * (1.0f + (av - 1.0f) * kac);
            f32x8 dec;
#pragma unroll
            for (int q = 0; q < 8; ++q) dec[q] = __expf(ld[q]);
            const f32x8 avec = -kkn, bvec = kkn * av;
            LAS unsigned char* dst = lds + (c & 1) * BUFB + tl * STEPB + cgp * 32;
#define ST8(off, val) do { *(LAS f32x4*)(dst + (off)) = (f32x4){val[0], val[1], val[2], val[3]}; *(LAS f32x4*)(dst + (off) + 16) = (f32x4){val[4], val[5], val[6], val[7]}; } while (0)
            ST8(0, r); ST8(256, dec); ST8(512, kadj); ST8(768, avec); ST8(1024, bvec);
            if (vmine) { LAS unsigned char* dv = lds + (c & 1) * BUFB + tl * STEPB + 1280 + (cgp & 1) * 32;
                *(LAS f32x4*)(dv) = (f32x4){v[0], v[1], v[2], v[3]}; *(LAS f32x4*)(dv + 16) = (f32x4){v[4], v[5], v[6], v[7]}; }
#undef ST8
            if (c >= 2) SCAN_FLUSH(c - 2);
            __syncthreads();
        }
        __syncthreads();
        SCAN_FLUSH(NC - 2); SCAN_FLUSH(NC - 1);
#undef SCAN_LOAD
#undef SCAN_FLUSH
    }
    __syncthreads();
}

__device__ __forceinline__ void phase_post(ArgsP a, int l, const int tid, const int bx) {
    const int lane = tid & 63, wave = tid >> 6; const int gw = bx * 8 + wave, NW = gridDim.x * 8;
    const bf16_t* Z = (const bf16_t*)(a->ws + WS_Z); const bf16_t* PL = (const bf16_t*)(a->ws + WS_PLANES); bf16_t* VF = (bf16_t*)(a->ws + WS_VFIRST);
    const bf16_t* Y = (const bf16_t*)(a->ws + WS_DPOOL); bf16_t* MIX = (bf16_t*)(a->ws + WS_MIX);
    const float* mus = a->in[I_MU_SHIFT] + (size_t)l * SHIFTW;
    const bool hasv = l > 0;
    for (int it = gw; it < M * 2; it += NW) {
        const int row = it >> 1, h = (it & 1) * 8 + (lane >> 3), col = h * HS + 8 * (lane & 7), tpos = row & (SEQ - 1);
        const bf16_t* z = Z + (size_t)row * NZ + col; const bf16_t* zq = (tpos > 0) ? z - NZ : z;
        const f32x8 zr = up8(*(const v4u*)(z + 1024)), zk = up8(*(const v4u*)(z + 2048)), zv = up8(*(const v4u*)(z + 3072));
        f32x8 zrp = up8(*(const v4u*)(zq + 1024)), zkp = up8(*(const v4u*)(zq + 2048)), zvp = up8(*(const v4u*)(zq + 3072));
        if (tpos == 0) {
#pragma unroll
            for (int q = 0; q < 8; ++q) { zrp[q] = 0.f; zkp[q] = 0.f; zvp[q] = 0.f; } }
        const f32x8 r = zr + (zrp - zr) * ld8f(mus + col), k = zk + (zkp - zk) * ld8f(mus + 1024 + col); f32x8 v = zv + (zvp - zv) * ld8f(mus + 2048 + col);
        const size_t po = (size_t)row * RW + col;
        const f32x8 av = up8(*(const v4u*)(PL + PLANE + po)), gg = up8(*(const v4u*)(PL + 2 * PLANE + po));
        if (hasv) v = v + (up8(*(const v4u*)(VF + po)) - v) * up8(*(const v4u*)(PL + 3 * PLANE + po));
        else *(v4u*)(VF + po) = pk8(v);
        const f32x8 kadj = k * (1.0f + (av - 1.0f) * ld8f(a->in[I_K_A] + (size_t)l * RW + col));
        float bonus = sum8(r * kadj * ld8f(a->in[I_R_K] + (size_t)l * RW + col));
        bonus += __shfl_xor(bonus, 1); bonus += __shfl_xor(bonus, 2); bonus += __shfl_xor(bonus, 4);
        const f32x8 y = up8(*(const v4u*)(Y + po));
        float sm = sum8(y); sm += __shfl_xor(sm, 1); sm += __shfl_xor(sm, 2); sm += __shfl_xor(sm, 4);
        const float mean = sm * (1.0f / 64.0f);
        const f32x8 d = y - mean;
        float vs = sum8(d * d); vs += __shfl_xor(vs, 1); vs += __shfl_xor(vs, 2); vs += __shfl_xor(vs, 4);
        const float rstd = rsqrtf(vs * (1.0f / 64.0f) + GN_EPS);
        const f32x8 o = (d * rstd * ld8f(a->in[I_GN_G] + (size_t)l * RW + col) + ld8f(a->in[I_GN_B] + (size_t)l * RW + col) + bonus * v) * gg;
        *(v4u*)(MIX + (size_t)row * DM + 1024 + col) = pk8(o);
    }
}

#define XB_TMO      128
#define XB_XCNT(j)  (256  + 64 * (j))
#define XB_XSUB(j)  (1280 + 64 * (j))
#define XB_XGEN(j)  (2304 + 64 * (j))
#define XB_TOP      3328
#define XB_TOPGEN   3392
#define XCD_BAR_WORDS 3456
#define XB_SPIN_CAP (1u << 18)

__device__ __forceinline__ unsigned xb_ld(unsigned* p)              { return __hip_atomic_load(p, __ATOMIC_RELAXED, __HIP_MEMORY_SCOPE_AGENT); }
__device__ __forceinline__ unsigned xb_add(unsigned* p, unsigned v) { return __hip_atomic_fetch_add(p, v, __ATOMIC_RELAXED, __HIP_MEMORY_SCOPE_AGENT); }
__device__ __forceinline__ unsigned xb_xcc_id() { return (unsigned)__builtin_amdgcn_s_getreg((3 << 11) | 20) & 0xFu; }
#define XB_SPIN(cond, bar) do { unsigned _sp = 0; while (cond) { __builtin_amdgcn_s_sleep(1); \
    if ((++_sp & 255u) == 0u) { if (xb_ld(&(bar)[XB_TMO])) break; if (_sp > XB_SPIN_CAP) { atomicAdd(&(bar)[XB_TMO], 1u); break; } } } } while (0)

struct XcdBarrier {
    unsigned* bar; unsigned x;
    volatile LAS unsigned* st;
};

__device__ __forceinline__ XcdBarrier xcd_barrier_post(unsigned* bar, volatile LAS unsigned* st) {
    XcdBarrier b; b.bar = bar; b.x = xb_xcc_id(); b.st = st;
    if (threadIdx.x == 0) (void)xb_add(&bar[XB_XCNT(b.x)], 1u);
    return b;
}
__device__ __forceinline__ void xcd_barrier_complete(unsigned* bar, unsigned x, unsigned& nloc, unsigned& nx) {
    const unsigned G = gridDim.x * gridDim.y * gridDim.z;
    unsigned sum, cnt, mine, sp = 0u;
    for (;;) {
        sum = 0u; cnt = 0u; mine = 0u;
#pragma unroll
        for (unsigned j = 0; j < 16; ++j) { const unsigned c = xb_ld(&bar[XB_XCNT(j)]); sum += c; cnt += (c > 0u) ? 1u : 0u; mine = (j == x) ? c : mine; }
        if (sum == G) break;
        __builtin_amdgcn_s_sleep(1);
        if ((++sp & 255u) == 0u) { if (xb_ld(&bar[XB_TMO])) break; if (sp > XB_SPIN_CAP) { atomicAdd(&bar[XB_TMO], 1u); break; } }
    }
    nloc = mine > 0u ? mine : 1u; nx = cnt > 0u ? cnt : 1u;
}

__device__ __forceinline__ void xcd_barrier(const XcdBarrier& b) {
    asm volatile("s_waitcnt vmcnt(0)" ::: "memory");
    __syncthreads();
    if (threadIdx.x == 0) {
        unsigned* bar = b.bar;
        __builtin_amdgcn_s_waitcnt(0);
        unsigned nloc = b.st[0], nx = b.st[1];
        if (nloc == 0u) { xcd_barrier_complete(bar, b.x, nloc, nx); b.st[0] = nloc; b.st[1] = nx; }
        const unsigned old = xb_add(&bar[XB_XSUB(b.x)], 1u);
        const unsigned gen = old / nloc;
        if (old + 1u == (gen + 1u) * nloc) {
            __builtin_amdgcn_fence(__ATOMIC_RELEASE, "agent");
            asm volatile("s_waitcnt vmcnt(0)" ::: "memory");
            const unsigned og = xb_add(&bar[XB_TOP], 1u);
            const unsigned tg = og / nx;
            if (og + 1u == (tg + 1u) * nx) xb_add(&bar[XB_TOPGEN], 1u);
            else XB_SPIN(xb_ld(&bar[XB_TOPGEN]) == tg, bar);
            __builtin_amdgcn_fence(__ATOMIC_ACQUIRE, "agent");
            xb_add(&bar[XB_XGEN(b.x)], 1u);
            asm volatile("s_waitcnt vmcnt(0)" ::: "memory");
        } else {
            XB_SPIN(xb_ld(&bar[XB_XGEN(b.x)]) == gen, bar);
            __builtin_amdgcn_fence(__ATOMIC_ACQUIRE, "agent");
            asm volatile("s_waitcnt vmcnt(0)" ::: "memory");
        }
    }
    __syncthreads();
}


constexpr int N_PHASES = 2 + 9 * DEPTH;
__device__ __forceinline__ bool make_job(ArgsP a, int l, int s, int q, pg8::Job& J) {
    unsigned char* ws = a->ws; u64* SS = (u64*)(ws + WS_SS);
    bf16_t* XC = (bf16_t*)(ws + ((l & 1) ? WS_XQ : WS_H)); bf16_t* XN = (bf16_t*)(ws + ((l & 1) ? WS_H : WS_XQ));
    bf16_t* MIX = (bf16_t*)(ws + WS_MIX); bf16_t* PP = (bf16_t*)(ws + WS_MIX);
    J.a_pn_step = 0; J.nM = M / 256; J.O = nullptr; J.ldc = DM; J.c0 = nullptr; J.c1 = nullptr; J.c2 = nullptr; J.base = nullptr; J.out = nullptr; J.pp = nullptr; J.ss_in = nullptr; J.ss_out = nullptr;
    if (s == 0 && q == 0) { J.A = XC; J.Bt = (const bf16_t*)(ws + WS_WIN) + (size_t)l * NZ * DM; J.lda = DM; J.ldb = DM; J.K = DM; J.nN = NZ / 256; J.mode = 0; J.O = (bf16_t*)(ws + WS_Z); J.ldc = NZ; J.ss_in = SS + (size_t)(3 * l) * M; return true; }
    if (s == 2 && q == 0) { J.A = (const bf16_t*)(ws + WS_ALORA); J.Bt = (const bf16_t*)(ws + WS_WLORA) + (size_t)l * 4096 * KL; J.lda = KL; J.ldb = KL; J.K = KL; J.nN = 16; J.mode = 3; J.O = (bf16_t*)(ws + WS_PLANES); J.ldc = RW;
                            J.c0 = a->in[I_W0] + (size_t)l * RW; J.c1 = a->in[I_A0] + (size_t)l * RW; J.c2 = (l > 0) ? a->in[I_V0] + (size_t)(l - 1) * RW : nullptr; return true; }
    if (s == 2 && q == 1) { J.A = (const bf16_t*)(ws + WS_DPOOL); J.Bt = (const bf16_t*)(ws + WS_WPOOL) + (size_t)l * 1024 * 256; J.lda = RW; J.ldb = 256; J.K = 256; J.a_pn_step = 256; J.nN = 4; J.mode = 2; J.O = MIX; J.ldc = DM;
                            J.c0 = a->in[I_POOL_SCALE] + (size_t)l * 1024; return true; }
    if (s == 5 && q == 0) { J.A = MIX; J.Bt = (const bf16_t*)(ws + WS_WOUT) + (size_t)l * DM * DM; J.lda = DM; J.ldb = DM; J.K = DM; J.nN = DM / 256; J.mode = 4; J.base = XC; J.out = XC; J.ss_out = SS + (size_t)(3 * l + 1) * M; return true; }
    if (s == 6 && q == 0) { J.A = XC; J.Bt = (const bf16_t*)(ws + WS_WUP) + (size_t)l * DFF * DM; J.lda = DM; J.ldb = DM; J.K = DM; J.nN = DFF / 256; J.mode = 1; J.O = (bf16_t*)(ws + WS_U); J.ldc = DFF; J.ss_in = SS + (size_t)(3 * l + 1) * M; return true; }
    if (s == 8 && q == 0) { J.A = (const bf16_t*)(ws + WS_PB) + (size_t)l * M * DPLE; J.Bt = (const bf16_t*)(ws + WS_WPROJ) + (size_t)l * DM * DPLE; J.lda = DPLE; J.ldb = DPLE; J.K = DPLE; J.nN = DM / 256; J.mode = 0; J.O = PP; J.ldc = DM; return true; }
    if (s == 7 && q == 0) { J.A = (const bf16_t*)(ws + WS_U); J.Bt = (const bf16_t*)(ws + WS_WDN) + (size_t)l * DM * DFF; J.lda = DFF; J.ldb = DFF; J.K = DFF; J.nN = DM / 256; J.mode = 4; J.base = XC; J.out = XC; J.ss_out = SS + (size_t)(3 * l + 2) * M; return true; }
    if (s == 8 && q == 1) { J.A = XC; J.Bt = (const bf16_t*)(ws + WS_WGATE) + (size_t)l * DM * DM; J.lda = DM; J.ldb = DM; J.K = DM; J.nN = DM / 256; J.mode = 5; J.base = XC; J.out = XN; J.pp = PP; J.ss_in = SS + (size_t)(3 * l + 2) * M;
                            J.ss_out = SS + (size_t)(3 * l + 3) * M; return true; }
    return false;
}
__device__ __forceinline__ void phase_final(ArgsP a, const int tid, const int bx) {
    const int lane = tid & 63, wave = tid >> 6; const int gw = bx * 8 + wave, NW = gridDim.x * 8;
    const bf16_t* X = (const bf16_t*)(a->ws + ((DEPTH & 1) ? WS_XQ : WS_H)); const u64* SS = (const u64*)(a->ws + WS_SS) + (size_t)(3 * DEPTH) * M; const float* g = a->in[I_FINAL_NORM]; float* out = a->out;
    f32x8 gv[4];
#pragma unroll
    for (int j = 0; j < 4; ++j) gv[j] = ld8f(g + 8 * lane + 512 * j);
    for (int row = gw; row < M; row += NW) {
        const float rs = rsqrtf((float)SS[row] * SS_INV + NORM_EPS);
#pragma unroll
        for (int j = 0; j < 4; ++j) { const f32x8 o = up8(*(const v4u*)(X + (size_t)row * DM + 8 * lane + 512 * j)) * rs * gv[j]; float* op = out + (size_t)row * DM + 8 * lane + 512 * j;
            *(f32x4*)op = (f32x4){o[0], o[1], o[2], o[3]}; *(f32x4*)(op + 4) = (f32x4){o[4], o[5], o[6], o[7]}; }
    }
}
constexpr int dup_count() { int c = 0; for (int s = 0; s < 9; ++s) c += (PROBE_DUP >> s) & 1; return c; }
constexpr int SUBS = 9 + dup_count(), PRE = 1 + ((PROBE_DUP >> 9) & 1);
constexpr int N_PHASES_RUN = PRE + SUBS * DEPTH + 1;
__global__ void __launch_bounds__(512, 2) fwd_megakernel(Args a_byval) {
    ArgsP a = (ArgsP)__builtin_amdgcn_kernarg_segment_ptr();
    extern __shared__ __attribute__((aligned(16))) unsigned char lds_raw[];
    LAS unsigned char* lds = (LAS unsigned char*)lds_raw;
    cg::grid_group grid = cg::this_grid();
    const int G = gridDim.x;
    if (threadIdx.x < 16) ((LAS unsigned*)(lds + BAR_LDS_OFF))[threadIdx.x] = 0u;
    __syncthreads();
    XcdBarrier xbar = xcd_barrier_post((unsigned*)a->ws, (volatile LAS unsigned*)(lds + BAR_LDS_OFF));
    const int ph_lo = a->ph_lo, ph_hi = a->ph_hi;
    const int wave_s = __builtin_amdgcn_readfirstlane((int)threadIdx.x >> 6);
    if (ph_lo < 0) grid.sync();
    for (int ph = ph_lo; ph < ph_hi; ++ph) {
        if (ph > ph_lo) xcd_barrier(xbar);
        asm volatile("" : "+s"(a) :: "memory");
        int tid = (wave_s << 6) + (int)__builtin_amdgcn_mbcnt_hi(~0u, __builtin_amdgcn_mbcnt_lo(~0u, 0u)), bx = blockIdx.x; asm volatile("" : "+v"(tid), "+s"(bx));
        int l = 0, s;
        if (ph < PRE) s = 13;
        else if (ph == N_PHASES_RUN - 1) s = 12;
        else { l = (ph - PRE) / SUBS; const int qq = (ph - PRE) % SUBS; int c = 0; s = 0;
               for (; s < 9; ++s) { const int n = 1 + ((PROBE_DUP >> s) & 1); if (qq < c + n) break; c += n; } }
        if (s == 13) { phase_convert(a, lds, tid, bx); }
        else if (s == 12) { phase_final(a, tid, bx); }
        else if (s == 1) { phase_prepa(a, l, tid, bx); }
        else if (s == 3) { const int vcu = (G % 8 == 0) ? (bx % 8) * (G / 8) + bx / 8 : bx; for (int u = vcu; u < 256; u += G) scan_unit(a, l, u, lds, tid); }
        else if (s == 4) { phase_post(a, l, tid, bx); }
        else {
            for (int q = 0; q < 2; ++q) { pg8::Job J; if (!make_job(a, l, s, q, J)) break;
                pg8::StaticOrder S; S.init(J.nM, J.nN, G, bx); pg8::gemm_phase(lds, J, S, tid); }
        }
    }
}

extern "C" void kernel_launch(void* const* d_in, const int* in_sizes, int n_in, void* d_out, int out_size, void* d_ws, size_t ws_size, hipStream_t stream) {
    static int grid = 0;
    if (grid == 0) {
        if (n_in != 29 || in_sizes[0] != M * DM || out_size != M * DM || ws_size < WS_END) {
            fprintf(stderr, "kernel_launch: unexpected shapes: n_in %d in0 %d out %d ws %zu (need %zu); nothing launched\n", n_in, n_in > 0 ? in_sizes[0] : -1, out_size, ws_size, (size_t)WS_END); grid = -1; return; }
        int dev = 0, cus = 0, per_cu = 0;
        if (hipGetDevice(&dev) != hipSuccess || hipDeviceGetAttribute(&cus, hipDeviceAttributeMultiprocessorCount, dev) != hipSuccess) { fprintf(stderr, "kernel_launch: device query failed\n"); grid = -1; return; }
        if (hipFuncSetAttribute((const void*)fwd_megakernel, hipFuncAttributeMaxDynamicSharedMemorySize, LDS_BYTES) != hipSuccess) { fprintf(stderr, "kernel_launch: hipFuncSetAttribute failed\n"); grid = -1; return; }
        if (hipOccupancyMaxActiveBlocksPerMultiprocessor(&per_cu, (const void*)fwd_megakernel, 512, LDS_BYTES) != hipSuccess || per_cu < 1) {
            fprintf(stderr, "kernel_launch: occupancy query says %d blocks/CU; using 1\n", per_cu); per_cu = 1; }
        (void)hipGetLastError();
        grid = cus * 1;
        if (grid > 256) grid = 256;
    }
    if (grid < 0) return;
    Args a{};
    for (int i = 0; i < 29; ++i) a.in[i] = (const float*)d_in[i];
    a.out = (float*)d_out; a.ws = (unsigned char*)d_ws;
    if (hipMemsetAsync(d_ws, 0, 65536, stream) != hipSuccess) { fprintf(stderr, "kernel_launch: memset of barrier words failed\n"); return; }
#if MK_PER_PHASE_LAUNCH
    for (int ph = 0; ph < N_PHASES_RUN; ++ph) {
        a.ph_lo = ph; a.ph_hi = ph + 1;
        hipLaunchKernelGGL(fwd_megakernel, dim3(grid), dim3(512), LDS_BYTES, stream, a);
    }
#else
    a.ph_lo = 0; a.ph_hi = N_PHASES_RUN;
    void* args[] = {&a};
    hipError_t e = hipLaunchCooperativeKernel((const void*)fwd_megakernel, dim3(grid), dim3(512), args, LDS_BYTES, stream);
    if (e != hipSuccess) fprintf(stderr, "cooperative launch failed: %s (grid %d)\n", hipGetErrorString(e), grid);
#endif
}
```
